# Optimizing an MI355X kernel written in HIP

```python
import math
import jax, jax.numpy as jnp
from jax import lax
import numpy as np

D_MODEL = 1024
BATCH = 8
SEQ = 2048
DEPTH = 2

DIL_PAIRS = ((128, 1), (512, 4), (2048, 16))
N_DIL_GROUPS = 3
A_SLOTS = 4
A_HEAD_DIM = 64
A_HEADS = N_DIL_GROUPS * A_SLOTS
A_QKV = A_HEADS * A_HEAD_DIM
A_OUT = A_SLOTS * A_HEAD_DIM

B_HEADS = 4
B_HEAD_DIM = 64
B_QK = B_HEADS * 2 * B_HEAD_DIM
B_V = B_HEADS * 2 * B_HEAD_DIM

C_HEADS = 6
C_NOPE = 64
C_ROPE = 32
C_V = 64
C_Q_LORA = 256
C_KV_LORA = 128
C_OUT = C_HEADS * C_V
ROPE_THETA = 10000.0

N_BRANCH = 3
IN_SPLITS = (A_QKV, A_QKV, A_QKV, B_QK, B_QK, B_V, C_Q_LORA, C_KV_LORA, C_ROPE, N_BRANCH * D_MODEL)
IN_COLS = sum(IN_SPLITS)

N_EXPERTS = 16
N_EXPERT_GROUPS = 4
EXPERTS_PER_GROUP = N_EXPERTS // N_EXPERT_GROUPS
TOP_K = 2
D_EXPERT = 512

Q_BLOCK = 128
RMS_EPS = 1e-6
NEG_INF = -1e30

kernel_name = "hybrid_gated_dilated_diff_mla_moe"


def rmsnorm(t, g):
    tf = t.astype(jnp.float32)
    y = tf * lax.rsqrt(jnp.mean(tf * tf, axis=-1, keepdims=True) + RMS_EPS)
    return (y * g.astype(jnp.float32)).astype(t.dtype)


def alibi_slopes(n):
    return 2.0 ** (-8.0 * jnp.arange(1, n + 1, dtype=jnp.float32) / n)


def rope(t, pos):
    d = t.shape[-1]
    half = d // 2
    inv = ROPE_THETA ** (-jnp.arange(half, dtype=jnp.float32) * 2.0 / d)
    ang = pos.astype(jnp.float32)[:, None] * inv[None, :]
    cos = jnp.cos(ang)[:, None, :]
    sin = jnp.sin(ang)[:, None, :]
    tf = t.astype(jnp.float32)
    t1, t2 = tf[..., :half], tf[..., half:]
    return jnp.concatenate([t1 * cos - t2 * sin, t1 * sin + t2 * cos], axis=-1).astype(t.dtype)


def causal_attention(q, k, v, scale, slopes=None):
    B, S, H, dk = q.shape
    nb = S // Q_BLOCK
    key_pos = jnp.arange(S)
    qb = q.reshape(B, nb, Q_BLOCK, H, dk).swapaxes(0, 1)

    def block(args):
        qi, bi = args
        dist = (bi * Q_BLOCK + jnp.arange(Q_BLOCK))[:, None] - key_pos[None, :]
        s = jnp.einsum('bqhd,bkhd->bhqk', qi, k).astype(jnp.float32) * scale
        if slopes is not None:
            s = s - slopes.astype(jnp.float32)[:, None, None] * dist.astype(jnp.float32)
        s = jnp.where(dist >= 0, s, NEG_INF)
        p = jax.nn.softmax(s, axis=-1)
        return jnp.einsum('bhqk,bkhd->bqhd', p.astype(v.dtype), v)

    out = lax.map(block, (qb, jnp.arange(nb)))
    return out.swapaxes(0, 1).reshape(B, S, H, v.shape[-1])


def dilated_group_attention(q, k, v, dilation, steps, slopes):
    B, S, H, d = q.shape
    L = S // dilation
    nb = -(-L // steps)
    Lp = nb * steps

    def to_residue_blocks(t):
        t = t.reshape(B, L, dilation, H, d).transpose(0, 2, 1, 3, 4)
        t = jnp.pad(t, ((0, 0), (0, 0), (0, Lp - L), (0, 0), (0, 0)))
        return t.reshape(B, dilation, nb, steps, H, d)

    def with_prev(t):
        prev = jnp.pad(t[:, :, :-1], ((0, 0), (0, 0), (1, 0), (0, 0), (0, 0), (0, 0)))
        return jnp.concatenate([prev, t], axis=3)

    qb = to_residue_blocks(q)
    kc = with_prev(to_residue_blocks(k))
    vc = with_prev(to_residue_blocks(v))

    s = jnp.einsum('brnqhd,brnkhd->brnhqk', qb, kc).astype(jnp.float32) * (d ** -0.5)
    qi = jnp.arange(nb)[:, None] * steps + jnp.arange(steps)[None, :]
    ki = jnp.arange(nb)[:, None] * steps - steps + jnp.arange(2 * steps)[None, :]
    dist = qi[:, :, None] - ki[:, None, :]
    valid = (dist >= 0) & (dist <= steps) & (ki[:, None, :] >= 0)
    bias = -slopes.astype(jnp.float32)[None, :, None, None] * (dist * dilation).astype(jnp.float32)[:, None]
    s = jnp.where(valid[:, None], s + bias, NEG_INF)
    lse = jax.nn.logsumexp(s, axis=-1)
    p = jnp.exp(s - lse[..., None])
    o = jnp.einsum('brnhqk,brnkhd->brnqhd', p.astype(v.dtype), vc)

    o = o.reshape(B, dilation, Lp, H, d)[:, :, :L].transpose(0, 2, 1, 3, 4).reshape(B, S, H, d)
    lse = lse.transpose(0, 1, 2, 4, 3).reshape(B, dilation, Lp, H)[:, :, :L]
    lse = lse.transpose(0, 2, 1, 3).reshape(B, S, H)
    return o, lse


def moe_ffn(h, w_router, router_bias, w_gate, w_up, w_down):
    def per_row(hr):
        scores = jax.nn.sigmoid((hr @ w_router).astype(jnp.float32))
        biased = scores + router_bias.astype(jnp.float32)
        grouped = biased.reshape(-1, N_EXPERT_GROUPS, EXPERTS_PER_GROUP)
        group_score = lax.top_k(grouped, TOP_K)[0].sum(-1)
        group = jnp.argmax(group_score, axis=-1)
        in_group = jnp.take_along_axis(grouped, group[:, None, None], axis=1)[:, 0]
        _, local = lax.top_k(in_group, TOP_K)
        expert = group[:, None] * EXPERTS_PER_GROUP + local
        w = jnp.take_along_axis(scores, expert, axis=1)
        w = w / jnp.sum(w, axis=-1, keepdims=True)
        combine = jnp.einsum('sk,ske->se', w, jax.nn.one_hot(expert, N_EXPERTS, dtype=jnp.float32))
        a = jnp.einsum('sd,edf->sef', hr, w_gate)
        b = jnp.einsum('sd,edf->sef', hr, w_up)
        act = jax.nn.silu(a) * b * combine[:, :, None].astype(hr.dtype)
        return jnp.einsum('sef,efd->sd', act, w_down)
    return lax.map(per_row, h)


def setup_inputs(seed: int = 0) -> dict:
    key = jax.random.key(seed)
    ks = jax.random.split(key, 24)
    f32 = jnp.float32

    def nrm(k, shape, fan_in, gain=1.0):
        return jax.random.normal(k, shape, f32) * (gain * fan_in ** -0.5)

    def gain_vec(k, shape):
        return 1.0 + 0.02 * jax.random.normal(k, shape, f32)

    res_gain = (2.0 * DEPTH) ** -0.5
    return {
        'x': jax.random.normal(ks[0], (BATCH, SEQ, D_MODEL), f32),
        'w_in': nrm(ks[1], (DEPTH, D_MODEL, IN_COLS), D_MODEL),
        'g_mix': gain_vec(ks[2], (DEPTH, D_MODEL)),
        'p_a': nrm(ks[3], (DEPTH, A_OUT, D_MODEL), A_OUT),
        'p_b': nrm(ks[4], (DEPTH, B_V, D_MODEL), B_V),
        'p_c': nrm(ks[5], (DEPTH, C_OUT, D_MODEL), C_OUT),
        'w_o': nrm(ks[6], (DEPTH, D_MODEL, D_MODEL), D_MODEL, res_gain),
        'g_q': gain_vec(ks[7], (DEPTH, C_Q_LORA)),
        'w_uq': nrm(ks[8], (DEPTH, C_Q_LORA, C_HEADS * (C_NOPE + C_ROPE)), C_Q_LORA),
        'g_kv': gain_vec(ks[9], (DEPTH, C_KV_LORA)),
        'w_ukv': nrm(ks[10], (DEPTH, C_KV_LORA, C_HEADS * (C_NOPE + C_V)), C_KV_LORA),
        'lam_q1': 0.1 * jax.random.normal(ks[11], (DEPTH, B_HEAD_DIM), f32),
        'lam_k1': 0.1 * jax.random.normal(ks[12], (DEPTH, B_HEAD_DIM), f32),
        'lam_q2': 0.1 * jax.random.normal(ks[13], (DEPTH, B_HEAD_DIM), f32),
        'lam_k2': 0.1 * jax.random.normal(ks[14], (DEPTH, B_HEAD_DIM), f32),
        'g_sub': gain_vec(ks[15], (DEPTH, 2 * B_HEAD_DIM)),
        'g_ffn': gain_vec(ks[16], (DEPTH, D_MODEL)),
        'w_router': nrm(ks[17], (D_MODEL, N_EXPERTS), D_MODEL),
        'router_bias': 0.01 * jax.random.normal(ks[18], (N_EXPERTS,), f32),
        'w_gate': nrm(ks[19], (DEPTH, N_EXPERTS, D_MODEL, D_EXPERT), D_MODEL),
        'w_up': nrm(ks[20], (DEPTH, N_EXPERTS, D_MODEL, D_EXPERT), D_MODEL),
        'w_down': nrm(ks[21], (DEPTH, N_EXPERTS, D_EXPERT, D_MODEL), D_EXPERT, res_gain),
        'g_final': gain_vec(ks[22], (D_MODEL,)),
    }


def reference(x, w_in, g_mix, p_a, p_b, p_c, w_o, g_q, w_uq, g_kv, w_ukv,
              lam_q1, lam_k1, lam_q2, lam_k2, g_sub, g_ffn, w_router, router_bias,
              w_gate, w_up, w_down, g_final):
    B, S, _ = x.shape
    pos = jnp.arange(S)
    slopes_a = alibi_slopes(A_HEADS).reshape(N_DIL_GROUPS, A_SLOTS)
    slopes_b = jnp.repeat(alibi_slopes(B_HEADS), 2)
    split_at = np.cumsum(IN_SPLITS)[:-1].tolist()

    for l in range(DEPTH):
        u = rmsnorm(x, g_mix[l])
        qa, ka, va, qd, kd, vd, cq, ckv, kr, gate_pre = jnp.split(u @ w_in[l], split_at, axis=-1)

        shp_a = (B, S, N_DIL_GROUPS, A_SLOTS, A_HEAD_DIM)
        qa, ka, va = qa.reshape(shp_a), ka.reshape(shp_a), va.reshape(shp_a)
        outs, lses = [], []
        for g, (window, dilation) in enumerate(DIL_PAIRS):
            o_g, lse_g = dilated_group_attention(qa[:, :, g], ka[:, :, g], va[:, :, g],
                                                 dilation, window // dilation, slopes_a[g])
            outs.append(o_g)
            lses.append(lse_g)
        alpha = jax.nn.softmax(jnp.stack(lses), axis=0)
        o_a = jnp.sum(alpha[..., None].astype(x.dtype) * jnp.stack(outs), axis=0).reshape(B, S, A_OUT)

        lam_init = 0.8 - 0.6 * math.exp(-0.3 * l)
        lam = (jnp.exp(jnp.sum(lam_q1[l].astype(jnp.float32) * lam_k1[l].astype(jnp.float32)))
               - jnp.exp(jnp.sum(lam_q2[l].astype(jnp.float32) * lam_k2[l].astype(jnp.float32)))
               + lam_init)
        q_d = qd.reshape(B, S, 2 * B_HEADS, B_HEAD_DIM)
        k_d = kd.reshape(B, S, 2 * B_HEADS, B_HEAD_DIM)
        v_d = jnp.repeat(vd.reshape(B, S, B_HEADS, 2 * B_HEAD_DIM), 2, axis=2)
        o_d = causal_attention(q_d, k_d, v_d, B_HEAD_DIM ** -0.5, slopes_b)
        o_d = o_d.reshape(B, S, B_HEADS, 2, 2 * B_HEAD_DIM)
        o_d = o_d[:, :, :, 0] - lam.astype(o_d.dtype) * o_d[:, :, :, 1]
        o_b = (rmsnorm(o_d, g_sub[l]) * (1.0 - lam_init)).reshape(B, S, B_V)

        q_c = (rmsnorm(cq, g_q[l]) @ w_uq[l]).reshape(B, S, C_HEADS, C_NOPE + C_ROPE)
        q_c = jnp.concatenate([q_c[..., :C_NOPE], rope(q_c[..., C_NOPE:], pos)], axis=-1)
        kv = (rmsnorm(ckv, g_kv[l]) @ w_ukv[l]).reshape(B, S, C_HEADS, C_NOPE + C_V)
        k_r = jnp.broadcast_to(rope(kr[:, :, None, :], pos), (B, S, C_HEADS, C_ROPE))
        k_c = jnp.concatenate([kv[..., :C_NOPE], k_r], axis=-1)
        o_c = causal_attention(q_c, k_c, kv[..., C_NOPE:], (C_NOPE + C_ROPE) ** -0.5).reshape(B, S, C_OUT)

        gates = jax.nn.sigmoid(gate_pre).reshape(B, S, N_BRANCH, D_MODEL)
        merged = (gates[:, :, 0] * (o_a @ p_a[l])
                  + gates[:, :, 1] * (o_b @ p_b[l])
                  + gates[:, :, 2] * (o_c @ p_c[l]))
        x = x + merged @ w_o[l]

        x = x + moe_ffn(rmsnorm(x, g_ffn[l]), w_router, router_bias, w_gate[l], w_up[l], w_down[l])

    return rmsnorm(x, g_final)
```

```cpp
#define ORACLE_BUILD 1
#include <hip/hip_runtime.h>
#include <cstdio>
#include <cstdint>
#include <cmath>

#define GAS __attribute__((address_space(1)))
#define LAS __attribute__((address_space(3)))
#define DI __device__ __forceinline__
typedef unsigned short bf16;
typedef unsigned v4u __attribute__((ext_vector_type(4)));
typedef unsigned v2u __attribute__((ext_vector_type(2)));
typedef float f32x4 __attribute__((ext_vector_type(4)));
typedef float f32x2 __attribute__((ext_vector_type(2)));
typedef float f32x16 __attribute__((ext_vector_type(16)));
typedef short bf16x8 __attribute__((ext_vector_type(8)));
typedef short s16x4 __attribute__((ext_vector_type(4)));

constexpr int NB = 8, SEQ = 2048, DM = 1024, M = NB * SEQ, DEPTH = 2;
constexpr int IN_COLS = 7328, NPROJ = 7424;
constexpr int NEXP = 16, DEXP = 512;
constexpr float RMS_EPS = 1e-6f;
constexpr float LOG2E = 1.4426950408889634f;
constexpr float C2A = 0.125f * LOG2E;
constexpr float C2C = 0.10206207261596577f * LOG2E;
constexpr int PA = 2304, PB = 1536, PCL = 512, PG = 3072, PQC = 576, PKV = 768, POC = 384, POA = 256;
constexpr int KR_COL = 384;

constexpr size_t MiB = 1u << 20;
constexpr size_t WS_CTL = 0, CTL_BYTES = 1 * MiB;
constexpr size_t WS_LIST = 1 * MiB;
constexpr size_t WS_WLIST = 2 * MiB;
constexpr size_t WS_SSQQ = 3 * MiB;
constexpr size_t WS_SSQKV = 3 * MiB + 256 * 1024;
constexpr size_t WS_LSE = 3 * MiB + 512 * 1024;
constexpr size_t WS_ROPE = 5 * MiB;
constexpr size_t WS_WMIX = 8 * MiB;
constexpr size_t WM_IN = WS_WMIX;
constexpr size_t WM_O = WM_IN + (size_t)NPROJ * DM * 2;
constexpr size_t WM_PA = WM_O + (size_t)DM * DM * 2;
constexpr size_t WM_PB = WM_PA + (size_t)DM * 256 * 2;
constexpr size_t WM_PC = WM_PB + (size_t)DM * 512 * 2;
constexpr size_t WM_UQ = WM_PC + (size_t)DM * 384 * 2;
constexpr size_t WM_UKV = WM_UQ + (size_t)768 * 256 * 2;
constexpr size_t WM_END = WM_UKV + (size_t)768 * 256 * 2;
static_assert(WM_END <= 28 * MiB, "mixer weights");
constexpr size_t WS_U = 28 * MiB;
constexpr size_t WS_KVC = WS_U;
constexpr size_t WS_OA = WS_U + 24 * MiB;
constexpr size_t WS_QKVA = 60 * MiB;
constexpr size_t WS_QKVB = 132 * MiB;
constexpr size_t WS_CLAT = 180 * MiB;
constexpr size_t WS_G = 196 * MiB;
constexpr size_t WS_QC = 292 * MiB;
constexpr size_t WS_OC = 310 * MiB;
constexpr size_t WS_END = 322 * MiB;
constexpr size_t WS_MERGED = WS_QKVA;
constexpr size_t WS_WGU = 60 * MiB;
constexpr size_t WS_WD = 92 * MiB;
constexpr size_t WS_ACT = 108 * MiB;
constexpr size_t WS_Y = 144 * MiB;
constexpr int ACT_ROWS = 2 * M + NEXP * 256;
static_assert(WS_ACT + (size_t)ACT_ROWS * DEXP * 2 <= WS_Y && WS_Y + (size_t)2 * M * DM * 2 <= WS_END, "moe map");
constexpr int CW_TMO = 0;
constexpr int CW_CNT = 64;
constexpr int CW_ERR = 256;
constexpr int CW_BAR = 4096;

struct Params {
    const float* in[23]; float* out; unsigned char* ws;
};

DI unsigned f2bf(float f) { unsigned u = __builtin_bit_cast(unsigned, f); return (u + 0x7fffu + ((u >> 16) & 1u)) >> 16; }
DI unsigned pk2(float lo, float hi) { return f2bf(lo) | (f2bf(hi) << 16); }
DI float bf2f(unsigned short b) { return __builtin_bit_cast(float, (unsigned)b << 16); }
DI float bflo(unsigned w) { return __builtin_bit_cast(float, w << 16); }
DI float bfhi(unsigned w) { return __builtin_bit_cast(float, w & 0xffff0000u); }
DI float wave_sum(float v) {
#pragma unroll
    for (int o = 1; o < 64; o <<= 1) v += __shfl_xor(v, o);
    return v;
}
DI float wave_max(float v) {
#pragma unroll
    for (int o = 1; o < 64; o <<= 1) v = fmaxf(v, __shfl_xor(v, o));
    return v;
}
DI float sigmoidf_(float x) { return 1.0f / (1.0f + __expf(-x)); }
DI float alibi_a(int h) { return exp2f(-8.0f * (float)(h + 1) / 12.0f); }
DI float alibi_b(int h) { return exp2f(-2.0f * (float)(h + 1)); }
DI float lam_init_of(int l) { return 0.8f - 0.6f * expf(-0.3f * (float)l); }
DI float lam_of(const Params& p, int l, int lane) {
    const float a = p.in[11][l * 64 + lane] * p.in[12][l * 64 + lane], b = p.in[13][l * 64 + lane] * p.in[14][l * 64 + lane];
    return expf(wave_sum(a)) - expf(wave_sum(b)) + lam_init_of(l);
}
#define LDS_WAIT() asm volatile("s_waitcnt lgkmcnt(0)" ::: "memory")

struct MapIdent { int off; DI int operator()(int n) const { return n + off; } };
struct MapWin { DI int operator()(int n) const { if (n < 4224) return n; if (n < 4256) { const int i = n - 4224; return 4224 + (i < 16 ? 2 * i : 2 * (i - 16) + 1); } return n + 96; } };
struct MapUq { DI int operator()(int n) const { const int h = n / 96, j = n % 96; if (j < 64) return n; const int i = j - 64; return h * 96 + 64 + (i < 16 ? 2 * i : 2 * (i - 16) + 1); } };
struct MapGate { DI int operator()(int n) const { return 8 * (n >> 2) + (n & 3); } };
struct MapUp { DI int operator()(int n) const { return 8 * (n >> 2) + 4 + (n & 3); } };

template <class Map>
DI void cvt_item(const float* __restrict__ W, int N, bf16* WT, int Kd, const float* gk, const Map& map, LAS float* scr, int item, int lane) {
    const int nblk = N / 32, kb = item / nblk, nb = item % nblk, k0 = 64 * kb, n0 = 32 * nb;
#pragma unroll 8
    for (int i = 0; i < 32; ++i) { const int kk = 2 * i + (lane >> 5); float v = W[(size_t)(k0 + kk) * N + n0 + (lane & 31)]; if (gk) v *= gk[k0 + kk]; scr[kk * 33 + (lane & 31)] = v; }
    LDS_WAIT(); asm volatile("" ::: "memory");
    const int c = lane & 7;
#pragma unroll
    for (int j = 0; j < 4; ++j) { const int n = (lane >> 3) + 8 * j; const LAS float* s = scr + (8 * c) * 33 + n;
        v4u o; o.x = pk2(s[0 * 33], s[1 * 33]); o.y = pk2(s[2 * 33], s[3 * 33]); o.z = pk2(s[4 * 33], s[5 * 33]); o.w = pk2(s[6 * 33], s[7 * 33]);
        const int dr = map(n0 + n);
        *(v4u*)(WT + (size_t)dr * Kd + k0 + 8 * c) = o; }
    LDS_WAIT(); asm volatile("" ::: "memory");
}

DI void ph_cvt_mixer(const Params& p, int l, int gw, int NGW, int lane, LAS float* scr) {
    unsigned char* ws = p.ws;
    constexpr int I_IN = 16 * (IN_COLS / 32), I_O = 16 * 32, I_PA = 4 * 32, I_PB = 8 * 32, I_PC = 6 * 32, I_UQ = 4 * 18, I_UKV = 2 * 24;
    constexpr int NIT = I_IN + I_O + I_PA + I_PB + I_PC + I_UQ + I_UKV;
    for (int it = gw; it < NIT; it += NGW) {
        int r = it;
        if (r < I_IN) { cvt_item(p.in[1] + (size_t)l * DM * IN_COLS, IN_COLS, (bf16*)(ws + WM_IN), DM, nullptr, MapWin{}, scr, r, lane); continue; } r -= I_IN;
        if (r < I_O) { cvt_item(p.in[6] + (size_t)l * DM * DM, DM, (bf16*)(ws + WM_O), DM, nullptr, MapIdent{0}, scr, r, lane); continue; } r -= I_O;
        if (r < I_PA) { cvt_item(p.in[3] + (size_t)l * 256 * DM, DM, (bf16*)(ws + WM_PA), 256, nullptr, MapIdent{0}, scr, r, lane); continue; } r -= I_PA;
        if (r < I_PB) { cvt_item(p.in[4] + (size_t)l * 512 * DM, DM, (bf16*)(ws + WM_PB), 512, nullptr, MapIdent{0}, scr, r, lane); continue; } r -= I_PB;
        if (r < I_PC) { cvt_item(p.in[5] + (size_t)l * 384 * DM, DM, (bf16*)(ws + WM_PC), 384, nullptr, MapIdent{0}, scr, r, lane); continue; } r -= I_PC;
        if (r < I_UQ) { cvt_item(p.in[8] + (size_t)l * 256 * 576, 576, (bf16*)(ws + WM_UQ), 256, p.in[7] + l * 256, MapUq{}, scr, r, lane); continue; } r -= I_UQ;
        cvt_item(p.in[10] + (size_t)l * 128 * 768, 768, (bf16*)(ws + WM_UKV), 256, p.in[9] + l * 128, MapIdent{0}, scr, r, lane);
    }
    const v4u z = {0u, 0u, 0u, 0u};
    const int gt = gw * 64 + lane, NT = NGW * 64;
    for (int c = gt; c < 96 * 128; c += NT) *(v4u*)((bf16*)(ws + WM_IN) + (size_t)4256 * DM + (size_t)c * 8) = z;
    for (int c = gt; c < 192 * 32; c += NT) *(v4u*)((bf16*)(ws + WM_UQ) + (size_t)576 * 256 + (size_t)c * 8) = z;
    for (int c = gt; c < 768 * 16; c += NT) *(v4u*)((bf16*)(ws + WM_UKV) + (size_t)(c >> 4) * 256 + 128 + (c & 15) * 8) = z;
}
DI void ph_cvt_experts(const Params& p, int l, int gw, int NGW, int lane, LAS float* scr) {
    unsigned char* ws = p.ws;
    constexpr int IG = 16 * 16, IDN = 8 * 32, PER = 2 * IG + IDN;
    for (int it = gw; it < NEXP * PER; it += NGW) {
        const int e = it / PER; int r = it % PER;
        const size_t eo = ((size_t)l * NEXP + e) * DM * DEXP;
        if (r < IG) { cvt_item(p.in[19] + eo, DEXP, (bf16*)(ws + WS_WGU) + (size_t)e * 1024 * 1024, DM, nullptr, MapGate{}, scr, r, lane); continue; } r -= IG;
        if (r < IG) { cvt_item(p.in[20] + eo, DEXP, (bf16*)(ws + WS_WGU) + (size_t)e * 1024 * 1024, DM, nullptr, MapUp{}, scr, r, lane); continue; } r -= IG;
        cvt_item(p.in[21] + eo, DM, (bf16*)(ws + WS_WD) + (size_t)e * 1024 * 512, DEXP, nullptr, MapIdent{0}, scr, r, lane);
    }
}
DI void ph_rope_table(const Params& p, int gw, int NGW, int lane) {
    f32x2* tab = (f32x2*)(p.ws + WS_ROPE);
    for (int idx = gw * 64 + lane; idx < SEQ * 16; idx += NGW * 64) {
        const int pos = idx >> 4, i = idx & 15;
        double inv = 1.0; for (int j = 0; j < i; ++j) inv *= 0.56234132519034908;
        const double rev = (double)pos * inv * 0.15915494309189535;
        double fr = rev - floor(rev); if (fr >= 0.5) fr -= 1.0;
        const float f = (float)fr;
        tab[idx] = (f32x2){__builtin_amdgcn_cosf(f), __builtin_amdgcn_sinf(f)};
    }
}
DI void load_row(const float* xr, int lane, f32x4 (&v)[4]) {
#pragma unroll
    for (int j = 0; j < 4; ++j) v[j] = ((const f32x4*)xr)[lane + 64 * j];
}
DI float row_ss(const f32x4 (&v)[4]) {
    float s = 0.f;
#pragma unroll
    for (int j = 0; j < 4; ++j) s += (v[j].x * v[j].x + v[j].y * v[j].y) + (v[j].z * v[j].z + v[j].w * v[j].w);
    return wave_sum(s);
}
DI void store_row_bf16(bf16* orow, int lane, const f32x4 (&v)[4], float rs, const float* g) {
#pragma unroll
    for (int j = 0; j < 4; ++j) { const f32x4 gg = ((const f32x4*)g)[lane + 64 * j];
        v2u o; o.x = pk2(v[j].x * rs * gg.x, v[j].y * rs * gg.y); o.y = pk2(v[j].z * rs * gg.z, v[j].w * rs * gg.w);
        ((v2u*)orow)[lane + 64 * j] = o; }
}
DI void ph_rmsnorm(const float* x, const float* g, bf16* out, int gw, int NGW, int lane) {
    for (int m = gw; m < M; m += NGW) { f32x4 v[4]; load_row(x + (size_t)m * DM, lane, v);
        const float rs = rsqrtf(row_ss(v) * (1.0f / DM) + RMS_EPS);
        store_row_bf16(out + (size_t)m * DM, lane, v, rs, g); }
}
DI void ph_router(const Params& p, int l, int gw, int NGW, int lane) {
    const float* x1 = p.out; const float* g = p.in[16] + l * DM; const float* wr = p.in[17]; const float* rb = p.in[18];
    bf16* h = (bf16*)(p.ws + WS_U); int* list = (int*)(p.ws + WS_LIST); float* wl = (float*)(p.ws + WS_WLIST);
    unsigned* cnt = (unsigned*)(p.ws + WS_CTL) + CW_CNT + l * 64;
    for (int m = gw; m < M; m += NGW) {
        f32x4 v[4]; load_row(x1 + (size_t)m * DM, lane, v);
        const float rs = rsqrtf(row_ss(v) * (1.0f / DM) + RMS_EPS);
        float lg[16];
#pragma unroll
        for (int e = 0; e < 16; ++e) lg[e] = 0.f;
#pragma unroll
        for (int j = 0; j < 4; ++j) { const f32x4 gg = ((const f32x4*)g)[lane + 64 * j];
            const float hv[4] = {v[j].x * rs * gg.x, v[j].y * rs * gg.y, v[j].z * rs * gg.z, v[j].w * rs * gg.w};
            v2u o; o.x = pk2(hv[0], hv[1]); o.y = pk2(hv[2], hv[3]); ((v2u*)(h + (size_t)m * DM))[lane + 64 * j] = o;
#pragma unroll
            for (int c = 0; c < 4; ++c) { const f32x4* wrow = (const f32x4*)(wr + (size_t)(4 * lane + 256 * j + c) * 16);
#pragma unroll
                for (int q = 0; q < 4; ++q) { const f32x4 w = wrow[q]; lg[4 * q] += hv[c] * w.x; lg[4 * q + 1] += hv[c] * w.y; lg[4 * q + 2] += hv[c] * w.z; lg[4 * q + 3] += hv[c] * w.w; } } }
        float sc[16], bs[16];
#pragma unroll
        for (int e = 0; e < 16; ++e) { const float t = wave_sum(lg[e]); sc[e] = 1.0f / (1.0f + expf(-t)); bs[e] = sc[e] + rb[e]; }
        int bg = 0; float bgs = -1e30f; int i1 = 0, i2 = 1;
#pragma unroll
        for (int gI = 0; gI < 4; ++gI) {
            int a = 0; float av = bs[4 * gI];
#pragma unroll
            for (int i = 1; i < 4; ++i) if (bs[4 * gI + i] > av) { av = bs[4 * gI + i]; a = i; }
            int b = -1; float bv = -1e30f;
#pragma unroll
            for (int i = 0; i < 4; ++i) if (i != a && bs[4 * gI + i] > bv) { bv = bs[4 * gI + i]; b = i; }
            const float gs = av + bv;
            if (gs > bgs) { bgs = gs; bg = gI; i1 = a; i2 = b; }
        }
        const int e1 = bg * 4 + i1, e2 = bg * 4 + i2;
        float s1 = 0.f, s2 = 0.f;
#pragma unroll
        for (int e = 0; e < 16; ++e) { if (e == e1) s1 = sc[e]; if (e == e2) s2 = sc[e]; }
        const float inv = 1.0f / (s1 + s2);
        if (lane == 0) {
            const unsigned p1 = atomicAdd(cnt + e1, 1u), p2 = atomicAdd(cnt + e2, 1u);
            list[e1 * M + p1] = m * 2; wl[e1 * M + p1] = s1 * inv;
            list[e2 * M + p2] = m * 2 + 1; wl[e2 * M + p2] = s2 * inv;
        }
    }
}
DI void ph_combine(const Params& p, int l, int gw, int NGW, int lane) {
    float* x1 = p.out; const bf16* Y = (const bf16*)(p.ws + WS_Y); bf16* u = (bf16*)(p.ws + WS_U);
    const bool last = (l == DEPTH - 1); const float* g = last ? p.in[22] : p.in[2] + (l + 1) * DM;
    for (int m = gw; m < M; m += NGW) {
        f32x4 v[4]; load_row(x1 + (size_t)m * DM, lane, v);
#pragma unroll
        for (int j = 0; j < 4; ++j) { const v2u a = ((const v2u*)(Y + (size_t)(2 * m) * DM))[lane + 64 * j], b = ((const v2u*)(Y + (size_t)(2 * m + 1) * DM))[lane + 64 * j];
            v[j].x += bflo(a.x) + bflo(b.x); v[j].y += bfhi(a.x) + bfhi(b.x); v[j].z += bflo(a.y) + bflo(b.y); v[j].w += bfhi(a.y) + bfhi(b.y); }
        const float rs = rsqrtf(row_ss(v) * (1.0f / DM) + RMS_EPS);
        if (last) {
#pragma unroll
            for (int j = 0; j < 4; ++j) { const f32x4 gg = ((const f32x4*)g)[lane + 64 * j]; ((f32x4*)(x1 + (size_t)m * DM))[lane + 64 * j] = v[j] * rs * gg; }
        } else {
#pragma unroll
            for (int j = 0; j < 4; ++j) ((f32x4*)(x1 + (size_t)m * DM))[lane + 64 * j] = v[j];
            store_row_bf16(u + (size_t)m * DM, lane, v, rs, g);
        }
    }
}
DI void ph_amerge(const Params& p, int gw, int NGW, int lane) {
    const bf16* og = (const bf16*)(p.ws + WS_QKVA); const float* lse = (const float*)(p.ws + WS_LSE); bf16* oa = (bf16*)(p.ws + WS_OA);
    const int s = lane >> 4, d0 = (lane & 15) * 4;
    for (int t = gw; t < M; t += NGW) {
        const float l0 = lse[((size_t)0 * M + t) * 4 + s], l1 = lse[((size_t)1 * M + t) * 4 + s], l2 = lse[((size_t)2 * M + t) * 4 + s];
        const float mx = fmaxf(l0, fmaxf(l1, l2)); const float a0 = exp2f(l0 - mx), a1 = exp2f(l1 - mx), a2 = exp2f(l2 - mx); const float inv = 1.0f / (a0 + a1 + a2);
        const v2u x0 = *(const v2u*)(og + (size_t)t * PA + (0 * 4 + s) * 64 + d0), x1 = *(const v2u*)(og + (size_t)t * PA + (1 * 4 + s) * 64 + d0), x2 = *(const v2u*)(og + (size_t)t * PA + (2 * 4 + s) * 64 + d0);
        const float w0 = a0 * inv, w1 = a1 * inv, w2 = a2 * inv;
        v2u o; o.x = pk2(w0 * bflo(x0.x) + w1 * bflo(x1.x) + w2 * bflo(x2.x), w0 * bfhi(x0.x) + w1 * bfhi(x1.x) + w2 * bfhi(x2.x));
        o.y = pk2(w0 * bflo(x0.y) + w1 * bflo(x1.y) + w2 * bflo(x2.y), w0 * bfhi(x0.y) + w1 * bfhi(x1.y) + w2 * bfhi(x2.y));
        *(v2u*)(oa + (size_t)t * POA + s * 64 + d0) = o;
    }
}

DI void store8_bf16(bf16* dst, const float (&v)[8]) { v4u o; o.x = pk2(v[0], v[1]); o.y = pk2(v[2], v[3]); o.z = pk2(v[4], v[5]); o.w = pk2(v[6], v[7]); *(v4u*)dst = o; }
DI void rope4(float (&v)[8], const f32x2* tab, int pos, int i0) {
#pragma unroll
    for (int j = 0; j < 4; ++j) { const f32x2 cs = tab[pos * 16 + i0 + j]; const float t1 = v[2 * j], t2 = v[2 * j + 1]; v[2 * j] = t1 * cs.x - t2 * cs.y; v[2 * j + 1] = t1 * cs.y + t2 * cs.x; }
}
struct EpiProj {
    bf16 *qkva, *qkvb, *clat, *g; const f32x2* rope;
    DI void s8(int row, int col, float (&v)[8]) const {
        if (col < 2304) { if (col < 768) {
#pragma unroll
                for (int i = 0; i < 8; ++i) v[i] *= C2A; }
            store8_bf16(qkva + (size_t)row * PA + col, v); }
        else if (col < 3840) { const int c = col - 2304; if (c < 512) {
#pragma unroll
                for (int i = 0; i < 8; ++i) v[i] *= C2A; }
            store8_bf16(qkvb + (size_t)row * PB + c, v); }
        else if (col < 4352) { const int c = col - 3840; if (c >= KR_COL && c < KR_COL + 32) rope4(v, rope, row & (SEQ - 1), (c - KR_COL) >> 1);
            store8_bf16(clat + (size_t)row * PCL + c, v); }
        else { const int c = col - 4352;
#pragma unroll
            for (int i = 0; i < 8; ++i) v[i] = sigmoidf_(v[i]);
            store8_bf16(g + (size_t)row * PG + c, v); }
    }
};
struct EpiQc {
    bf16* qc; const float* ssq; const f32x2* rope;
    DI void s8(int row, int col, float (&v)[8]) const {
        if (col >= 576) return;
        const f32x4 pp = *(const f32x4*)(ssq + (size_t)row * 4); const float rs = rsqrtf(((pp.x + pp.y) + (pp.z + pp.w)) * (1.0f / 256.0f) + RMS_EPS);
#pragma unroll
        for (int i = 0; i < 8; ++i) v[i] *= rs;
        const int j = col % 96; if (j >= 64) rope4(v, rope, row & (SEQ - 1), (j - 64) >> 1);
#pragma unroll
        for (int i = 0; i < 8; ++i) v[i] *= C2C;
        store8_bf16(qc + (size_t)row * PQC + col, v);
    }
};
struct EpiKv {
    bf16* kvc; const float* ssq;
    DI void s8(int row, int col, float (&v)[8]) const {
        const f32x4 pp = *(const f32x4*)(ssq + (size_t)row * 4); const float rs = rsqrtf(((pp.x + pp.y) + (pp.z + pp.w)) * (1.0f / 128.0f) + RMS_EPS);
#pragma unroll
        for (int i = 0; i < 8; ++i) v[i] *= rs;
        store8_bf16(kvc + (size_t)row * PKV + col, v);
    }
};
struct EpiMerge {
    bf16* merged; const bf16* gate; bool first;
    DI void s8(int row, int col, float (&v)[8]) const {
        const v4u gw = *(const v4u*)(gate + (size_t)row * PG + col);
        float r[8] = {v[0] * bflo(gw.x), v[1] * bfhi(gw.x), v[2] * bflo(gw.y), v[3] * bfhi(gw.y), v[4] * bflo(gw.z), v[5] * bfhi(gw.z), v[6] * bflo(gw.w), v[7] * bfhi(gw.w)};
        bf16* dst = merged + (size_t)row * DM + col;
        if (!first) { const v4u o = *(const v4u*)dst; r[0] += bflo(o.x); r[1] += bfhi(o.x); r[2] += bflo(o.y); r[3] += bfhi(o.y); r[4] += bflo(o.z); r[5] += bfhi(o.z); r[6] += bflo(o.w); r[7] += bfhi(o.w); }
        store8_bf16(dst, r);
    }
};
struct EpiResid {
    const float* xin; float* xout;
    DI void s4(int row, int col, f32x4 v) const { const f32x4 b = *(const f32x4*)(xin + (size_t)row * DM + col); *(f32x4*)(xout + (size_t)row * DM + col) = b + v; }
};
struct EpiGateUp {
    bf16* act; const float* wl; int slot0;
    DI void s8(int row, int col, float (&v)[8]) const {
        const float w = wl[row];
        float a[4];
#pragma unroll
        for (int i = 0; i < 4; ++i) a[i] = v[i] / (1.0f + __expf(-v[i])) * v[4 + i] * w;
        v2u o; o.x = pk2(a[0], a[1]); o.y = pk2(a[2], a[3]);
        *(v2u*)(act + (size_t)(slot0 + row) * DEXP + (col >> 1)) = o;
    }
};
struct EpiDown {
    bf16* y; const int* list; int cnt;
    DI void s8(int row, int col, float (&v)[8]) const { if (row >= cnt) return; store8_bf16(y + (size_t)list[row] * DM + col, v); }
};
template <class ARow, class Epi, bool F32OUT>
DI void ngemm_tile(const ARow& arow, const bf16* __restrict__ Bt, int K, int m0, int n0, const Epi& epi, float* As, float* Bs) {
    const int tid = threadIdx.x, ty = tid >> 4, tx = tid & 15;
    float acc[4][8];
#pragma unroll
    for (int i = 0; i < 4; ++i)
#pragma unroll
        for (int j = 0; j < 8; ++j) acc[i][j] = 0.f;
    const int ar = tid >> 2, akq = (tid & 3) * 4, bn = tid >> 1, bkq = (tid & 1) * 8;
    const bf16* ap = arow(m0 + ar);
    const bf16* bp = Bt + (size_t)(n0 + bn) * K;
    for (int kt = 0; kt < K; kt += 16) {
        v2u a = {0u, 0u}; if (ap) a = *(const v2u*)(ap + kt + akq);
        const v4u b = *(const v4u*)(bp + kt + bkq);
        As[(akq + 0) * 68 + ar] = bflo(a.x); As[(akq + 1) * 68 + ar] = bfhi(a.x); As[(akq + 2) * 68 + ar] = bflo(a.y); As[(akq + 3) * 68 + ar] = bfhi(a.y);
        Bs[(bkq + 0) * 132 + bn] = bflo(b.x); Bs[(bkq + 1) * 132 + bn] = bfhi(b.x); Bs[(bkq + 2) * 132 + bn] = bflo(b.y); Bs[(bkq + 3) * 132 + bn] = bfhi(b.y);
        Bs[(bkq + 4) * 132 + bn] = bflo(b.z); Bs[(bkq + 5) * 132 + bn] = bfhi(b.z); Bs[(bkq + 6) * 132 + bn] = bflo(b.w); Bs[(bkq + 7) * 132 + bn] = bfhi(b.w);
        __syncthreads();
#pragma unroll
        for (int k = 0; k < 16; ++k) {
            float av[4], bv[8];
#pragma unroll
            for (int i = 0; i < 4; ++i) av[i] = As[k * 68 + ty * 4 + i];
#pragma unroll
            for (int j = 0; j < 8; ++j) bv[j] = Bs[k * 132 + tx * 8 + j];
#pragma unroll
            for (int i = 0; i < 4; ++i)
#pragma unroll
                for (int j = 0; j < 8; ++j) acc[i][j] += av[i] * bv[j];
        }
        __syncthreads();
    }
#pragma unroll
    for (int i = 0; i < 4; ++i) { const int row = m0 + ty * 4 + i;
        if constexpr (F32OUT) { epi.s4(row, n0 + tx * 8, (f32x4){acc[i][0], acc[i][1], acc[i][2], acc[i][3]}); epi.s4(row, n0 + tx * 8 + 4, (f32x4){acc[i][4], acc[i][5], acc[i][6], acc[i][7]}); }
        else epi.s8(row, n0 + tx * 8, acc[i]); }
}
struct ARowPlain { const bf16* A; int lda; DI const bf16* operator()(int r) const { return A + (size_t)r * lda; } };
struct ARowGather { const bf16* H; const int* list; int cnt; DI const bf16* operator()(int r) const { return r < cnt ? H + (size_t)(list[r] >> 1) * DM : nullptr; } };
struct ARowAct { const bf16* act; int slot0; int cnt; DI const bf16* operator()(int r) const { return r < cnt ? act + (size_t)(slot0 + r) * DEXP : nullptr; } };

DI int slot_base(const unsigned* cnt, int e) { int b = 0; for (int i = 0; i < e; ++i) b += (int)((cnt[i] + 255u) & ~255u); return b; }

template <int WHICH>
__global__ void __launch_bounds__(256) k_ngemm(Params p, int l) {
    __shared__ float As[16 * 68]; __shared__ float Bs[16 * 132];
    unsigned char* ws = p.ws; const int m0 = blockIdx.x * 64, n0 = blockIdx.y * 128;
    const f32x2* rope = (const f32x2*)(ws + WS_ROPE);
    if constexpr (WHICH == 0) { EpiProj E{(bf16*)(ws + WS_QKVA), (bf16*)(ws + WS_QKVB), (bf16*)(ws + WS_CLAT), (bf16*)(ws + WS_G), rope};
        ngemm_tile<ARowPlain, EpiProj, false>(ARowPlain{(const bf16*)(ws + WS_U), DM}, (const bf16*)(ws + WM_IN), DM, m0, n0, E, As, Bs); }
    if constexpr (WHICH == 1) { EpiQc E{(bf16*)(ws + WS_QC), (const float*)(ws + WS_SSQQ), rope};
        ngemm_tile<ARowPlain, EpiQc, false>(ARowPlain{(const bf16*)(ws + WS_CLAT), PCL}, (const bf16*)(ws + WM_UQ), 256, m0, n0, E, As, Bs); }
    if constexpr (WHICH == 2) { EpiKv E{(bf16*)(ws + WS_KVC), (const float*)(ws + WS_SSQKV)};
        ngemm_tile<ARowPlain, EpiKv, false>(ARowPlain{(const bf16*)(ws + WS_CLAT) + 256, PCL}, (const bf16*)(ws + WM_UKV), 256, m0, n0, E, As, Bs); }
    if constexpr (WHICH == 3) { EpiMerge E{(bf16*)(ws + WS_MERGED), (const bf16*)(ws + WS_G), true};
        ngemm_tile<ARowPlain, EpiMerge, false>(ARowPlain{(const bf16*)(ws + WS_OA), POA}, (const bf16*)(ws + WM_PA), 256, m0, n0, E, As, Bs); }
    if constexpr (WHICH == 4) { EpiMerge E{(bf16*)(ws + WS_MERGED), (const bf16*)(ws + WS_G) + 1024, false};
        ngemm_tile<ARowPlain, EpiMerge, false>(ARowPlain{(const bf16*)(ws + WS_QKVB), PB}, (const bf16*)(ws + WM_PB), 512, m0, n0, E, As, Bs); }
    if constexpr (WHICH == 5) { EpiMerge E{(bf16*)(ws + WS_MERGED), (const bf16*)(ws + WS_G) + 2048, false};
        ngemm_tile<ARowPlain, EpiMerge, false>(ARowPlain{(const bf16*)(ws + WS_OC), POC}, (const bf16*)(ws + WM_PC), 384, m0, n0, E, As, Bs); }
    if constexpr (WHICH == 6) { EpiResid E{l == 0 ? p.in[0] : p.out, p.out};
        ngemm_tile<ARowPlain, EpiResid, true>(ARowPlain{(const bf16*)(ws + WS_MERGED), DM}, (const bf16*)(ws + WM_O), DM, m0, n0, E, As, Bs); }
    if constexpr (WHICH == 7 || WHICH == 8) {
        const int e = blockIdx.z; const unsigned* cnt = (const unsigned*)(ws + WS_CTL) + CW_CNT + l * 64; const int c = (int)cnt[e];
        if (m0 >= c) return;
        const int sb = slot_base(cnt, e); const int* list = (const int*)(ws + WS_LIST) + e * M;
        if constexpr (WHICH == 7) { EpiGateUp E{(bf16*)(ws + WS_ACT), (const float*)(ws + WS_WLIST) + e * M, sb};
            ngemm_tile<ARowGather, EpiGateUp, false>(ARowGather{(const bf16*)(ws + WS_U), list, c}, (const bf16*)(ws + WS_WGU) + (size_t)e * 1024 * 1024, DM, m0, n0, E, As, Bs); }
        else { EpiDown E{(bf16*)(ws + WS_Y), list, c};
            ngemm_tile<ARowAct, EpiDown, false>(ARowAct{(const bf16*)(ws + WS_ACT), sb, c}, (const bf16*)(ws + WS_WD) + (size_t)e * 1024 * 512, DEXP, m0, n0, E, As, Bs); }
    }
}
__global__ void __launch_bounds__(256) k_nssq(Params p) {
    const int gw = blockIdx.x * 4 + (threadIdx.x >> 6), lane = threadIdx.x & 63; if (gw >= M) return;
    const bf16* r = (const bf16*)(p.ws + WS_CLAT) + (size_t)gw * PCL;
    float a = 0.f, b = 0.f;
    for (int c = lane; c < 256; c += 64) { const float v = bf2f(r[c]); a += v * v; }
    for (int c = lane; c < 128; c += 64) { const float v = bf2f(r[256 + c]); b += v * v; }
    a = wave_sum(a); b = wave_sum(b);
    if (lane == 0) { *(f32x4*)((float*)(p.ws + WS_SSQQ) + (size_t)gw * 4) = (f32x4){a, 0.f, 0.f, 0.f}; *(f32x4*)((float*)(p.ws + WS_SSQKV) + (size_t)gw * 4) = (f32x4){b, 0.f, 0.f, 0.f}; }
}
struct NAJob { const bf16* q; const bf16* k; int kstride; const bf16* k2; int k2stride; const bf16* v; int vstride; int dk1, dk2, dv, nkeys, dil; float bias2; };
DI void naive_attend(const NAJob& J, float* sq, float* ss, int lane, float& o0, float& o1, float& lse2) {
    for (int d = lane; d < J.dk1 + J.dk2; d += 64) sq[d] = bf2f(J.q[d]);
    LDS_WAIT(); asm volatile("" ::: "memory");
    float mx = -1e30f;
    for (int j = lane; j < J.nkeys; j += 64) {
        const bf16* kr = J.k - (ptrdiff_t)j * J.dil * J.kstride; float s = 0.f;
        for (int c = 0; c < J.dk1; c += 8) { const v4u w = *(const v4u*)(kr + c); s += sq[c] * bflo(w.x) + sq[c + 1] * bfhi(w.x) + sq[c + 2] * bflo(w.y) + sq[c + 3] * bfhi(w.y) + sq[c + 4] * bflo(w.z) + sq[c + 5] * bfhi(w.z) + sq[c + 6] * bflo(w.w) + sq[c + 7] * bfhi(w.w); }
        if (J.dk2) { const bf16* k2 = J.k2 - (ptrdiff_t)j * J.dil * J.k2stride; for (int c = 0; c < J.dk2; c += 8) { const v4u w = *(const v4u*)(k2 + c); const float* q2 = sq + J.dk1 + c; s += q2[0] * bflo(w.x) + q2[1] * bfhi(w.x) + q2[2] * bflo(w.y) + q2[3] * bfhi(w.y) + q2[4] * bflo(w.z) + q2[5] * bfhi(w.z) + q2[6] * bflo(w.w) + q2[7] * bfhi(w.w); } }
        s += J.bias2 * (float)j; ss[j] = s; mx = fmaxf(mx, s);
    }
    mx = wave_max(mx); float l = 0.f;
    for (int j = lane; j < J.nkeys; j += 64) { const float pv = exp2f(ss[j] - mx); ss[j] = pv; l += pv; }
    l = wave_sum(l);
    LDS_WAIT(); asm volatile("" ::: "memory");
    float a0 = 0.f, a1 = 0.f;
    for (int j = 0; j < J.nkeys; ++j) { const bf16* vr = J.v - (ptrdiff_t)j * J.dil * J.vstride; const float pj = ss[j]; a0 += pj * bf2f(vr[lane]); if (J.dv > 64) a1 += pj * bf2f(vr[64 + lane]); }
    LDS_WAIT(); asm volatile("" ::: "memory");
    o0 = a0 / l; o1 = a1 / l; lse2 = mx + log2f(l);
}
template <int KIND>
__global__ void __launch_bounds__(256) k_nattn(Params p, int l) {
    __shared__ float sqs[4][96]; __shared__ float sss[4][2048];
    const int w = threadIdx.x >> 6, lane = threadIdx.x & 63; float* sq = sqs[w]; float* ss = sss[w];
    unsigned char* ws = p.ws; const int idx = blockIdx.x * 4 + w;
    if constexpr (KIND == 0) {
        const int t = idx / 12, hh = idx % 12, g = hh >> 2, s = hh & 3, tp = t & (SEQ - 1), dil = g == 0 ? 1 : (g == 1 ? 4 : 16);
        bf16* base = (bf16*)(ws + WS_QKVA) + (size_t)t * PA + hh * 64; int nk = tp / dil + 1; if (nk > 129) nk = 129;
        NAJob J{base, base + 768, PA, nullptr, 0, base + 1536, PA, 64, 0, 64, nk, dil, -alibi_a(hh) * LOG2E * (float)dil};
        float o0, o1, lse; naive_attend(J, sq, ss, lane, o0, o1, lse);
        base[lane] = (bf16)f2bf(o0); if (lane == 0) ((float*)(ws + WS_LSE))[((size_t)g * M + t) * 4 + s] = lse;
    }
    if constexpr (KIND == 1) {
        const int t = idx >> 2, h = idx & 3, tp = t & (SEQ - 1);
        bf16* row = (bf16*)(ws + WS_QKVB) + (size_t)t * PB; float oa[2][2];
        for (int mp = 0; mp < 2; ++mp) { NAJob J{row + (2 * h + mp) * 64, row + 512 + (2 * h + mp) * 64, PB, nullptr, 0, row + 1024 + h * 128, PB, 64, 0, 128, tp + 1, 1, -alibi_b(h) * LOG2E};
            float lse; naive_attend(J, sq, ss, lane, oa[mp][0], oa[mp][1], lse); }
        const float lam = lam_of(p, l, lane); const float d0 = oa[0][0] - lam * oa[1][0], d1 = oa[0][1] - lam * oa[1][1];
        const float rs = rsqrtf(wave_sum(d0 * d0 + d1 * d1) * (1.0f / 128.0f) + RMS_EPS) * (1.0f - lam_init_of(l));
        const float* gs = p.in[15] + l * 128;
        row[h * 128 + lane] = (bf16)f2bf(d0 * rs * gs[lane]); row[h * 128 + 64 + lane] = (bf16)f2bf(d1 * rs * gs[64 + lane]);
    }
    if constexpr (KIND == 2) {
        const int t = idx / 6, h = idx % 6, tp = t & (SEQ - 1);
        const bf16* kv = (const bf16*)(ws + WS_KVC) + (size_t)t * PKV + h * 128;
        NAJob J{(const bf16*)(ws + WS_QC) + (size_t)t * PQC + h * 96, kv, PKV, (const bf16*)(ws + WS_CLAT) + (size_t)t * PCL + KR_COL, PCL, kv + 64, PKV, 64, 32, 64, tp + 1, 1, 0.f};
        float o0, o1, lse; naive_attend(J, sq, ss, lane, o0, o1, lse);
        ((bf16*)(ws + WS_OC))[(size_t)t * POC + h * 64 + lane] = (bf16)f2bf(o0);
    }
}
template <int WHICH>
__global__ void __launch_bounds__(256) k_thin(Params p, int l) {
    __shared__ float scr[4 * 64 * 33];
    const int wave = threadIdx.x >> 6, lane = threadIdx.x & 63, gw = blockIdx.x * 4 + wave, NGW = gridDim.x * 4;
    LAS float* s = (LAS float*)scr + wave * 64 * 33;
    if constexpr (WHICH == 0) { ph_cvt_mixer(p, l, gw, NGW, lane, s); if (l == 0) { ph_rope_table(p, gw, NGW, lane); ph_rmsnorm(p.in[0], p.in[2], (bf16*)(p.ws + WS_U), gw, NGW, lane); } }
    if constexpr (WHICH == 1) ph_amerge(p, gw, NGW, lane);
    if constexpr (WHICH == 2) { ph_router(p, l, gw, NGW, lane); ph_cvt_experts(p, l, gw, NGW, lane, s); }
    if constexpr (WHICH == 3) ph_combine(p, l, gw, NGW, lane);
}

#ifdef ORACLE_BUILD
extern "C" void kernel_launch(void* const* d_in, const int* in_sizes, int n_in, void* d_out, int out_size, void* d_ws, size_t ws_size, hipStream_t stream) {
    if (n_in != 23 || ws_size < WS_END || out_size != M * DM) { fprintf(stderr, "kernel_launch: unexpected sizes\n"); return; }
    Params p{}; for (int i = 0; i < 23; ++i) p.in[i] = (const float*)d_in[i]; p.out = (float*)d_out; p.ws = (unsigned char*)d_ws;
    hipMemsetAsync((char*)d_ws + WS_CTL, 0, CTL_BYTES, stream);
    for (int l = 0; l < DEPTH; ++l) {
        if (l == 0) k_thin<0><<<1024, 256, 0, stream>>>(p, 0);
        k_ngemm<0><<<dim3(M / 64, NPROJ / 128), 256, 0, stream>>>(p, l);
        k_nssq<<<M / 4, 256, 0, stream>>>(p);
        k_ngemm<1><<<dim3(M / 64, 768 / 128), 256, 0, stream>>>(p, l);
        k_ngemm<2><<<dim3(M / 64, 768 / 128), 256, 0, stream>>>(p, l);
        k_nattn<0><<<M * 12 / 4, 256, 0, stream>>>(p, l);
        k_nattn<1><<<M * 4 / 4, 256, 0, stream>>>(p, l);
        k_nattn<2><<<M * 6 / 4, 256, 0, stream>>>(p, l);
        k_thin<1><<<1024, 256, 0, stream>>>(p, l);
        k_ngemm<3><<<dim3(M / 64, DM / 128), 256, 0, stream>>>(p, l);
        k_ngemm<4><<<dim3(M / 64, DM / 128), 256, 0, stream>>>(p, l);
        k_ngemm<5><<<dim3(M / 64, DM / 128), 256, 0, stream>>>(p, l);
        k_ngemm<6><<<dim3(M / 64, DM / 128), 256, 0, stream>>>(p, l);
        k_thin<2><<<1024, 256, 0, stream>>>(p, l);
        k_ngemm<7><<<dim3(M / 64, 1024 / 128, NEXP), 256, 0, stream>>>(p, l);
        k_ngemm<8><<<dim3(M / 64, 1024 / 128, NEXP), 256, 0, stream>>>(p, l);
        k_thin<3><<<1024, 256, 0, stream>>>(p, l);
        if (l + 1 < DEPTH) k_thin<0><<<1024, 256, 0, stream>>>(p, l + 1);
    }
}
#endif
```

```cpp
#include <hip/hip_runtime.h>
#include <cstdio>
#include <cstdint>
#include <cmath>

#define GAS __attribute__((address_space(1)))
#define LAS __attribute__((address_space(3)))
#define DI __device__ __forceinline__
typedef unsigned short bf16;
typedef unsigned v4u __attribute__((ext_vector_type(4)));
typedef unsigned v2u __attribute__((ext_vector_type(2)));
typedef float f32x4 __attribute__((ext_vector_type(4)));
typedef float f32x2 __attribute__((ext_vector_type(2)));
typedef float f32x16 __attribute__((ext_vector_type(16)));
typedef short bf16x8 __attribute__((ext_vector_type(8)));
typedef short s16x4 __attribute__((ext_vector_type(4)));

constexpr int NB = 8, SEQ = 2048, DM = 1024, M = NB * SEQ, DEPTH = 2;
constexpr int IN_COLS = 7328, NPROJ = 7424;
constexpr int NEXP = 16, DEXP = 512;
constexpr float RMS_EPS = 1e-6f;
constexpr float LOG2E = 1.4426950408889634f;
constexpr float C2A = 0.125f * LOG2E;
constexpr float C2C = 0.10206207261596577f * LOG2E;
constexpr int PA = 2304, PB = 1536, PCL = 512, PG = 3072, PQC = 576, PKV = 768, POC = 384, POA = 256;
constexpr int KR_COL = 384;

constexpr size_t MiB = 1u << 20;
constexpr size_t WS_CTL = 0, CTL_BYTES = 1 * MiB;
constexpr size_t WS_LIST = 1 * MiB;
constexpr size_t WS_WLIST = 2 * MiB;
constexpr size_t WS_SSQQ = 3 * MiB;
constexpr size_t WS_SSQKV = 3 * MiB + 256 * 1024;
constexpr size_t WS_LSE = 3 * MiB + 512 * 1024;
constexpr size_t WS_ROPE = 5 * MiB;
constexpr size_t WS_WMIX = 8 * MiB;
constexpr size_t WM_IN = WS_WMIX;
constexpr size_t WM_O = WM_IN + (size_t)NPROJ * DM * 2;
constexpr size_t WM_PA = WM_O + (size_t)DM * DM * 2;
constexpr size_t WM_PB = WM_PA + (size_t)DM * 256 * 2;
constexpr size_t WM_PC = WM_PB + (size_t)DM * 512 * 2;
constexpr size_t WM_UQ = WM_PC + (size_t)DM * 384 * 2;
constexpr size_t WM_UKV = WM_UQ + (size_t)768 * 256 * 2;
constexpr size_t WM_END = WM_UKV + (size_t)768 * 256 * 2;
static_assert(WM_END <= 28 * MiB, "mixer weights");
constexpr size_t WS_U = 28 * MiB;
constexpr size_t WS_KVC = WS_U;
constexpr size_t WS_OA = WS_U + 24 * MiB;
constexpr size_t WS_QKVA = 60 * MiB;
constexpr size_t WS_QKVB = 132 * MiB;
constexpr size_t WS_CLAT = 180 * MiB;
constexpr size_t WS_G = 196 * MiB;
constexpr size_t WS_QC = 292 * MiB;
constexpr size_t WS_OC = 310 * MiB;
constexpr size_t WS_END = 322 * MiB;
constexpr size_t WS_MERGED = WS_QKVA;
constexpr size_t WS_WGU = 60 * MiB;
constexpr size_t WS_WD = 92 * MiB;
constexpr size_t WS_ACT = 108 * MiB;
constexpr size_t WS_Y = 144 * MiB;
constexpr int ACT_ROWS = 2 * M + NEXP * 256;
static_assert(WS_ACT + (size_t)ACT_ROWS * DEXP * 2 <= WS_Y && WS_Y + (size_t)2 * M * DM * 2 <= WS_END, "moe map");
constexpr int CW_TMO = 0;
constexpr int CW_CNT = 64;
constexpr int CW_ERR = 256;
constexpr int CW_BAR = 4096;

struct Params {
    const float* in[23]; float* out; unsigned char* ws;
};

DI unsigned f2bf(float f) { unsigned u = __builtin_bit_cast(unsigned, f); return (u + 0x7fffu + ((u >> 16) & 1u)) >> 16; }
DI unsigned pk2(float lo, float hi) { return f2bf(lo) | (f2bf(hi) << 16); }
DI float bf2f(unsigned short b) { return __builtin_bit_cast(float, (unsigned)b << 16); }
DI float bflo(unsigned w) { return __builtin_bit_cast(float, w << 16); }
DI float bfhi(unsigned w) { return __builtin_bit_cast(float, w & 0xffff0000u); }
DI float wave_sum(float v) {
#pragma unroll
    for (int o = 1; o < 64; o <<= 1) v += __shfl_xor(v, o);
    return v;
}
DI float wave_max(float v) {
#pragma unroll
    for (int o = 1; o < 64; o <<= 1) v = fmaxf(v, __shfl_xor(v, o));
    return v;
}
DI float sigmoidf_(float x) { return 1.0f / (1.0f + __expf(-x)); }
DI float alibi_a(int h) { return exp2f(-8.0f * (float)(h + 1) / 12.0f); }
DI float alibi_b(int h) { return exp2f(-2.0f * (float)(h + 1)); }
DI float lam_init_of(int l) { return 0.8f - 0.6f * expf(-0.3f * (float)l); }
DI float lam_of(const Params& p, int l, int lane) {
    const float a = p.in[11][l * 64 + lane] * p.in[12][l * 64 + lane], b = p.in[13][l * 64 + lane] * p.in[14][l * 64 + lane];
    return expf(wave_sum(a)) - expf(wave_sum(b)) + lam_init_of(l);
}
#define LDS_WAIT() asm volatile("s_waitcnt lgkmcnt(0)" ::: "memory")

struct MapIdent { int off; DI int operator()(int n) const { return n + off; } };
struct MapWin { DI int operator()(int n) const { if (n < 4224) return n; if (n < 4256) { const int i = n - 4224; return 4224 + (i < 16 ? 2 * i : 2 * (i - 16) + 1); } return n + 96; } };
struct MapUq { DI int operator()(int n) const { const int h = n / 96, j = n % 96; if (j < 64) return n; const int i = j - 64; return h * 96 + 64 + (i < 16 ? 2 * i : 2 * (i - 16) + 1); } };
struct MapGate { DI int operator()(int n) const { return 8 * (n >> 2) + (n & 3); } };
struct MapUp { DI int operator()(int n) const { return 8 * (n >> 2) + 4 + (n & 3); } };

template <class Map>
DI void cvt_item(const float* __restrict__ W, int N, bf16* WT, int Kd, const float* gk, const Map& map, LAS float* scr, int item, int lane) {
    const int nblk = N / 32, kb = item / nblk, nb = item % nblk, k0 = 64 * kb, n0 = 32 * nb;
#pragma unroll 8
    for (int i = 0; i < 32; ++i) { const int kk = 2 * i + (lane >> 5); float v = W[(size_t)(k0 + kk) * N + n0 + (lane & 31)]; if (gk) v *= gk[k0 + kk]; scr[kk * 33 + (lane & 31)] = v; }
    LDS_WAIT(); asm volatile("" ::: "memory");
    const int c = lane & 7;
#pragma unroll
    for (int j = 0; j < 4; ++j) { const int n = (lane >> 3) + 8 * j; const LAS float* s = scr + (8 * c) * 33 + n;
        v4u o; o.x = pk2(s[0 * 33], s[1 * 33]); o.y = pk2(s[2 * 33], s[3 * 33]); o.z = pk2(s[4 * 33], s[5 * 33]); o.w = pk2(s[6 * 33], s[7 * 33]);
        const int dr = map(n0 + n);
        *(v4u*)(WT + (size_t)dr * Kd + k0 + 8 * c) = o; }
    LDS_WAIT(); asm volatile("" ::: "memory");
}

DI void ph_cvt_mixer(const Params& p, int l, int gw, int NGW, int lane, LAS float* scr) {
    unsigned char* ws = p.ws;
    constexpr int I_IN = 16 * (IN_COLS / 32), I_O = 16 * 32, I_PA = 4 * 32, I_PB = 8 * 32, I_PC = 6 * 32, I_UQ = 4 * 18, I_UKV = 2 * 24;
    constexpr int NIT = I_IN + I_O + I_PA + I_PB + I_PC + I_UQ + I_UKV;
    for (int it = gw; it < NIT; it += NGW) {
        int r = it;
        if (r < I_IN) { cvt_item(p.in[1] + (size_t)l * DM * IN_COLS, IN_COLS, (bf16*)(ws + WM_IN), DM, nullptr, MapWin{}, scr, r, lane); continue; } r -= I_IN;
        if (r < I_O) { cvt_item(p.in[6] + (size_t)l * DM * DM, DM, (bf16*)(ws + WM_O), DM, nullptr, MapIdent{0}, scr, r, lane); continue; } r -= I_O;
        if (r < I_PA) { cvt_item(p.in[3] + (size_t)l * 256 * DM, DM, (bf16*)(ws + WM_PA), 256, nullptr, MapIdent{0}, scr, r, lane); continue; } r -= I_PA;
        if (r < I_PB) { cvt_item(p.in[4] + (size_t)l * 512 * DM, DM, (bf16*)(ws + WM_PB), 512, nullptr, MapIdent{0}, scr, r, lane); continue; } r -= I_PB;
        if (r < I_PC) { cvt_item(p.in[5] + (size_t)l * 384 * DM, DM, (bf16*)(ws + WM_PC), 384, nullptr, MapIdent{0}, scr, r, lane); continue; } r -= I_PC;
        if (r < I_UQ) { cvt_item(p.in[8] + (size_t)l * 256 * 576, 576, (bf16*)(ws + WM_UQ), 256, p.in[7] + l * 256, MapUq{}, scr, r, lane); continue; } r -= I_UQ;
        cvt_item(p.in[10] + (size_t)l * 128 * 768, 768, (bf16*)(ws + WM_UKV), 256, p.in[9] + l * 128, MapIdent{0}, scr, r, lane);
    }
    const v4u z = {0u, 0u, 0u, 0u};
    const int gt = gw * 64 + lane, NT = NGW * 64;
    for (int c = gt; c < 96 * 128; c += NT) *(v4u*)((bf16*)(ws + WM_IN) + (size_t)4256 * DM + (size_t)c * 8) = z;
    for (int c = gt; c < 192 * 32; c += NT) *(v4u*)((bf16*)(ws + WM_UQ) + (size_t)576 * 256 + (size_t)c * 8) = z;
    for (int c = gt; c < 768 * 16; c += NT) *(v4u*)((bf16*)(ws + WM_UKV) + (size_t)(c >> 4) * 256 + 128 + (c & 15) * 8) = z;
}
DI void ph_cvt_experts(const Params& p, int l, int gw, int NGW, int lane, LAS float* scr) {
    unsigned char* ws = p.ws;
    constexpr int IG = 16 * 16, IDN = 8 * 32, PER = 2 * IG + IDN;
    for (int it = gw; it < NEXP * PER; it += NGW) {
        const int e = it / PER; int r = it % PER;
        const size_t eo = ((size_t)l * NEXP + e) * DM * DEXP;
        if (r < IG) { cvt_item(p.in[19] + eo, DEXP, (bf16*)(ws + WS_WGU) + (size_t)e * 1024 * 1024, DM, nullptr, MapGate{}, scr, r, lane); continue; } r -= IG;
        if (r < IG) { cvt_item(p.in[20] + eo, DEXP, (bf16*)(ws + WS_WGU) + (size_t)e * 1024 * 1024, DM, nullptr, MapUp{}, scr, r, lane); continue; } r -= IG;
        cvt_item(p.in[21] + eo, DM, (bf16*)(ws + WS_WD) + (size_t)e * 1024 * 512, DEXP, nullptr, MapIdent{0}, scr, r, lane);
    }
}
DI void ph_rope_table(const Params& p, int gw, int NGW, int lane) {
    f32x2* tab = (f32x2*)(p.ws + WS_ROPE);
    for (int idx = gw * 64 + lane; idx < SEQ * 16; idx += NGW * 64) {
        const int pos = idx >> 4, i = idx & 15;
        double inv = 1.0; for (int j = 0; j < i; ++j) inv *= 0.56234132519034908;
        const double rev = (double)pos * inv * 0.15915494309189535;
        double fr = rev - floor(rev); if (fr >= 0.5) fr -= 1.0;
        const float f = (float)fr;
        tab[idx] = (f32x2){__builtin_amdgcn_cosf(f), __builtin_amdgcn_sinf(f)};
    }
}
DI void load_row(const float* xr, int lane, f32x4 (&v)[4]) {
#pragma unroll
    for (int j = 0; j < 4; ++j) v[j] = ((const f32x4*)xr)[lane + 64 * j];
}
DI float row_ss(const f32x4 (&v)[4]) {
    float s = 0.f;
#pragma unroll
    for (int j = 0; j < 4; ++j) s += (v[j].x * v[j].x + v[j].y * v[j].y) + (v[j].z * v[j].z + v[j].w * v[j].w);
    return wave_sum(s);
}
DI void store_row_bf16(bf16* orow, int lane, const f32x4 (&v)[4], float rs, const float* g) {
#pragma unroll
    for (int j = 0; j < 4; ++j) { const f32x4 gg = ((const f32x4*)g)[lane + 64 * j];
        v2u o; o.x = pk2(v[j].x * rs * gg.x, v[j].y * rs * gg.y); o.y = pk2(v[j].z * rs * gg.z, v[j].w * rs * gg.w);
        ((v2u*)orow)[lane + 64 * j] = o; }
}
DI void ph_rmsnorm(const float* x, const float* g, bf16* out, int gw, int NGW, int lane) {
    for (int m = gw; m < M; m += NGW) { f32x4 v[4]; load_row(x + (size_t)m * DM, lane, v);
        const float rs = rsqrtf(row_ss(v) * (1.0f / DM) + RMS_EPS);
        store_row_bf16(out + (size_t)m * DM, lane, v, rs, g); }
}
DI void ph_router(const Params& p, int l, int gw, int NGW, int lane) {
    const float* x1 = p.out; const float* g = p.in[16] + l * DM; const float* wr = p.in[17]; const float* rb = p.in[18];
    bf16* h = (bf16*)(p.ws + WS_U); int* list = (int*)(p.ws + WS_LIST); float* wl = (float*)(p.ws + WS_WLIST);
    unsigned* cnt = (unsigned*)(p.ws + WS_CTL) + CW_CNT + l * 64;
    for (int m = gw; m < M; m += NGW) {
        f32x4 v[4]; load_row(x1 + (size_t)m * DM, lane, v);
        const float rs = rsqrtf(row_ss(v) * (1.0f / DM) + RMS_EPS);
        float lg[16];
#pragma unroll
        for (int e = 0; e < 16; ++e) lg[e] = 0.f;
#pragma unroll
        for (int j = 0; j < 4; ++j) { const f32x4 gg = ((const f32x4*)g)[lane + 64 * j];
            const float hv[4] = {v[j].x * rs * gg.x, v[j].y * rs * gg.y, v[j].z * rs * gg.z, v[j].w * rs * gg.w};
            v2u o; o.x = pk2(hv[0], hv[1]); o.y = pk2(hv[2], hv[3]); ((v2u*)(h + (size_t)m * DM))[lane + 64 * j] = o;
#pragma unroll
            for (int c = 0; c < 4; ++c) { const f32x4* wrow = (const f32x4*)(wr + (size_t)(4 * lane + 256 * j + c) * 16);
#pragma unroll
                for (int q = 0; q < 4; ++q) { const f32x4 w = wrow[q]; lg[4 * q] += hv[c] * w.x; lg[4 * q + 1] += hv[c] * w.y; lg[4 * q + 2] += hv[c] * w.z; lg[4 * q + 3] += hv[c] * w.w; } } }
        float sc[16], bs[16];
#pragma unroll
        for (int e = 0; e < 16; ++e) { const float t = wave_sum(lg[e]); sc[e] = 1.0f / (1.0f + expf(-t)); bs[e] = sc[e] + rb[e]; }
        int bg = 0; float bgs = -1e30f; int i1 = 0, i2 = 1;
#pragma unroll
        for (int gI = 0; gI < 4; ++gI) {
            int a = 0; float av = bs[4 * gI];
#pragma unroll
            for (int i = 1; i < 4; ++i) if (bs[4 * gI + i] > av) { av = bs[4 * gI + i]; a = i; }
            int b = -1; float bv = -1e30f;
#pragma unroll
            for (int i = 0; i < 4; ++i) if (i != a && bs[4 * gI + i] > bv) { bv = bs[4 * gI + i]; b = i; }
            const float gs = av + bv;
            if (gs > bgs) { bgs = gs; bg = gI; i1 = a; i2 = b; }
        }
        const int e1 = bg * 4 + i1, e2 = bg * 4 + i2;
        float s1 = 0.f, s2 = 0.f;
#pragma unroll
        for (int e = 0; e < 16; ++e) { if (e == e1) s1 = sc[e]; if (e == e2) s2 = sc[e]; }
        const float inv = 1.0f / (s1 + s2);
        if (lane == 0) {
            const unsigned p1 = atomicAdd(cnt + e1, 1u), p2 = atomicAdd(cnt + e2, 1u);
            list[e1 * M + p1] = m * 2; wl[e1 * M + p1] = s1 * inv;
            list[e2 * M + p2] = m * 2 + 1; wl[e2 * M + p2] = s2 * inv;
        }
    }
}
DI void ph_combine(const Params& p, int l, int gw, int NGW, int lane) {
    float* x1 = p.out; const bf16* Y = (const bf16*)(p.ws + WS_Y); bf16* u = (bf16*)(p.ws + WS_U);
    const bool last = (l == DEPTH - 1); const float* g = last ? p.in[22] : p.in[2] + (l + 1) * DM;
    for (int m = gw; m < M; m += NGW) {
        f32x4 v[4]; load_row(x1 + (size_t)m * DM, lane, v);
#pragma unroll
        for (int j = 0; j < 4; ++j) { const v2u a = ((const v2u*)(Y + (size_t)(2 * m) * DM))[lane + 64 * j], b = ((const v2u*)(Y + (size_t)(2 * m + 1) * DM))[lane + 64 * j];
            v[j].x += bflo(a.x) + bflo(b.x); v[j].y += bfhi(a.x) + bfhi(b.x); v[j].z += bflo(a.y) + bflo(b.y); v[j].w += bfhi(a.y) + bfhi(b.y); }
        const float rs = rsqrtf(row_ss(v) * (1.0f / DM) + RMS_EPS);
        if (last) {
#pragma unroll
            for (int j = 0; j < 4; ++j) { const f32x4 gg = ((const f32x4*)g)[lane + 64 * j]; ((f32x4*)(x1 + (size_t)m * DM))[lane + 64 * j] = v[j] * rs * gg; }
        } else {
#pragma unroll
            for (int j = 0; j < 4; ++j) ((f32x4*)(x1 + (size_t)m * DM))[lane + 64 * j] = v[j];
            store_row_bf16(u + (size_t)m * DM, lane, v, rs, g);
        }
    }
}
DI void ph_amerge(const Params& p, int gw, int NGW, int lane) {
    const bf16* og = (const bf16*)(p.ws + WS_QKVA); const float* lse = (const float*)(p.ws + WS_LSE); bf16* oa = (bf16*)(p.ws + WS_OA);
    const int s = lane >> 4, d0 = (lane & 15) * 4;
    for (int t = gw; t < M; t += NGW) {
        const float l0 = lse[((size_t)0 * M + t) * 4 + s], l1 = lse[((size_t)1 * M + t) * 4 + s], l2 = lse[((size_t)2 * M + t) * 4 + s];
        const float mx = fmaxf(l0, fmaxf(l1, l2)); const float a0 = exp2f(l0 - mx), a1 = exp2f(l1 - mx), a2 = exp2f(l2 - mx); const float inv = 1.0f / (a0 + a1 + a2);
        const v2u x0 = *(const v2u*)(og + (size_t)t * PA + (0 * 4 + s) * 64 + d0), x1 = *(const v2u*)(og + (size_t)t * PA + (1 * 4 + s) * 64 + d0), x2 = *(const v2u*)(og + (size_t)t * PA + (2 * 4 + s) * 64 + d0);
        const float w0 = a0 * inv, w1 = a1 * inv, w2 = a2 * inv;
        v2u o; o.x = pk2(w0 * bflo(x0.x) + w1 * bflo(x1.x) + w2 * bflo(x2.x), w0 * bfhi(x0.x) + w1 * bfhi(x1.x) + w2 * bfhi(x2.x));
        o.y = pk2(w0 * bflo(x0.y) + w1 * bflo(x1.y) + w2 * bflo(x2.y), w0 * bfhi(x0.y) + w1 * bfhi(x1.y) + w2 * bfhi(x2.y));
        *(v2u*)(oa + (size_t)t * POA + s * 64 + d0) = o;
    }
}

DI void store8_bf16(bf16* dst, const float (&v)[8]) { v4u o; o.x = pk2(v[0], v[1]); o.y = pk2(v[2], v[3]); o.z = pk2(v[4], v[5]); o.w = pk2(v[6], v[7]); *(v4u*)dst = o; }
DI void rope4(float (&v)[8], const f32x2* tab, int pos, int i0) {
#pragma unroll
    for (int j = 0; j < 4; ++j) { const f32x2 cs = tab[pos * 16 + i0 + j]; const float t1 = v[2 * j], t2 = v[2 * j + 1]; v[2 * j] = t1 * cs.x - t2 * cs.y; v[2 * j + 1] = t1 * cs.y + t2 * cs.x; }
}
struct EpiProj {
    bf16* dst; int pitch, coff, mode; const f32x2* rope;
    DI void s8(int row, int col, float (&v)[8]) const {
        const int c = col - coff;
        if (mode == 0) {
#pragma unroll
            for (int i = 0; i < 8; ++i) v[i] *= C2A; }
        else if (mode == 2) { if (c >= KR_COL && c < KR_COL + 32) rope4(v, rope, row & (SEQ - 1), (c - KR_COL) >> 1); }
        else if (mode == 3) {
#pragma unroll
            for (int i = 0; i < 8; ++i) v[i] = sigmoidf_(v[i]); }
        store8_bf16(dst + (size_t)row * pitch + c, v);
    }
};
struct ProjDst { bf16 *qkva, *qkvb, *clat, *g; const f32x2* rope;
    DI EpiProj of(int col0) const {
        if (col0 < 2304) return EpiProj{qkva, PA, 0, col0 < 768 ? 0 : 1, rope};
        if (col0 < 3840) return EpiProj{qkvb, PB, 2304, col0 < 2816 ? 0 : 1, rope};
        if (col0 < 4352) return EpiProj{clat, PCL, 3840, col0 < 4096 ? 1 : 2, rope};
        return EpiProj{g, PG, 4352, 3, rope};
    }
};
struct EpiQc {
    bf16* qc; const float* ssq; const f32x2* rope;
    DI void s8(int row, int col, float (&v)[8]) const {
        if (col >= 576) return;
        const f32x4 pp = *(const f32x4*)(ssq + (size_t)row * 4); const float rs = rsqrtf(((pp.x + pp.y) + (pp.z + pp.w)) * (1.0f / 256.0f) + RMS_EPS);
#pragma unroll
        for (int i = 0; i < 8; ++i) v[i] *= rs;
        const int j = col % 96; if (j >= 64) rope4(v, rope, row & (SEQ - 1), (j - 64) >> 1);
#pragma unroll
        for (int i = 0; i < 8; ++i) v[i] *= C2C;
        store8_bf16(qc + (size_t)row * PQC + col, v);
    }
};
struct EpiKv {
    bf16* kvc; const float* ssq;
    DI void s8(int row, int col, float (&v)[8]) const {
        const f32x4 pp = *(const f32x4*)(ssq + (size_t)row * 4); const float rs = rsqrtf(((pp.x + pp.y) + (pp.z + pp.w)) * (1.0f / 128.0f) + RMS_EPS);
#pragma unroll
        for (int i = 0; i < 8; ++i) v[i] *= rs;
        store8_bf16(kvc + (size_t)row * PKV + col, v);
    }
};
struct EpiMerge {
    bf16* merged; const bf16* gate; bool first;
    DI void s8(int row, int col, float (&v)[8]) const {
        const v4u gw = *(const v4u*)(gate + (size_t)row * PG + col);
        float r[8] = {v[0] * bflo(gw.x), v[1] * bfhi(gw.x), v[2] * bflo(gw.y), v[3] * bfhi(gw.y), v[4] * bflo(gw.z), v[5] * bfhi(gw.z), v[6] * bflo(gw.w), v[7] * bfhi(gw.w)};
        bf16* dst = merged + (size_t)row * DM + col;
        if (!first) { const v4u o = *(const v4u*)dst; r[0] += bflo(o.x); r[1] += bfhi(o.x); r[2] += bflo(o.y); r[3] += bfhi(o.y); r[4] += bflo(o.z); r[5] += bfhi(o.z); r[6] += bflo(o.w); r[7] += bfhi(o.w); }
        store8_bf16(dst, r);
    }
};
struct EpiResid {
    const float* xin; float* xout;
    DI void s4(int row, int col, f32x4 v) const { const f32x4 b = *(const f32x4*)(xin + (size_t)row * DM + col); *(f32x4*)(xout + (size_t)row * DM + col) = b + v; }
};
struct EpiGateUp {
    bf16* act; const float* wl; int slot0;
    DI void s8(int row, int col, float (&v)[8]) const {
        const float w = wl[row];
        float a[4];
#pragma unroll
        for (int i = 0; i < 4; ++i) a[i] = v[i] / (1.0f + __expf(-v[i])) * v[4 + i] * w;
        v2u o; o.x = pk2(a[0], a[1]); o.y = pk2(a[2], a[3]);
        *(v2u*)(act + (size_t)(slot0 + row) * DEXP + (col >> 1)) = o;
    }
};
struct EpiDown {
    bf16* y; const int* list; int cnt;
    DI void s8(int row, int col, float (&v)[8]) const { if (row >= cnt) return; store8_bf16(y + (size_t)list[row] * DM + col, v); }
};
namespace pg8 {
typedef unsigned u32x4 __attribute__((ext_vector_type(4)));
constexpr int BM = 256, BK = 64, HALF = 128, HTB = HALF * BK * 2, STAGE_BYTES = 8 * HTB, NXCD = 8, WGM = 8;
__host__ __device__ __forceinline__ int lds_byte(int r, int c) { const int st = (r >> 4) * 2 + (c >> 5), rr = r & 15, cc = c & 31, ob = rr * 64 + cc * 2; return st * 1024 + (ob ^ (((ob >> 9) & 1) << 5)); }
__host__ __device__ __forceinline__ void stage_rc(int b, int& R, int& C) { const int st = b / 1024, sb = b % 1024, swz = sb ^ (((sb >> 9) & 1) << 5); R = (st >> 1) * 16 + swz / 64; C = (st & 1) * 32 + (swz % 64) / 2; }
__host__ __device__ __forceinline__ int perm32(int rho) { const int n = rho >> 4, i = rho & 15; return 8 * (i >> 2) + 4 * n + (i & 3); }

struct GUnit { const char* a; const char* b; int row0, col0, e, cnt, sb; };

struct TileOrder {
    int nM, nN, nwg, G, c;
    DI void init(int nM_, int nN_, int G_, int c_) { nM = nM_; nN = nN_; nwg = nM * nN; G = G_; c = c_; }
    DI bool tile(int i, int& pm, int& pn) const {
        const long L = (long)i * G + c; if (L >= nwg) return false;
        int wgid = (int)L; { const int q = nwg / NXCD, r = nwg % NXCD, xcd = wgid % NXCD, off = wgid / NXCD; wgid = (xcd < r ? xcd * (q + 1) : r * (q + 1) + (xcd - r) * q) + off; }
        const int nig = WGM * nN, gid = wgid / nig, fm = gid * WGM, gsz = (nM - fm) < WGM ? (nM - fm) : WGM;
        pm = fm + ((wgid % nig) % gsz); pn = (wgid % nig) / gsz; return true;
    }
};
struct DenseSched {
    static constexpr bool GATHER = false;
    TileOrder T; const char* A; const char* Bt; int lda, K;
    DI bool next(int i, GUnit& u) const { int pm, pn; if (!T.tile(i, pm, pn)) return false;
        u.a = A + (size_t)pm * BM * lda * 2; u.b = Bt + (size_t)pn * BM * K * 2; u.row0 = pm * BM; u.col0 = pn * BM; u.e = 0; u.cnt = BM; u.sb = 0; return true; }
    DI unsigned gather_off(const GUnit&, int, int) const { return 0u; }
};
template <bool GATH>
struct MoeSched {
    static constexpr bool GATHER = GATH;
    const unsigned* cnt; const int* list; const char* A; const char* Bt; int lda, K, nN, G, c; size_t bstride;
    DI bool next(int i, GUnit& u) const {
        const int L = i * G + c; int tl = L / nN; const int pn = L % nN; int sb = 0;
        for (int e = 0; e < NEXP; ++e) { const int ce = (int)__builtin_amdgcn_readfirstlane((int)cnt[e]); const int nt = (ce + 255) >> 8;
            if (tl < nt) { u.e = e; u.sb = sb; u.cnt = ce - tl * 256; u.row0 = tl * 256; u.col0 = pn * BM; u.b = Bt + (size_t)e * bstride + (size_t)pn * BM * K * 2;
                u.a = GATH ? A : A + (size_t)(sb + tl * 256) * lda * 2; return true; }
            tl -= nt; sb += nt * 256; }
        return false;
    }
    DI unsigned gather_off(const GUnit& u, int r, int C) const {
        const int lr = u.row0 + r; int tok = 0; if (r < u.cnt) tok = list[u.e * M + lr] >> 1;
        return (unsigned)(tok * lda + C) * 2u;
    }
};

DI unsigned cvt_pk_bf16(float lo, float hi) { unsigned r; asm volatile("v_cvt_pk_bf16_f32 %0, %1, %2" : "=v"(r) : "v"(lo), "v"(hi)); return r; }

template <class Mk>
struct Epi8 {
    static constexpr bool PERM = true;
    Mk mk;
    DI void operator()(const f32x4 (&acc)[2][2][4][2], const GUnit& u, int wr, int wc, int fr, int fq) const {
        asm volatile("" : "+v"(fr), "+v"(fq));
        const auto F = mk.make(u);
#pragma unroll
        for (int ai = 0; ai < 2; ++ai)
#pragma unroll
            for (int m = 0; m < 4; ++m) { const int row = u.row0 + ai * HALF + wr * 64 + m * 16 + fr;
#pragma unroll
                for (int bj = 0; bj < 2; ++bj) { const f32x4 a = acc[ai][bj][m][0], b = acc[ai][bj][m][1]; float v[8] = {a[0], a[1], a[2], a[3], b[0], b[1], b[2], b[3]};
                    F.s8(row, u.col0 + bj * HALF + wc * 32 + 8 * fq, v); }
                asm volatile("" ::: "memory"); }
        mk.extra(acc, u, wr, wc, fr, fq);
    }
};
template <class Mk>
struct Epi4 {
    static constexpr bool PERM = false;
    Mk mk;
    DI void operator()(const f32x4 (&acc)[2][2][4][2], const GUnit& u, int wr, int wc, int fr, int fq) const {
        asm volatile("" : "+v"(fr), "+v"(fq));
        const auto F = mk.make(u);
#pragma unroll
        for (int ai = 0; ai < 2; ++ai)
#pragma unroll
            for (int m = 0; m < 4; ++m) { const int row = u.row0 + ai * HALF + wr * 64 + m * 16 + fr;
#pragma unroll
                for (int bj = 0; bj < 2; ++bj)
#pragma unroll
                    for (int n = 0; n < 2; ++n) F.s4(row, u.col0 + bj * HALF + wc * 32 + 16 * n + 4 * fq, acc[ai][bj][m][n]);
                asm volatile("" ::: "memory"); }
    }
};

template <class Epi, class Sched>
__device__ __forceinline__ void gemm_phase(LAS unsigned char* lds, const Sched& S, const Epi& E) {
    constexpr bool GATHER = Sched::GATHER;
    int tid_ = threadIdx.x; asm volatile("" : "+v"(tid_));
    const int tid = tid_, wid = __builtin_amdgcn_readfirstlane(tid >> 6), lane = tid & 63, wr = wid >> 2, wc = wid & 3, fr = lane & 15, fq = lane >> 4;
    const int K = S.K, lda = S.lda, nt = K / BK;
    int sR[2], sC[2];
    unsigned voffA[2][2], voffB[2], nvoffA[2][2];
#pragma unroll
    for (int i = 0; i < 2; ++i) { stage_rc(tid * 16 + i * 8192, sR[i], sC[i]); const int Rb = Epi::PERM ? ((sR[i] & ~31) + perm32(sR[i] & 31)) : sR[i];
        voffA[0][i] = (unsigned)(sR[i] * lda + sC[i]) * 2u; voffA[1][i] = voffA[0][i]; nvoffA[0][i] = voffA[0][i]; nvoffA[1][i] = voffA[0][i]; voffB[i] = (unsigned)(Rb * K + sC[i]) * 2u; }
    const size_t kstep = (size_t)(BK * 2);
    const size_t hstepA = GATHER ? 0 : (size_t)HALF * lda * 2, hstepB = (size_t)HALF * K * 2;
    const unsigned ldsw = (unsigned)wid * 1024u;
    const int aoff = lds_byte(wr * 64 + fr, fq * 8), boff = lds_byte(wc * 32 + fr, fq * 8);
#define PG8_SA(b, h) (((b) * 2 + (h)) * HTB)
#define PG8_SB(b, h) ((4 + (b) * 2 + (h)) * HTB)
#define PG8_STAGE(bufoff, gbase, voff) do { _Pragma("unroll") for (int _i = 0; _i < 2; ++_i) \
        __builtin_amdgcn_global_load_lds((const unsigned*)((const char*)(gbase) + (voff)[_i]), (LAS unsigned*)(lds + (bufoff) + ldsw + _i * 8192), 16, 0, 0); } while (0)
#define PG8_LDA(dst, b, h) do { _Pragma("unroll") for (int m = 0; m < 4; ++m) _Pragma("unroll") for (int k = 0; k < 2; ++k) dst[m][k] = *(const LAS bf16x8*)(lds + PG8_SA(b, h) + aoff + m * 2048 + k * 1024); } while (0)
#define PG8_LDB(dst, b, h) do { _Pragma("unroll") for (int n = 0; n < 2; ++n) _Pragma("unroll") for (int k = 0; k < 2; ++k) dst[n][k] = *(const LAS bf16x8*)(lds + PG8_SB(b, h) + boff + n * 2048 + k * 1024); } while (0)
#define PG8_MMA(ai, bj, At, Bt) do { __builtin_amdgcn_s_setprio(1); _Pragma("unroll") for (int m = 0; m < 4; ++m) _Pragma("unroll") for (int n = 0; n < 2; ++n) _Pragma("unroll") for (int k = 0; k < 2; ++k) \
        acc[ai][bj][m][n] = __builtin_amdgcn_mfma_f32_16x16x32_bf16(Bt[n][k], At[m][k], acc[ai][bj][m][n], 0, 0, 0); __builtin_amdgcn_s_setprio(0); } while (0)
#define PG8_WAIT_V(n) asm volatile("s_waitcnt vmcnt(" #n ")" ::: "memory")
#define PG8_WAIT_L(n) asm volatile("s_waitcnt lgkmcnt(" #n ")" ::: "memory")
#define PG8_BAR __builtin_amdgcn_s_barrier()
#define PG8_SCHED __builtin_amdgcn_sched_barrier(0)
    GUnit cur, nxt; int ui = 0;
    if (!S.next(0, cur)) return;
    if constexpr (GATHER) {
#pragma unroll
        for (int h = 0; h < 2; ++h)
#pragma unroll
            for (int i = 0; i < 2; ++i) voffA[h][i] = S.gather_off(cur, h * HALF + sR[i], sC[i]);
    }
    f32x4 acc[2][2][4][2];
#pragma unroll
    for (int a = 0; a < 2; ++a)
#pragma unroll
        for (int b = 0; b < 2; ++b)
#pragma unroll
            for (int m = 0; m < 4; ++m)
#pragma unroll
                for (int n = 0; n < 2; ++n) acc[a][b][m][n] = (f32x4){0.f, 0.f, 0.f, 0.f};
    bf16x8 At[4][2], B0[2][2], B1[2][2];
    const char* cA = cur.a; const char* cB = cur.b;
    PG8_STAGE(PG8_SB(0, 0), cB, voffB); PG8_STAGE(PG8_SB(0, 1), cB + hstepB, voffB); PG8_STAGE(PG8_SA(0, 0), cA, voffA[0]); PG8_STAGE(PG8_SA(0, 1), cA + hstepA, voffA[1]);
    if (wr == 1) PG8_BAR;
    PG8_WAIT_V(2); PG8_BAR;
    PG8_STAGE(PG8_SB(1, 0), cB + kstep, voffB); PG8_STAGE(PG8_SA(1, 0), cA + kstep, voffA[0]); PG8_STAGE(PG8_SB(1, 1), cB + hstepB + kstep, voffB);
    PG8_WAIT_V(6); PG8_BAR;
    for (;;) {
        const bool has_next = S.next(ui + 1, nxt);
        const char* nA = has_next ? nxt.a : cA; const char* nB = has_next ? nxt.b : cB;
        if constexpr (GATHER) {
#pragma unroll
            for (int h = 0; h < 2; ++h)
#pragma unroll
                for (int i = 0; i < 2; ++i) nvoffA[h][i] = has_next ? S.gather_off(nxt, h * HALF + sR[i], sC[i]) : voffA[h][i];
        }
        for (int t = 0; t < nt; t += 2) {
            const bool last = (t == nt - 2);
            const char* a1 = cA + (size_t)(t + 1) * kstep;
            const char* a2 = last ? nA : cA + (size_t)(t + 2) * kstep; const char* b2 = last ? nB : cB + (size_t)(t + 2) * kstep;
            const char* a3 = a2 + kstep; const char* b3 = b2 + kstep;
            unsigned v2[2][2];
#pragma unroll
            for (int h = 0; h < 2; ++h)
#pragma unroll
                for (int i = 0; i < 2; ++i) v2[h][i] = (GATHER && last) ? nvoffA[h][i] : voffA[h][i];
            PG8_LDB(B0, 0, 0); PG8_LDB(B1, 0, 1); PG8_SCHED; PG8_LDA(At, 0, 0); PG8_STAGE(PG8_SA(1, 1), a1 + hstepA, voffA[1]);
            PG8_WAIT_V(8); PG8_WAIT_L(0); PG8_BAR; PG8_MMA(0, 0, At, B0); PG8_MMA(0, 1, At, B1); PG8_BAR; PG8_SCHED;
            PG8_LDA(At, 0, 1); PG8_STAGE(PG8_SB(0, 0), b2, voffB); PG8_STAGE(PG8_SB(0, 1), b2 + hstepB, voffB); PG8_STAGE(PG8_SA(0, 0), a2, v2[0]);
            PG8_WAIT_V(8); PG8_WAIT_L(0); PG8_BAR; PG8_MMA(1, 0, At, B0); PG8_MMA(1, 1, At, B1); PG8_BAR; PG8_SCHED;
            PG8_LDB(B0, 1, 0); PG8_LDB(B1, 1, 1); PG8_SCHED; PG8_LDA(At, 1, 0); PG8_STAGE(PG8_SA(0, 1), a2 + hstepA, v2[1]);
            PG8_WAIT_V(8); PG8_WAIT_L(0); PG8_BAR; PG8_MMA(0, 0, At, B0); PG8_MMA(0, 1, At, B1); PG8_BAR; PG8_SCHED;
            PG8_LDA(At, 1, 1); PG8_STAGE(PG8_SB(1, 0), b3, voffB); PG8_STAGE(PG8_SB(1, 1), b3 + hstepB, voffB); PG8_STAGE(PG8_SA(1, 0), a3, v2[0]);
            PG8_WAIT_V(8); PG8_WAIT_L(0); PG8_BAR; PG8_MMA(1, 0, At, B0); PG8_MMA(1, 1, At, B1); PG8_BAR; PG8_SCHED;
        }
        if (wr == 0) PG8_BAR;
        E(acc, cur, wr, wc, fr, fq);
        if (!has_next) break;
#pragma unroll
        for (int a = 0; a < 2; ++a)
#pragma unroll
            for (int b = 0; b < 2; ++b)
#pragma unroll
                for (int m = 0; m < 4; ++m)
#pragma unroll
                    for (int n = 0; n < 2; ++n) acc[a][b][m][n] = (f32x4){0.f, 0.f, 0.f, 0.f};
        cur = nxt; cA = nA; cB = nB; ++ui;
        if constexpr (GATHER) {
#pragma unroll
            for (int h = 0; h < 2; ++h)
#pragma unroll
                for (int i = 0; i < 2; ++i) voffA[h][i] = nvoffA[h][i];
        }
        if (wr == 1) PG8_BAR;
    }
    PG8_WAIT_V(0);
    PG8_BAR;
#undef PG8_SA
#undef PG8_SB
#undef PG8_STAGE
#undef PG8_LDA
#undef PG8_LDB
#undef PG8_MMA
#undef PG8_WAIT_V
#undef PG8_WAIT_L
#undef PG8_BAR
#undef PG8_SCHED
}
}
struct MkProj {
    ProjDst D; float* ssq_q; float* ssq_kv;
    DI EpiProj make(const pg8::GUnit& u) const { return D.of(u.col0); }
    DI void extra(const f32x4 (&acc)[2][2][4][2], const pg8::GUnit& u, int wr, int wc, int fr, int fq) const {
        if (u.col0 != 3840 && u.col0 != 4096) return;
        const bool kv = (u.col0 == 4096); float* dst = kv ? ssq_kv : ssq_q;
#pragma unroll
        for (int ai = 0; ai < 2; ++ai)
#pragma unroll
            for (int m = 0; m < 4; ++m) { float s = 0.f;
#pragma unroll
                for (int bj = 0; bj < 2; ++bj) { if (kv && bj == 1) continue;
#pragma unroll
                    for (int n = 0; n < 2; ++n)
#pragma unroll
                        for (int c = 0; c < 4; ++c) { const float r = bf2f((unsigned short)f2bf(acc[ai][bj][m][n][c])); s += r * r; } }
                s += __shfl_xor(s, 16); s += __shfl_xor(s, 32);
                if (fq == 0) dst[(size_t)(u.row0 + ai * 128 + wr * 64 + m * 16 + fr) * 4 + wc] = s; }
    }
};
template <class F> struct MkPlain { F E; DI F make(const pg8::GUnit&) const { return E; } DI void extra(const f32x4 (&)[2][2][4][2], const pg8::GUnit&, int, int, int, int) const {} };
struct MkGateUp { bf16* act; const float* wl;
    DI EpiGateUp make(const pg8::GUnit& u) const { return EpiGateUp{act, wl + u.e * M, u.sb}; }
    DI void extra(const f32x4 (&)[2][2][4][2], const pg8::GUnit&, int, int, int, int) const {} };
struct MkDown { bf16* y; const int* list;
    DI EpiDown make(const pg8::GUnit& u) const { return EpiDown{y, list + u.e * M, u.row0 + u.cnt}; }
    DI void extra(const f32x4 (&)[2][2][4][2], const pg8::GUnit&, int, int, int, int) const {} };

struct NAJob { const bf16* q; const bf16* k; int kstride; const bf16* k2; int k2stride; const bf16* v; int vstride; int dk1, dk2, dv, nkeys, dil; float bias2; };
DI void naive_attend(const NAJob& J, LAS float* sq, LAS float* ss, int lane, float& o0, float& o1, float& lse2) {
    for (int d = lane; d < J.dk1 + J.dk2; d += 64) sq[d] = bf2f(J.q[d]);
    LDS_WAIT(); asm volatile("" ::: "memory");
    float mx = -1e30f;
    for (int j = lane; j < J.nkeys; j += 64) {
        const bf16* kr = J.k - (ptrdiff_t)j * J.dil * J.kstride; float s = 0.f;
        for (int c = 0; c < J.dk1; c += 8) { const v4u w = *(const v4u*)(kr + c); s += sq[c] * bflo(w.x) + sq[c + 1] * bfhi(w.x) + sq[c + 2] * bflo(w.y) + sq[c + 3] * bfhi(w.y) + sq[c + 4] * bflo(w.z) + sq[c + 5] * bfhi(w.z) + sq[c + 6] * bflo(w.w) + sq[c + 7] * bfhi(w.w); }
        if (J.dk2) { const bf16* k2 = J.k2 - (ptrdiff_t)j * J.dil * J.k2stride; for (int c = 0; c < J.dk2; c += 8) { const v4u w = *(const v4u*)(k2 + c); const LAS float* q2 = sq + J.dk1 + c; s += q2[0] * bflo(w.x) + q2[1] * bfhi(w.x) + q2[2] * bflo(w.y) + q2[3] * bfhi(w.y) + q2[4] * bflo(w.z) + q2[5] * bfhi(w.z) + q2[6] * bflo(w.w) + q2[7] * bfhi(w.w); } }
        s += J.bias2 * (float)j; ss[j] = s; mx = fmaxf(mx, s);
    }
    mx = wave_max(mx); float l = 0.f;
    for (int j = lane; j < J.nkeys; j += 64) { const float pv = exp2f(ss[j] - mx); ss[j] = pv; l += pv; }
    l = wave_sum(l);
    LDS_WAIT(); asm volatile("" ::: "memory");
    float a0 = 0.f, a1 = 0.f;
    for (int j = 0; j < J.nkeys; ++j) { const bf16* vr = J.v - (ptrdiff_t)j * J.dil * J.vstride; const float pj = ss[j]; a0 += pj * bf2f(vr[lane]); if (J.dv > 64) a1 += pj * bf2f(vr[64 + lane]); }
    LDS_WAIT(); asm volatile("" ::: "memory");
    o0 = a0 / l; o1 = a1 / l; lse2 = mx + log2f(l);
}
DI void nattn_a(const Params& p, int idx, LAS float* sq, LAS float* ss, int lane) {
    unsigned char* ws = p.ws;
    const int t = idx / 12, hh = idx % 12, g = hh >> 2, s = hh & 3, tp = t & (SEQ - 1), dil = g == 0 ? 1 : (g == 1 ? 4 : 16);
    bf16* base = (bf16*)(ws + WS_QKVA) + (size_t)t * PA + hh * 64; int nk = tp / dil + 1; if (nk > 129) nk = 129;
    NAJob J{base, base + 768, PA, nullptr, 0, base + 1536, PA, 64, 0, 64, nk, dil, -alibi_a(hh) * LOG2E * (float)dil};
    float o0, o1, lse; naive_attend(J, sq, ss, lane, o0, o1, lse);
    base[lane] = (bf16)f2bf(o0); if (lane == 0) ((float*)(ws + WS_LSE))[((size_t)g * M + t) * 4 + s] = lse;
}
DI void nattn_b(const Params& p, int l, int idx, LAS float* sq, LAS float* ss, int lane) {
    unsigned char* ws = p.ws;
    const int t = idx >> 2, h = idx & 3, tp = t & (SEQ - 1);
    bf16* row = (bf16*)(ws + WS_QKVB) + (size_t)t * PB; float oa[2][2];
#pragma unroll
    for (int mp = 0; mp < 2; ++mp) { NAJob J{row + (2 * h + mp) * 64, row + 512 + (2 * h + mp) * 64, PB, nullptr, 0, row + 1024 + h * 128, PB, 64, 0, 128, tp + 1, 1, -alibi_b(h) * LOG2E};
        float lse; naive_attend(J, sq, ss, lane, oa[mp][0], oa[mp][1], lse); }
    const float lam = lam_of(p, l, lane); const float d0 = oa[0][0] - lam * oa[1][0], d1 = oa[0][1] - lam * oa[1][1];
    const float rs = rsqrtf(wave_sum(d0 * d0 + d1 * d1) * (1.0f / 128.0f) + RMS_EPS) * (1.0f - lam_init_of(l));
    const float* gs = p.in[15] + l * 128;
    row[h * 128 + lane] = (bf16)f2bf(d0 * rs * gs[lane]); row[h * 128 + 64 + lane] = (bf16)f2bf(d1 * rs * gs[64 + lane]);
}
DI void nattn_c(const Params& p, int idx, LAS float* sq, LAS float* ss, int lane) {
    unsigned char* ws = p.ws;
    const int t = idx / 6, h = idx % 6, tp = t & (SEQ - 1);
    const bf16* kv = (const bf16*)(ws + WS_KVC) + (size_t)t * PKV + h * 128;
    NAJob J{(const bf16*)(ws + WS_QC) + (size_t)t * PQC + h * 96, kv, PKV, (const bf16*)(ws + WS_CLAT) + (size_t)t * PCL + KR_COL, PCL, kv + 64, PKV, 64, 32, 64, tp + 1, 1, 0.f};
    float o0, o1, lse; naive_attend(J, sq, ss, lane, o0, o1, lse);
    ((bf16*)(ws + WS_OC))[(size_t)t * POC + h * 64 + lane] = (bf16)f2bf(o0);
}

#define XB_TMO      128
#define XB_XCNT(j)  (256  + 64 * (j))
#define XB_XSUB(j)  (1280 + 64 * (j))
#define XB_XGEN(j)  (2304 + 64 * (j))
#define XB_TOP      3328
#define XB_TOPGEN   3392
#define XCD_BAR_WORDS 3456
#define XB_SPIN_CAP (1u << 18)
__device__ __forceinline__ unsigned xb_ld(unsigned* p)              { return __hip_atomic_load(p, __ATOMIC_RELAXED, __HIP_MEMORY_SCOPE_AGENT); }
__device__ __forceinline__ unsigned xb_add(unsigned* p, unsigned v) { return __hip_atomic_fetch_add(p, v, __ATOMIC_RELAXED, __HIP_MEMORY_SCOPE_AGENT); }
__device__ __forceinline__ unsigned xb_xcc_id() { return (unsigned)__builtin_amdgcn_s_getreg((3 << 11) | 20) & 0xFu; }
#define XB_SPIN(cond, bar) do { unsigned _sp = 0; while (cond) { __builtin_amdgcn_s_sleep(1); \
    if ((++_sp & 255u) == 0u) { if (xb_ld(&(bar)[XB_TMO])) break; if (_sp > XB_SPIN_CAP) { atomicAdd(&(bar)[XB_TMO], 1u); break; } } } } while (0)
struct XcdBarrier { unsigned* bar; unsigned x; volatile LAS unsigned* st; };
__device__ __forceinline__ XcdBarrier xcd_barrier_post(unsigned* bar, volatile LAS unsigned* st) {
    XcdBarrier b; b.bar = bar; b.x = xb_xcc_id(); b.st = st;
    if (threadIdx.x == 0) (void)xb_add(&bar[XB_XCNT(b.x)], 1u);
    return b;
}
__device__ __forceinline__ void xcd_barrier_complete(unsigned* bar, unsigned x, unsigned& nloc, unsigned& nx) {
    const unsigned G = gridDim.x * gridDim.y * gridDim.z;
    unsigned sum, cnt, mine, sp = 0u;
    for (;;) {
        sum = 0u; cnt = 0u; mine = 0u;
#pragma unroll
        for (unsigned j = 0; j < 16; ++j) { const unsigned c = xb_ld(&bar[XB_XCNT(j)]); sum += c; cnt += (c > 0u) ? 1u : 0u; mine = (j == x) ? c : mine; }
        if (sum == G) break;
        __builtin_amdgcn_s_sleep(1);
        if ((++sp & 255u) == 0u) { if (xb_ld(&bar[XB_TMO])) break; if (sp > XB_SPIN_CAP) { atomicAdd(&bar[XB_TMO], 1u); break; } }
    }
    nloc = mine > 0u ? mine : 1u; nx = cnt > 0u ? cnt : 1u;
}
__device__ __forceinline__ void xcd_barrier(const XcdBarrier& b) {
    asm volatile("s_waitcnt vmcnt(0)" ::: "memory");
    __syncthreads();
    if (threadIdx.x == 0) {
        unsigned* bar = b.bar;
        __builtin_amdgcn_s_waitcnt(0);
        unsigned nloc = b.st[0], nx = b.st[1];
        if (nloc == 0u) { xcd_barrier_complete(bar, b.x, nloc, nx); b.st[0] = nloc; b.st[1] = nx; }
        const unsigned old = xb_add(&bar[XB_XSUB(b.x)], 1u);
        const unsigned gen = old / nloc;
        if (old + 1u == (gen + 1u) * nloc) {
            __builtin_amdgcn_fence(__ATOMIC_RELEASE, "agent");
            asm volatile("s_waitcnt vmcnt(0)" ::: "memory");
            const unsigned og = xb_add(&bar[XB_TOP], 1u);
            const unsigned tg = og / nx;
            if (og + 1u == (tg + 1u) * nx) xb_add(&bar[XB_TOPGEN], 1u);
            else XB_SPIN(xb_ld(&bar[XB_TOPGEN]) == tg, bar);
            __builtin_amdgcn_fence(__ATOMIC_ACQUIRE, "agent");
            xb_add(&bar[XB_XGEN(b.x)], 1u);
            asm volatile("s_waitcnt vmcnt(0)" ::: "memory");
        } else {
            XB_SPIN(xb_ld(&bar[XB_XGEN(b.x)]) == gen, bar);
            __builtin_amdgcn_fence(__ATOMIC_ACQUIRE, "agent");
            asm volatile("s_waitcnt vmcnt(0)" ::: "memory");
        }
    }
    __syncthreads();
}

constexpr int NWAVES = 8;
constexpr int RING_BYTES = 131072, MISC_OFF = RING_BYTES, LDS_BYTES = 147456;
#ifndef PH_MASK
#define PH_MASK 0x7ff
#endif
#define PH_EN(k) (((PH_MASK) >> (k)) & 1)
#ifndef MK_PER_PHASE
#define MK_PER_PHASE 0
#endif
constexpr int N_PHASES = 1 + DEPTH * 10;
struct Args { Params p; int ph_lo, ph_hi; };

DI unsigned long long rf64(unsigned long long v) { const unsigned lo = __builtin_amdgcn_readfirstlane((unsigned)v), hi = __builtin_amdgcn_readfirstlane((unsigned)(v >> 32)); return ((unsigned long long)hi << 32) | lo; }
DI Params load_params(LAS const unsigned long long* PT) { Params p;
#pragma unroll
    for (int i = 0; i < 23; ++i) p.in[i] = (const float*)rf64(PT[i]);
    p.out = (float*)rf64(PT[23]); p.ws = (unsigned char*)rf64(PT[24]); return p; }
__global__ void __launch_bounds__(NWAVES * 64, 2) mega_fwd(Args args) {
    extern __shared__ __attribute__((aligned(16))) unsigned char lds_raw[];
    LAS unsigned char* lds = (LAS unsigned char*)lds_raw;
    const int tid = threadIdx.x, lane0 = tid & 63, wave0 = __builtin_amdgcn_readfirstlane(tid >> 6);
    LAS unsigned long long* PT = (LAS unsigned long long*)(lds + MISC_OFF + 256);
    if (tid < 23) PT[tid] = (unsigned long long)args.p.in[tid];
    if (tid == 23) PT[23] = (unsigned long long)args.p.out;
    if (tid == 24) PT[24] = (unsigned long long)args.p.ws;
    const int G0 = gridDim.x;
    volatile LAS unsigned* MISC = (volatile LAS unsigned*)(lds + MISC_OFF);
    if (tid < 64) MISC[tid] = 0u;
    __syncthreads();
    XcdBarrier bar; { unsigned* ctl0 = (unsigned*)((unsigned char*)rf64(PT[24]) + WS_CTL); bar.bar = ctl0 + CW_BAR; bar.x = 0; bar.st = nullptr;
        if (!MK_PER_PHASE) bar = xcd_barrier_post(ctl0 + CW_BAR, MISC + 8); }
#define LOADP() int lane = lane0, wave = wave0, G = G0, bid = (int)blockIdx.x; asm volatile("" : "+v"(lane)); asm volatile("" : "+s"(wave), "+s"(G), "+s"(bid)); \
    const int gw = bid * NWAVES + wave, NGW = G * NWAVES; LAS float* const scr = (LAS float*)(lds + wave * 16384); (void)gw; (void)NGW; (void)scr; (void)lane; \
    const Params p = load_params(PT); unsigned char* const ws = p.ws; unsigned* const ctl = (unsigned*)(ws + WS_CTL); const f32x2* const rope = (const f32x2*)(ws + WS_ROPE); (void)ctl; (void)rope
    const int lo = args.ph_lo, hi = args.ph_hi;
#define IN(k) (lo <= (k) && (k) < hi)
#define SEAM(k) do { if (IN(k) && IN((k) + 1)) xcd_barrier(bar); } while (0)

    if (PH_EN(0) && IN(0)) { LOADP(); ph_cvt_mixer(p, 0, gw, NGW, lane, scr); ph_rope_table(p, gw, NGW, lane); ph_rmsnorm(p.in[0], p.in[2], (bf16*)(ws + WS_U), gw, NGW, lane); }
    SEAM(0);
    for (int l = 0; l < DEPTH; ++l) {
        const int P = 1 + l * 10;
        if (PH_EN(1) && IN(P + 0)) { LOADP();
            pg8::DenseSched S; S.T.init(M / 256, NPROJ / 256, G, bid); S.A = (const char*)(ws + WS_U); S.Bt = (const char*)(ws + WM_IN); S.lda = DM; S.K = DM;
            pg8::Epi8<MkProj> E{MkProj{ProjDst{(bf16*)(ws + WS_QKVA), (bf16*)(ws + WS_QKVB), (bf16*)(ws + WS_CLAT), (bf16*)(ws + WS_G), rope}, (float*)(ws + WS_SSQQ), (float*)(ws + WS_SSQKV)}};
            pg8::gemm_phase(lds, S, E);
        }
        SEAM(P + 0);
        if (PH_EN(2) && IN(P + 1)) { LOADP();
            { pg8::DenseSched S; S.T.init(M / 256, 3, G, bid); S.A = (const char*)(ws + WS_CLAT); S.Bt = (const char*)(ws + WM_UQ); S.lda = PCL; S.K = 256;
              pg8::Epi8<MkPlain<EpiQc>> E{MkPlain<EpiQc>{EpiQc{(bf16*)(ws + WS_QC), (const float*)(ws + WS_SSQQ), rope}}};
              pg8::gemm_phase(lds, S, E); }
            { pg8::DenseSched S; S.T.init(M / 256, 3, G, bid); S.A = (const char*)(ws + WS_CLAT) + 512; S.Bt = (const char*)(ws + WM_UKV); S.lda = PCL; S.K = 256;
              pg8::Epi8<MkPlain<EpiKv>> E{MkPlain<EpiKv>{EpiKv{(bf16*)(ws + WS_KVC), (const float*)(ws + WS_SSQKV)}}};
              pg8::gemm_phase(lds, S, E); }
        }
        SEAM(P + 1);
        if (PH_EN(3) && IN(P + 2)) { LOADP();
            LAS float* sq = scr; LAS float* ss = scr + 128;
            for (int idx = gw; idx < M * 12; idx += NGW) nattn_a(p, idx, sq, ss, lane);
            for (int idx = gw; idx < M * 4; idx += NGW) nattn_b(p, l, idx, sq, ss, lane);
            for (int idx = gw; idx < M * 6; idx += NGW) nattn_c(p, idx, sq, ss, lane);
        }
        SEAM(P + 2);
        if (PH_EN(4) && IN(P + 3)) { LOADP(); ph_amerge(p, gw, NGW, lane); }
        SEAM(P + 3);
        if (PH_EN(5) && IN(P + 4)) { LOADP();
            { pg8::DenseSched S; S.T.init(M / 256, 4, G, bid); S.A = (const char*)(ws + WS_OA); S.Bt = (const char*)(ws + WM_PA); S.lda = POA; S.K = 256;
              pg8::Epi8<MkPlain<EpiMerge>> E{MkPlain<EpiMerge>{EpiMerge{(bf16*)(ws + WS_MERGED), (const bf16*)(ws + WS_G), true}}};
              pg8::gemm_phase(lds, S, E); }
            { pg8::DenseSched S; S.T.init(M / 256, 4, G, bid); S.A = (const char*)(ws + WS_QKVB); S.Bt = (const char*)(ws + WM_PB); S.lda = PB; S.K = 512;
              pg8::Epi8<MkPlain<EpiMerge>> E{MkPlain<EpiMerge>{EpiMerge{(bf16*)(ws + WS_MERGED), (const bf16*)(ws + WS_G) + 1024, false}}};
              pg8::gemm_phase(lds, S, E); }
            { pg8::DenseSched S; S.T.init(M / 256, 4, G, bid); S.A = (const char*)(ws + WS_OC); S.Bt = (const char*)(ws + WM_PC); S.lda = POC; S.K = 384;
              pg8::Epi8<MkPlain<EpiMerge>> E{MkPlain<EpiMerge>{EpiMerge{(bf16*)(ws + WS_MERGED), (const bf16*)(ws + WS_G) + 2048, false}}};
              pg8::gemm_phase(lds, S, E); }
        }
        SEAM(P + 4);
        if (PH_EN(6) && IN(P + 5)) { LOADP();
            pg8::DenseSched S; S.T.init(M / 256, 4, G, bid); S.A = (const char*)(ws + WS_MERGED); S.Bt = (const char*)(ws + WM_O); S.lda = DM; S.K = DM;
            pg8::Epi4<MkPlain<EpiResid>> E{MkPlain<EpiResid>{EpiResid{l == 0 ? p.in[0] : p.out, p.out}}};
            pg8::gemm_phase(lds, S, E);
        }
        SEAM(P + 5);
        if (PH_EN(7) && IN(P + 6)) { LOADP(); ph_router(p, l, gw, NGW, lane); ph_cvt_experts(p, l, gw, NGW, lane, scr); }
        SEAM(P + 6);
        if (PH_EN(8) && IN(P + 7)) { LOADP();
            const unsigned* cnt = ctl + CW_CNT + l * 64;
            pg8::MoeSched<true> S{cnt, (const int*)(ws + WS_LIST), (const char*)(ws + WS_U), (const char*)(ws + WS_WGU), DM, DM, 4, G, bid, (size_t)1024 * 1024 * 2};
            pg8::Epi8<MkGateUp> E{MkGateUp{(bf16*)(ws + WS_ACT), (const float*)(ws + WS_WLIST)}};
            pg8::gemm_phase(lds, S, E);
        }
        SEAM(P + 7);
        if (PH_EN(9) && IN(P + 8)) { LOADP();
            const unsigned* cnt = ctl + CW_CNT + l * 64;
            pg8::MoeSched<false> S{cnt, (const int*)(ws + WS_LIST), (const char*)(ws + WS_ACT), (const char*)(ws + WS_WD), DEXP, DEXP, 4, G, bid, (size_t)1024 * 512 * 2};
            pg8::Epi8<MkDown> E{MkDown{(bf16*)(ws + WS_Y), (const int*)(ws + WS_LIST)}};
            pg8::gemm_phase(lds, S, E);
        }
        SEAM(P + 8);
        if (PH_EN(10) && IN(P + 9)) { LOADP(); ph_combine(p, l, gw, NGW, lane); if (l + 1 < DEPTH) ph_cvt_mixer(p, l + 1, gw, NGW, lane, scr); }
        SEAM(P + 9);
    }
#undef IN
#undef SEAM
}

extern "C" void kernel_launch(void* const* d_in, const int* in_sizes, int n_in, void* d_out, int out_size, void* d_ws, size_t ws_size, hipStream_t stream) {
    static int grid = 0;
    if (grid == 0) {
        if (n_in != 23 || ws_size < WS_END || out_size != M * DM) { fprintf(stderr, "kernel_launch: unexpected sizes\n"); grid = -1; return; }
        int dev = 0, cus = 0, per_cu = 0;
        if (hipGetDevice(&dev) != hipSuccess || hipDeviceGetAttribute(&cus, hipDeviceAttributeMultiprocessorCount, dev) != hipSuccess) { grid = -1; return; }
        if (hipFuncSetAttribute((const void*)mega_fwd, hipFuncAttributeMaxDynamicSharedMemorySize, LDS_BYTES) != hipSuccess) { fprintf(stderr, "kernel_launch: hipFuncSetAttribute failed\n"); grid = -1; return; }
        if (hipOccupancyMaxActiveBlocksPerMultiprocessor(&per_cu, (const void*)mega_fwd, NWAVES * 64, LDS_BYTES) != hipSuccess || per_cu < 1) { fprintf(stderr, "kernel_launch: occupancy query says %d\n", per_cu); }
        (void)hipGetLastError();
        grid = cus;
    }
    if (grid < 0) return;
    (void)hipMemsetAsync((char*)d_ws + WS_CTL, 0, CTL_BYTES, stream);
    Args a{}; for (int i = 0; i < 23; ++i) a.p.in[i] = (const float*)d_in[i]; a.p.out = (float*)d_out; a.p.ws = (unsigned char*)d_ws;
#if MK_PER_PHASE
    for (int ph = 0; ph < N_PHASES; ++ph) { a.ph_lo = ph; a.ph_hi = ph + 1; hipLaunchKernelGGL(mega_fwd, dim3(grid), dim3(NWAVES * 64), LDS_BYTES, stream, a); }
#else
    a.ph_lo = 0; a.ph_hi = N_PHASES; hipLaunchKernelGGL(mega_fwd, dim3(grid), dim3(NWAVES * 64), LDS_BYTES, stream, a);
#endif
}
```

```cpp
#include <hip/hip_runtime.h>
#include <cstdio>
#include <cstdint>
#include <cmath>

#define GAS __attribute__((address_space(1)))
#define LAS __attribute__((address_space(3)))
#define DI __device__ __forceinline__
typedef unsigned short bf16;
typedef unsigned v4u __attribute__((ext_vector_type(4)));
typedef unsigned v2u __attribute__((ext_vector_type(2)));
typedef float f32x4 __attribute__((ext_vector_type(4)));
typedef float f32x2 __attribute__((ext_vector_type(2)));
typedef float f32x16 __attribute__((ext_vector_type(16)));
typedef short bf16x8 __attribute__((ext_vector_type(8)));
typedef short s16x4 __attribute__((ext_vector_type(4)));

constexpr int NB = 8, SEQ = 2048, DM = 1024, M = NB * SEQ, DEPTH = 2;
constexpr int IN_COLS = 7328, NPROJ = 7424;
constexpr int NEXP = 16, DEXP = 512;
constexpr float RMS_EPS = 1e-6f;
constexpr float LOG2E = 1.4426950408889634f;
constexpr float C2A = 0.125f * LOG2E;
constexpr float C2C = 0.10206207261596577f * LOG2E;
constexpr int PA = 2304, PB = 1536, PCL = 512, PG = 3072, PQC = 576, PKV = 768, POC = 384, POA = 256;
constexpr int KR_COL = 384;

constexpr size_t MiB = 1u << 20;
constexpr size_t WS_CTL = 0, CTL_BYTES = 1 * MiB;
constexpr size_t WS_LIST = 1 * MiB;
constexpr size_t WS_WLIST = 2 * MiB;
constexpr size_t WS_SSQQ = 3 * MiB;
constexpr size_t WS_SSQKV = 3 * MiB + 256 * 1024;
constexpr size_t WS_LSE = 3 * MiB + 512 * 1024;
constexpr size_t WS_ROPE = 5 * MiB;
constexpr size_t WS_WMIX = 8 * MiB;
constexpr size_t WM_IN = WS_WMIX;
constexpr size_t WM_O = WM_IN + (size_t)NPROJ * DM * 2;
constexpr size_t WM_PA = WM_O + (size_t)DM * DM * 2;
constexpr size_t WM_PB = WM_PA + (size_t)DM * 256 * 2;
constexpr size_t WM_PC = WM_PB + (size_t)DM * 512 * 2;
constexpr size_t WM_UQ = WM_PC + (size_t)DM * 384 * 2;
constexpr size_t WM_UKV = WM_UQ + (size_t)768 * 256 * 2;
constexpr size_t WM_END = WM_UKV + (size_t)768 * 256 * 2;
static_assert(WM_END <= 28 * MiB, "mixer weights");
constexpr size_t WS_U = 28 * MiB;
constexpr size_t WS_KVC = WS_U;
constexpr size_t WS_OA = WS_U + 24 * MiB;
constexpr size_t WS_QKVA = 60 * MiB;
constexpr size_t WS_QKVB = 132 * MiB;
constexpr size_t WS_CLAT = 180 * MiB;
constexpr size_t WS_G = 196 * MiB;
constexpr size_t WS_QC = 292 * MiB;
constexpr size_t WS_OC = 310 * MiB;
constexpr size_t WS_END = 322 * MiB;
constexpr size_t WS_MERGED = WS_QKVA;
constexpr size_t WS_WGU = 60 * MiB;
constexpr size_t WS_WD = 92 * MiB;
constexpr size_t WS_ACT = 108 * MiB;
constexpr size_t WS_Y = 144 * MiB;
constexpr int ACT_ROWS = 2 * M + NEXP * 256;
static_assert(WS_ACT + (size_t)ACT_ROWS * DEXP * 2 <= WS_Y && WS_Y + (size_t)2 * M * DM * 2 <= WS_END, "moe map");
constexpr int CW_TMO = 0;
constexpr int CW_CNT = 64;
constexpr int CW_ERR = 256;
constexpr int CW_ATTN = 512;
constexpr int CW_BAR = 4096;

struct Params {
    const float* in[23]; float* out; unsigned char* ws;
};

DI unsigned f2bf(float f) { unsigned u = __builtin_bit_cast(unsigned, f); return (u + 0x7fffu + ((u >> 16) & 1u)) >> 16; }
DI unsigned pk2(float lo, float hi) { return f2bf(lo) | (f2bf(hi) << 16); }
DI float bf2f(unsigned short b) { return __builtin_bit_cast(float, (unsigned)b << 16); }
DI float bflo(unsigned w) { return __builtin_bit_cast(float, w << 16); }
DI float bfhi(unsigned w) { return __builtin_bit_cast(float, w & 0xffff0000u); }
DI float wave_sum(float v) {
#pragma unroll
    for (int o = 1; o < 64; o <<= 1) v += __shfl_xor(v, o);
    return v;
}
DI float wave_max(float v) {
#pragma unroll
    for (int o = 1; o < 64; o <<= 1) v = fmaxf(v, __shfl_xor(v, o));
    return v;
}
DI float sigmoidf_(float x) { return 1.0f / (1.0f + __expf(-x)); }
DI float alibi_a(int h) { return exp2f(-8.0f * (float)(h + 1) / 12.0f); }
DI float alibi_b(int h) { return exp2f(-2.0f * (float)(h + 1)); }
DI float lam_init_of(int l) { return 0.8f - 0.6f * expf(-0.3f * (float)l); }
DI float lam_of(const Params& p, int l, int lane) {
    const float a = p.in[11][l * 64 + lane] * p.in[12][l * 64 + lane], b = p.in[13][l * 64 + lane] * p.in[14][l * 64 + lane];
    return expf(wave_sum(a)) - expf(wave_sum(b)) + lam_init_of(l);
}
#define LDS_WAIT() asm volatile("s_waitcnt lgkmcnt(0)" ::: "memory")

struct MapIdent { int off; DI int operator()(int n) const { return n + off; } };
struct MapWin { DI int operator()(int n) const { if (n < 4224) return n; if (n < 4256) { const int i = n - 4224; return 4224 + (i < 16 ? 2 * i : 2 * (i - 16) + 1); } return n + 96; } };
struct MapUq { DI int operator()(int n) const { const int h = n / 96, j = n % 96; if (j < 64) return n; const int i = j - 64; return h * 96 + 64 + (i < 16 ? 2 * i : 2 * (i - 16) + 1); } };
struct MapGate { DI int operator()(int n) const { return 8 * (n >> 2) + (n & 3); } };
struct MapUp { DI int operator()(int n) const { return 8 * (n >> 2) + 4 + (n & 3); } };

template <class Map>
DI void cvt_item(const float* __restrict__ W, int N, bf16* WT, int Kd, const float* gk, const Map& map, LAS float* scr, int item, int lane) {
    const int nblk = N / 32, kb = item / nblk, nb = item % nblk, k0 = 64 * kb, n0 = 32 * nb;
#pragma unroll 8
    for (int i = 0; i < 32; ++i) { const int kk = 2 * i + (lane >> 5); float v = W[(size_t)(k0 + kk) * N + n0 + (lane & 31)]; if (gk) v *= gk[k0 + kk]; scr[kk * 33 + (lane & 31)] = v; }
    LDS_WAIT(); asm volatile("" ::: "memory");
    const int c = lane & 7;
#pragma unroll
    for (int j = 0; j < 4; ++j) { const int n = (lane >> 3) + 8 * j; const LAS float* s = scr + (8 * c) * 33 + n;
        v4u o; o.x = pk2(s[0 * 33], s[1 * 33]); o.y = pk2(s[2 * 33], s[3 * 33]); o.z = pk2(s[4 * 33], s[5 * 33]); o.w = pk2(s[6 * 33], s[7 * 33]);
        const int dr = map(n0 + n);
        *(v4u*)(WT + (size_t)dr * Kd + k0 + 8 * c) = o; }
    LDS_WAIT(); asm volatile("" ::: "memory");
}

DI void ph_cvt_mixer(const Params& p, int l, int gw, int NGW, int lane, LAS float* scr) {
    unsigned char* ws = p.ws;
    constexpr int I_IN = 16 * (IN_COLS / 32), I_O = 16 * 32, I_PA = 4 * 32, I_PB = 8 * 32, I_PC = 6 * 32, I_UQ = 4 * 18, I_UKV = 2 * 24;
    constexpr int NIT = I_IN + I_O + I_PA + I_PB + I_PC + I_UQ + I_UKV;
    for (int it = gw; it < NIT; it += NGW) {
        int r = it;
        if (r < I_IN) { cvt_item(p.in[1] + (size_t)l * DM * IN_COLS, IN_COLS, (bf16*)(ws + WM_IN), DM, nullptr, MapWin{}, scr, r, lane); continue; } r -= I_IN;
        if (r < I_O) { cvt_item(p.in[6] + (size_t)l * DM * DM, DM, (bf16*)(ws + WM_O), DM, nullptr, MapIdent{0}, scr, r, lane); continue; } r -= I_O;
        if (r < I_PA) { cvt_item(p.in[3] + (size_t)l * 256 * DM, DM, (bf16*)(ws + WM_PA), 256, nullptr, MapIdent{0}, scr, r, lane); continue; } r -= I_PA;
        if (r < I_PB) { cvt_item(p.in[4] + (size_t)l * 512 * DM, DM, (bf16*)(ws + WM_PB), 512, nullptr, MapIdent{0}, scr, r, lane); continue; } r -= I_PB;
        if (r < I_PC) { cvt_item(p.in[5] + (size_t)l * 384 * DM, DM, (bf16*)(ws + WM_PC), 384, nullptr, MapIdent{0}, scr, r, lane); continue; } r -= I_PC;
        if (r < I_UQ) { cvt_item(p.in[8] + (size_t)l * 256 * 576, 576, (bf16*)(ws + WM_UQ), 256, p.in[7] + l * 256, MapUq{}, scr, r, lane); continue; } r -= I_UQ;
        cvt_item(p.in[10] + (size_t)l * 128 * 768, 768, (bf16*)(ws + WM_UKV), 256, p.in[9] + l * 128, MapIdent{0}, scr, r, lane);
    }
    const v4u z = {0u, 0u, 0u, 0u};
    const int gt = gw * 64 + lane, NT = NGW * 64;
    for (int c = gt; c < 96 * 128; c += NT) *(v4u*)((bf16*)(ws + WM_IN) + (size_t)4256 * DM + (size_t)c * 8) = z;
    for (int c = gt; c < 192 * 32; c += NT) *(v4u*)((bf16*)(ws + WM_UQ) + (size_t)576 * 256 + (size_t)c * 8) = z;
    for (int c = gt; c < 768 * 16; c += NT) *(v4u*)((bf16*)(ws + WM_UKV) + (size_t)(c >> 4) * 256 + 128 + (c & 15) * 8) = z;
}
DI void ph_cvt_experts(const Params& p, int l, int gw, int NGW, int lane, LAS float* scr) {
    unsigned char* ws = p.ws;
    constexpr int IG = 16 * 16, IDN = 8 * 32, PER = 2 * IG + IDN;
    for (int it = gw; it < NEXP * PER; it += NGW) {
        const int e = it / PER; int r = it % PER;
        const size_t eo = ((size_t)l * NEXP + e) * DM * DEXP;
        if (r < IG) { cvt_item(p.in[19] + eo, DEXP, (bf16*)(ws + WS_WGU) + (size_t)e * 1024 * 1024, DM, nullptr, MapGate{}, scr, r, lane); continue; } r -= IG;
        if (r < IG) { cvt_item(p.in[20] + eo, DEXP, (bf16*)(ws + WS_WGU) + (size_t)e * 1024 * 1024, DM, nullptr, MapUp{}, scr, r, lane); continue; } r -= IG;
        cvt_item(p.in[21] + eo, DM, (bf16*)(ws + WS_WD) + (size_t)e * 1024 * 512, DEXP, nullptr, MapIdent{0}, scr, r, lane);
    }
}
DI void ph_rope_table(const Params& p, int gw, int NGW, int lane) {
    f32x2* tab = (f32x2*)(p.ws + WS_ROPE);
    for (int idx = gw * 64 + lane; idx < SEQ * 16; idx += NGW * 64) {
        const int pos = idx >> 4, i = idx & 15;
        double inv = 1.0; for (int j = 0; j < i; ++j) inv *= 0.56234132519034908;
        const double rev = (double)pos * inv * 0.15915494309189535;
        double fr = rev - floor(rev); if (fr >= 0.5) fr -= 1.0;
        const float f = (float)fr;
        tab[idx] = (f32x2){__builtin_amdgcn_cosf(f), __builtin_amdgcn_sinf(f)};
    }
}
DI void load_row(const float* xr, int lane, f32x4 (&v)[4]) {
#pragma unroll
    for (int j = 0; j < 4; ++j) v[j] = ((const f32x4*)xr)[lane + 64 * j];
}
DI float row_ss(const f32x4 (&v)[4]) {
    float s = 0.f;
#pragma unroll
    for (int j = 0; j < 4; ++j) s += (v[j].x * v[j].x + v[j].y * v[j].y) + (v[j].z * v[j].z + v[j].w * v[j].w);
    return wave_sum(s);
}
DI void store_row_bf16(bf16* orow, int lane, const f32x4 (&v)[4], float rs, const float* g) {
#pragma unroll
    for (int j = 0; j < 4; ++j) { const f32x4 gg = ((const f32x4*)g)[lane + 64 * j];
        v2u o; o.x = pk2(v[j].x * rs * gg.x, v[j].y * rs * gg.y); o.y = pk2(v[j].z * rs * gg.z, v[j].w * rs * gg.w);
        ((v2u*)orow)[lane + 64 * j] = o; }
}
DI void ph_rmsnorm(const float* x, const float* g, bf16* out, int gw, int NGW, int lane) {
    for (int m = gw; m < M; m += NGW) { f32x4 v[4]; load_row(x + (size_t)m * DM, lane, v);
        const float rs = rsqrtf(row_ss(v) * (1.0f / DM) + RMS_EPS);
        store_row_bf16(out + (size_t)m * DM, lane, v, rs, g); }
}
DI void ph_router(const Params& p, int l, int gw, int NGW, int lane) {
    const float* x1 = p.out; const float* g = p.in[16] + l * DM; const float* wr = p.in[17]; const float* rb = p.in[18];
    bf16* h = (bf16*)(p.ws + WS_U); int* list = (int*)(p.ws + WS_LIST); float* wl = (float*)(p.ws + WS_WLIST);
    unsigned* cnt = (unsigned*)(p.ws + WS_CTL) + CW_CNT + l * 64;
    for (int m = gw; m < M; m += NGW) {
        f32x4 v[4]; load_row(x1 + (size_t)m * DM, lane, v);
        const float rs = rsqrtf(row_ss(v) * (1.0f / DM) + RMS_EPS);
        float lg[16];
#pragma unroll
        for (int e = 0; e < 16; ++e) lg[e] = 0.f;
#pragma unroll
        for (int j = 0; j < 4; ++j) { const f32x4 gg = ((const f32x4*)g)[lane + 64 * j];
            const float hv[4] = {v[j].x * rs * gg.x, v[j].y * rs * gg.y, v[j].z * rs * gg.z, v[j].w * rs * gg.w};
            v2u o; o.x = pk2(hv[0], hv[1]); o.y = pk2(hv[2], hv[3]); ((v2u*)(h + (size_t)m * DM))[lane + 64 * j] = o;
#pragma unroll
            for (int c = 0; c < 4; ++c) { const f32x4* wrow = (const f32x4*)(wr + (size_t)(4 * lane + 256 * j + c) * 16);
#pragma unroll
                for (int q = 0; q < 4; ++q) { const f32x4 w = wrow[q]; lg[4 * q] += hv[c] * w.x; lg[4 * q + 1] += hv[c] * w.y; lg[4 * q + 2] += hv[c] * w.z; lg[4 * q + 3] += hv[c] * w.w; } } }
        float sc[16], bs[16];
#pragma unroll
        for (int e = 0; e < 16; ++e) { const float t = wave_sum(lg[e]); sc[e] = 1.0f / (1.0f + expf(-t)); bs[e] = sc[e] + rb[e]; }
        int bg = 0; float bgs = -1e30f; int i1 = 0, i2 = 1;
#pragma unroll
        for (int gI = 0; gI < 4; ++gI) {
            int a = 0; float av = bs[4 * gI];
#pragma unroll
            for (int i = 1; i < 4; ++i) if (bs[4 * gI + i] > av) { av = bs[4 * gI + i]; a = i; }
            int b = -1; float bv = -1e30f;
#pragma unroll
            for (int i = 0; i < 4; ++i) if (i != a && bs[4 * gI + i] > bv) { bv = bs[4 * gI + i]; b = i; }
            const float gs = av + bv;
            if (gs > bgs) { bgs = gs; bg = gI; i1 = a; i2 = b; }
        }
        const int e1 = bg * 4 + i1, e2 = bg * 4 + i2;
        float s1 = 0.f, s2 = 0.f;
#pragma unroll
        for (int e = 0; e < 16; ++e) { if (e == e1) s1 = sc[e]; if (e == e2) s2 = sc[e]; }
        const float inv = 1.0f / (s1 + s2);
        if (lane == 0) {
            const unsigned p1 = atomicAdd(cnt + e1, 1u), p2 = atomicAdd(cnt + e2, 1u);
            list[e1 * M + p1] = m * 2; wl[e1 * M + p1] = s1 * inv;
            list[e2 * M + p2] = m * 2 + 1; wl[e2 * M + p2] = s2 * inv;
        }
    }
}
DI void ph_combine(const Params& p, int l, int gw, int NGW, int lane) {
    float* x1 = p.out; const bf16* Y = (const bf16*)(p.ws + WS_Y); bf16* u = (bf16*)(p.ws + WS_U);
    const bool last = (l == DEPTH - 1); const float* g = last ? p.in[22] : p.in[2] + (l + 1) * DM;
    for (int m = gw; m < M; m += NGW) {
        f32x4 v[4]; load_row(x1 + (size_t)m * DM, lane, v);
#pragma unroll
        for (int j = 0; j < 4; ++j) { const v2u a = ((const v2u*)(Y + (size_t)(2 * m) * DM))[lane + 64 * j], b = ((const v2u*)(Y + (size_t)(2 * m + 1) * DM))[lane + 64 * j];
            v[j].x += bflo(a.x) + bflo(b.x); v[j].y += bfhi(a.x) + bfhi(b.x); v[j].z += bflo(a.y) + bflo(b.y); v[j].w += bfhi(a.y) + bfhi(b.y); }
        const float rs = rsqrtf(row_ss(v) * (1.0f / DM) + RMS_EPS);
        if (last) {
#pragma unroll
            for (int j = 0; j < 4; ++j) { const f32x4 gg = ((const f32x4*)g)[lane + 64 * j]; ((f32x4*)(x1 + (size_t)m * DM))[lane + 64 * j] = v[j] * rs * gg; }
        } else {
#pragma unroll
            for (int j = 0; j < 4; ++j) ((f32x4*)(x1 + (size_t)m * DM))[lane + 64 * j] = v[j];
            store_row_bf16(u + (size_t)m * DM, lane, v, rs, g);
        }
    }
}
DI void ph_amerge(const Params& p, int gw, int NGW, int lane) {
    const bf16* og = (const bf16*)(p.ws + WS_QKVA); const float* lse = (const float*)(p.ws + WS_LSE); bf16* oa = (bf16*)(p.ws + WS_OA);
    const int s = lane >> 4, d0 = (lane & 15) * 4;
    for (int t = gw; t < M; t += NGW) {
        const float l0 = lse[((size_t)0 * M + t) * 4 + s], l1 = lse[((size_t)1 * M + t) * 4 + s], l2 = lse[((size_t)2 * M + t) * 4 + s];
        const float mx = fmaxf(l0, fmaxf(l1, l2)); const float a0 = exp2f(l0 - mx), a1 = exp2f(l1 - mx), a2 = exp2f(l2 - mx); const float inv = 1.0f / (a0 + a1 + a2);
        const v2u x0 = *(const v2u*)(og + (size_t)t * PA + (0 * 4 + s) * 64 + d0), x1 = *(const v2u*)(og + (size_t)t * PA + (1 * 4 + s) * 64 + d0), x2 = *(const v2u*)(og + (size_t)t * PA + (2 * 4 + s) * 64 + d0);
        const float w0 = a0 * inv, w1 = a1 * inv, w2 = a2 * inv;
        v2u o; o.x = pk2(w0 * bflo(x0.x) + w1 * bflo(x1.x) + w2 * bflo(x2.x), w0 * bfhi(x0.x) + w1 * bfhi(x1.x) + w2 * bfhi(x2.x));
        o.y = pk2(w0 * bflo(x0.y) + w1 * bflo(x1.y) + w2 * bflo(x2.y), w0 * bfhi(x0.y) + w1 * bfhi(x1.y) + w2 * bfhi(x2.y));
        *(v2u*)(oa + (size_t)t * POA + s * 64 + d0) = o;
    }
}

DI void store8_bf16(bf16* dst, const float (&v)[8]) { v4u o; o.x = pk2(v[0], v[1]); o.y = pk2(v[2], v[3]); o.z = pk2(v[4], v[5]); o.w = pk2(v[6], v[7]); *(v4u*)dst = o; }
DI void rope4(float (&v)[8], const f32x2* tab, int pos, int i0) {
#pragma unroll
    for (int j = 0; j < 4; ++j) { const f32x2 cs = tab[pos * 16 + i0 + j]; const float t1 = v[2 * j], t2 = v[2 * j + 1]; v[2 * j] = t1 * cs.x - t2 * cs.y; v[2 * j + 1] = t1 * cs.y + t2 * cs.x; }
}
struct EpiProj {
    bf16* dst; int pitch, coff, mode; const f32x2* rope;
    DI void s8(int row, int col, float (&v)[8]) const {
        const int c = col - coff;
        if (mode == 0) {
#pragma unroll
            for (int i = 0; i < 8; ++i) v[i] *= C2A; }
        else if (mode == 2) { if (c >= KR_COL && c < KR_COL + 32) rope4(v, rope, row & (SEQ - 1), (c - KR_COL) >> 1); }
        else if (mode == 3) {
#pragma unroll
            for (int i = 0; i < 8; ++i) v[i] = sigmoidf_(v[i]); }
        store8_bf16(dst + (size_t)row * pitch + c, v);
    }
};
struct ProjDst { bf16 *qkva, *qkvb, *clat, *g; const f32x2* rope;
    DI EpiProj of(int col0) const {
        if (col0 < 2304) return EpiProj{qkva, PA, 0, col0 < 768 ? 0 : 1, rope};
        if (col0 < 3840) return EpiProj{qkvb, PB, 2304, col0 < 2816 ? 0 : 1, rope};
        if (col0 < 4352) return EpiProj{clat, PCL, 3840, col0 < 4096 ? 1 : 2, rope};
        return EpiProj{g, PG, 4352, 3, rope};
    }
};
struct EpiQc {
    bf16* qc; const float* ssq; const f32x2* rope;
    DI void s8(int row, int col, float (&v)[8]) const {
        if (col >= 576) return;
        const f32x4 pp = *(const f32x4*)(ssq + (size_t)row * 4); const float rs = rsqrtf(((pp.x + pp.y) + (pp.z + pp.w)) * (1.0f / 256.0f) + RMS_EPS);
#pragma unroll
        for (int i = 0; i < 8; ++i) v[i] *= rs;
        const int j = col % 96; if (j >= 64) rope4(v, rope, row & (SEQ - 1), (j - 64) >> 1);
#pragma unroll
        for (int i = 0; i < 8; ++i) v[i] *= C2C;
        store8_bf16(qc + (size_t)row * PQC + col, v);
    }
};
struct EpiKv {
    bf16* kvc; const float* ssq;
    DI void s8(int row, int col, float (&v)[8]) const {
        const f32x4 pp = *(const f32x4*)(ssq + (size_t)row * 4); const float rs = rsqrtf(((pp.x + pp.y) + (pp.z + pp.w)) * (1.0f / 128.0f) + RMS_EPS);
#pragma unroll
        for (int i = 0; i < 8; ++i) v[i] *= rs;
        store8_bf16(kvc + (size_t)row * PKV + col, v);
    }
};
struct EpiMerge {
    bf16* merged; const bf16* gate; bool first;
    DI void s8(int row, int col, float (&v)[8]) const {
        const v4u gw = *(const v4u*)(gate + (size_t)row * PG + col);
        float r[8] = {v[0] * bflo(gw.x), v[1] * bfhi(gw.x), v[2] * bflo(gw.y), v[3] * bfhi(gw.y), v[4] * bflo(gw.z), v[5] * bfhi(gw.z), v[6] * bflo(gw.w), v[7] * bfhi(gw.w)};
        bf16* dst = merged + (size_t)row * DM + col;
        if (!first) { const v4u o = *(const v4u*)dst; r[0] += bflo(o.x); r[1] += bfhi(o.x); r[2] += bflo(o.y); r[3] += bfhi(o.y); r[4] += bflo(o.z); r[5] += bfhi(o.z); r[6] += bflo(o.w); r[7] += bfhi(o.w); }
        store8_bf16(dst, r);
    }
};
struct EpiResid {
    const float* xin; float* xout;
    DI void s4(int row, int col, f32x4 v) const { const f32x4 b = *(const f32x4*)(xin + (size_t)row * DM + col); *(f32x4*)(xout + (size_t)row * DM + col) = b + v; }
};
struct EpiGateUp {
    bf16* act; const float* wl; int slot0;
    DI void s8(int row, int col, float (&v)[8]) const {
        const float w = wl[row];
        float a[4];
#pragma unroll
        for (int i = 0; i < 4; ++i) a[i] = v[i] / (1.0f + __expf(-v[i])) * v[4 + i] * w;
        v2u o; o.x = pk2(a[0], a[1]); o.y = pk2(a[2], a[3]);
        *(v2u*)(act + (size_t)(slot0 + row) * DEXP + (col >> 1)) = o;
    }
};
struct EpiDown {
    bf16* y; const int* list; int cnt;
    DI void s8(int row, int col, float (&v)[8]) const { if (row >= cnt) return; store8_bf16(y + (size_t)list[row] * DM + col, v); }
};
namespace pg8 {
typedef unsigned u32x4 __attribute__((ext_vector_type(4)));
constexpr int BM = 256, BK = 64, HALF = 128, HTB = HALF * BK * 2, STAGE_BYTES = 8 * HTB, NXCD = 8, WGM = 8;
__host__ __device__ __forceinline__ int lds_byte(int r, int c) { const int st = (r >> 4) * 2 + (c >> 5), rr = r & 15, cc = c & 31, ob = rr * 64 + cc * 2; return st * 1024 + (ob ^ (((ob >> 9) & 1) << 5)); }
__host__ __device__ __forceinline__ void stage_rc(int b, int& R, int& C) { const int st = b / 1024, sb = b % 1024, swz = sb ^ (((sb >> 9) & 1) << 5); R = (st >> 1) * 16 + swz / 64; C = (st & 1) * 32 + (swz % 64) / 2; }
__host__ __device__ __forceinline__ int perm32(int rho) { const int n = rho >> 4, i = rho & 15; return 8 * (i >> 2) + 4 * n + (i & 3); }

struct GUnit { const char* a; const char* b; int row0, col0, e, cnt, sb; };

struct TileOrder {
    int nM, nN, nwg, G, c;
    DI void init(int nM_, int nN_, int G_, int c_) { nM = nM_; nN = nN_; nwg = nM * nN; G = G_; c = c_; }
    DI bool tile(int i, int& pm, int& pn) const {
        const long L = (long)i * G + c; if (L >= nwg) return false;
        int wgid = (int)L; { const int q = nwg / NXCD, r = nwg % NXCD, xcd = wgid % NXCD, off = wgid / NXCD; wgid = (xcd < r ? xcd * (q + 1) : r * (q + 1) + (xcd - r) * q) + off; }
        const int nig = WGM * nN, gid = wgid / nig, fm = gid * WGM, gsz = (nM - fm) < WGM ? (nM - fm) : WGM;
        pm = fm + ((wgid % nig) % gsz); pn = (wgid % nig) / gsz; return true;
    }
};
struct DenseSched {
    static constexpr bool GATHER = false;
    TileOrder T; const char* A; const char* Bt; int lda, K;
    DI bool next(int i, GUnit& u) const { int pm, pn; if (!T.tile(i, pm, pn)) return false;
        u.a = A + (size_t)pm * BM * lda * 2; u.b = Bt + (size_t)pn * BM * K * 2; u.row0 = pm * BM; u.col0 = pn * BM; u.e = 0; u.cnt = BM; u.sb = 0; return true; }
    DI unsigned gather_off(const GUnit&, int, int) const { return 0u; }
};
template <bool GATH>
struct MoeSched {
    static constexpr bool GATHER = GATH;
    const unsigned* cnt; const int* list; const char* A; const char* Bt; int lda, K, nN, G, c; size_t bstride;
    DI bool next(int i, GUnit& u) const {
        const int L = i * G + c; int tl = L / nN; const int pn = L % nN; int sb = 0;
        for (int e = 0; e < NEXP; ++e) { const int ce = (int)__builtin_amdgcn_readfirstlane((int)cnt[e]); const int nt = (ce + 255) >> 8;
            if (tl < nt) { u.e = e; u.sb = sb; u.cnt = ce - tl * 256; u.row0 = tl * 256; u.col0 = pn * BM; u.b = Bt + (size_t)e * bstride + (size_t)pn * BM * K * 2;
                u.a = GATH ? A : A + (size_t)(sb + tl * 256) * lda * 2; return true; }
            tl -= nt; sb += nt * 256; }
        return false;
    }
    DI unsigned gather_off(const GUnit& u, int r, int C) const {
        const int lr = u.row0 + r; int tok = 0; if (r < u.cnt) tok = list[u.e * M + lr] >> 1;
        return (unsigned)(tok * lda + C) * 2u;
    }
};

DI unsigned cvt_pk_bf16(float lo, float hi) { unsigned r; asm volatile("v_cvt_pk_bf16_f32 %0, %1, %2" : "=v"(r) : "v"(lo), "v"(hi)); return r; }

template <class Mk>
struct Epi8 {
    static constexpr bool PERM = true;
    Mk mk;
    DI void operator()(const f32x4 (&acc)[2][2][4][2], const GUnit& u, int wr, int wc, int fr, int fq) const {
        asm volatile("" : "+v"(fr), "+v"(fq));
        const auto F = mk.make(u);
#pragma unroll
        for (int ai = 0; ai < 2; ++ai)
#pragma unroll
            for (int m = 0; m < 4; ++m) { const int row = u.row0 + ai * HALF + wr * 64 + m * 16 + fr;
#pragma unroll
                for (int bj = 0; bj < 2; ++bj) { const f32x4 a = acc[ai][bj][m][0], b = acc[ai][bj][m][1]; float v[8] = {a[0], a[1], a[2], a[3], b[0], b[1], b[2], b[3]};
                    F.s8(row, u.col0 + bj * HALF + wc * 32 + 8 * fq, v); }
                asm volatile("" ::: "memory"); }
        mk.extra(acc, u, wr, wc, fr, fq);
    }
};
template <class Mk>
struct Epi4 {
    static constexpr bool PERM = false;
    Mk mk;
    DI void operator()(const f32x4 (&acc)[2][2][4][2], const GUnit& u, int wr, int wc, int fr, int fq) const {
        asm volatile("" : "+v"(fr), "+v"(fq));
        const auto F = mk.make(u);
#pragma unroll
        for (int ai = 0; ai < 2; ++ai)
#pragma unroll
            for (int m = 0; m < 4; ++m) { const int row = u.row0 + ai * HALF + wr * 64 + m * 16 + fr;
#pragma unroll
                for (int bj = 0; bj < 2; ++bj)
#pragma unroll
                    for (int n = 0; n < 2; ++n) F.s4(row, u.col0 + bj * HALF + wc * 32 + 16 * n + 4 * fq, acc[ai][bj][m][n]);
                asm volatile("" ::: "memory"); }
    }
};

template <class Epi, class Sched>
__device__ __forceinline__ void gemm_phase(LAS unsigned char* lds, const Sched& S, const Epi& E) {
    constexpr bool GATHER = Sched::GATHER;
    int tid_ = threadIdx.x; asm volatile("" : "+v"(tid_));
    const int tid = tid_, wid = __builtin_amdgcn_readfirstlane(tid >> 6), lane = tid & 63, wr = wid >> 2, wc = wid & 3, fr = lane & 15, fq = lane >> 4;
    const int K = S.K, lda = S.lda, nt = K / BK;
    int sR[2], sC[2];
    unsigned voffA[2][2], voffB[2], nvoffA[2][2];
#pragma unroll
    for (int i = 0; i < 2; ++i) { stage_rc(tid * 16 + i * 8192, sR[i], sC[i]); const int Rb = Epi::PERM ? ((sR[i] & ~31) + perm32(sR[i] & 31)) : sR[i];
        voffA[0][i] = (unsigned)(sR[i] * lda + sC[i]) * 2u; voffA[1][i] = voffA[0][i]; nvoffA[0][i] = voffA[0][i]; nvoffA[1][i] = voffA[0][i]; voffB[i] = (unsigned)(Rb * K + sC[i]) * 2u; }
    const size_t kstep = (size_t)(BK * 2);
    const size_t hstepA = GATHER ? 0 : (size_t)HALF * lda * 2, hstepB = (size_t)HALF * K * 2;
    const unsigned ldsw = (unsigned)wid * 1024u;
    const int aoff = lds_byte(wr * 64 + fr, fq * 8), boff = lds_byte(wc * 32 + fr, fq * 8);
#define PG8_SA(b, h) (((b) * 2 + (h)) * HTB)
#define PG8_SB(b, h) ((4 + (b) * 2 + (h)) * HTB)
#define PG8_STAGE(bufoff, gbase, voff) do { _Pragma("unroll") for (int _i = 0; _i < 2; ++_i) \
        __builtin_amdgcn_global_load_lds((const unsigned*)((const char*)(gbase) + (voff)[_i]), (LAS unsigned*)(lds + (bufoff) + ldsw + _i * 8192), 16, 0, 0); } while (0)
#define PG8_LDA(dst, b, h) do { _Pragma("unroll") for (int m = 0; m < 4; ++m) _Pragma("unroll") for (int k = 0; k < 2; ++k) dst[m][k] = *(const LAS bf16x8*)(lds + PG8_SA(b, h) + aoff + m * 2048 + k * 1024); } while (0)
#define PG8_LDB(dst, b, h) do { _Pragma("unroll") for (int n = 0; n < 2; ++n) _Pragma("unroll") for (int k = 0; k < 2; ++k) dst[n][k] = *(const LAS bf16x8*)(lds + PG8_SB(b, h) + boff + n * 2048 + k * 1024); } while (0)
#define PG8_MMA(ai, bj, At, Bt) do { __builtin_amdgcn_s_setprio(1); _Pragma("unroll") for (int m = 0; m < 4; ++m) _Pragma("unroll") for (int n = 0; n < 2; ++n) _Pragma("unroll") for (int k = 0; k < 2; ++k) \
        acc[ai][bj][m][n] = __builtin_amdgcn_mfma_f32_16x16x32_bf16(Bt[n][k], At[m][k], acc[ai][bj][m][n], 0, 0, 0); __builtin_amdgcn_s_setprio(0); } while (0)
#define PG8_WAIT_V(n) asm volatile("s_waitcnt vmcnt(" #n ")" ::: "memory")
#define PG8_WAIT_L(n) asm volatile("s_waitcnt lgkmcnt(" #n ")" ::: "memory")
#define PG8_BAR __builtin_amdgcn_s_barrier()
#define PG8_SCHED __builtin_amdgcn_sched_barrier(0)
    GUnit cur, nxt; int ui = 0;
    if (!S.next(0, cur)) return;
    if constexpr (GATHER) {
#pragma unroll
        for (int h = 0; h < 2; ++h)
#pragma unroll
            for (int i = 0; i < 2; ++i) voffA[h][i] = S.gather_off(cur, h * HALF + sR[i], sC[i]);
    }
    f32x4 acc[2][2][4][2];
#pragma unroll
    for (int a = 0; a < 2; ++a)
#pragma unroll
        for (int b = 0; b < 2; ++b)
#pragma unroll
            for (int m = 0; m < 4; ++m)
#pragma unroll
                for (int n = 0; n < 2; ++n) acc[a][b][m][n] = (f32x4){0.f, 0.f, 0.f, 0.f};
    bf16x8 At[4][2], B0[2][2], B1[2][2];
    const char* cA = cur.a; const char* cB = cur.b;
    PG8_STAGE(PG8_SB(0, 0), cB, voffB); PG8_STAGE(PG8_SB(0, 1), cB + hstepB, voffB); PG8_STAGE(PG8_SA(0, 0), cA, voffA[0]); PG8_STAGE(PG8_SA(0, 1), cA + hstepA, voffA[1]);
    if (wr == 1) PG8_BAR;
    PG8_WAIT_V(2); PG8_BAR;
    PG8_STAGE(PG8_SB(1, 0), cB + kstep, voffB); PG8_STAGE(PG8_SA(1, 0), cA + kstep, voffA[0]); PG8_STAGE(PG8_SB(1, 1), cB + hstepB + kstep, voffB);
    PG8_WAIT_V(6); PG8_BAR;
    for (;;) {
        const bool has_next = S.next(ui + 1, nxt);
        const char* nA = has_next ? nxt.a : cA; const char* nB = has_next ? nxt.b : cB;
        if constexpr (GATHER) {
#pragma unroll
            for (int h = 0; h < 2; ++h)
#pragma unroll
                for (int i = 0; i < 2; ++i) nvoffA[h][i] = has_next ? S.gather_off(nxt, h * HALF + sR[i], sC[i]) : voffA[h][i];
        }
        for (int t = 0; t < nt; t += 2) {
            const bool last = (t == nt - 2);
            const char* a1 = cA + (size_t)(t + 1) * kstep;
            const char* a2 = last ? nA : cA + (size_t)(t + 2) * kstep; const char* b2 = last ? nB : cB + (size_t)(t + 2) * kstep;
            const char* a3 = a2 + kstep; const char* b3 = b2 + kstep;
            unsigned v2[2][2];
#pragma unroll
            for (int h = 0; h < 2; ++h)
#pragma unroll
                for (int i = 0; i < 2; ++i) v2[h][i] = (GATHER && last) ? nvoffA[h][i] : voffA[h][i];
            PG8_LDB(B0, 0, 0); PG8_LDB(B1, 0, 1); PG8_SCHED; PG8_LDA(At, 0, 0); PG8_STAGE(PG8_SA(1, 1), a1 + hstepA, voffA[1]);
            PG8_WAIT_V(8); PG8_WAIT_L(0); PG8_BAR; PG8_MMA(0, 0, At, B0); PG8_MMA(0, 1, At, B1); PG8_BAR; PG8_SCHED;
            PG8_LDA(At, 0, 1); PG8_STAGE(PG8_SB(0, 0), b2, voffB); PG8_STAGE(PG8_SB(0, 1), b2 + hstepB, voffB); PG8_STAGE(PG8_SA(0, 0), a2, v2[0]);
            PG8_WAIT_V(8); PG8_WAIT_L(0); PG8_BAR; PG8_MMA(1, 0, At, B0); PG8_MMA(1, 1, At, B1); PG8_BAR; PG8_SCHED;
            PG8_LDB(B0, 1, 0); PG8_LDB(B1, 1, 1); PG8_SCHED; PG8_LDA(At, 1, 0); PG8_STAGE(PG8_SA(0, 1), a2 + hstepA, v2[1]);
            PG8_WAIT_V(8); PG8_WAIT_L(0); PG8_BAR; PG8_MMA(0, 0, At, B0); PG8_MMA(0, 1, At, B1); PG8_BAR; PG8_SCHED;
            PG8_LDA(At, 1, 1); PG8_STAGE(PG8_SB(1, 0), b3, voffB); PG8_STAGE(PG8_SB(1, 1), b3 + hstepB, voffB); PG8_STAGE(PG8_SA(1, 0), a3, v2[0]);
            PG8_WAIT_V(8); PG8_WAIT_L(0); PG8_BAR; PG8_MMA(1, 0, At, B0); PG8_MMA(1, 1, At, B1); PG8_BAR; PG8_SCHED;
        }
        if (wr == 0) PG8_BAR;
        E(acc, cur, wr, wc, fr, fq);
        if (!has_next) break;
#pragma unroll
        for (int a = 0; a < 2; ++a)
#pragma unroll
            for (int b = 0; b < 2; ++b)
#pragma unroll
                for (int m = 0; m < 4; ++m)
#pragma unroll
                    for (int n = 0; n < 2; ++n) acc[a][b][m][n] = (f32x4){0.f, 0.f, 0.f, 0.f};
        cur = nxt; cA = nA; cB = nB; ++ui;
        if constexpr (GATHER) {
#pragma unroll
            for (int h = 0; h < 2; ++h)
#pragma unroll
                for (int i = 0; i < 2; ++i) voffA[h][i] = nvoffA[h][i];
        }
        if (wr == 1) PG8_BAR;
    }
    PG8_WAIT_V(0);
    PG8_BAR;
#undef PG8_SA
#undef PG8_SB
#undef PG8_STAGE
#undef PG8_LDA
#undef PG8_LDB
#undef PG8_MMA
#undef PG8_WAIT_V
#undef PG8_WAIT_L
#undef PG8_BAR
#undef PG8_SCHED
}
}
#ifndef ATT_MASK
#define ATT_MASK 7
#endif
namespace att {
typedef __bf16 bf16x2_t __attribute__((ext_vector_type(2)));
typedef short v4i16_t __attribute__((ext_vector_type(4)));
DI unsigned cvtpk(float lo, float hi) { f32x2 v = {lo, hi}; bf16x2_t b = __builtin_convertvector(v, bf16x2_t); return __builtin_bit_cast(unsigned, b); }
constexpr int BIGBAND = 1 << 28;

struct HJob {
    const bf16* q; int qpitch;
    const bf16* k; int kpitch;
    const bf16* k2; int k2pitch;
    const bf16* v; int vpitch;
    int qs0, ks0, kmax, ntiles, band; float slope2;
};

template <int DK, int DV>
struct Core {
    static constexpr int KSTR = DK * 2 + 16, VSTR = (DV == 128) ? 320 : 192;
    static constexpr int KBYTES = 64 * KSTR, VBYTES = 64 * VSTR, HBYTES = KBYTES + VBYTES;
    static constexpr int NDS = DK / 16, NC = DV / 32, KCH = DK / 32, VCH = DV / 32, KCPR = DK / 8, VCPR = DV / 8;

    static DI void run(LAS unsigned char* lds, const HJob& J, int nt_max, f32x16 (&o)[NC], float& m_out, float& l_out) {
        int tid_ = threadIdx.x; asm volatile("" : "+v"(tid_));
        const int tid = tid_, lane = tid & 63, r = lane & 31, h = lane >> 5;
        const int wave = __builtin_amdgcn_readfirstlane(tid >> 6), half = wave >> 2, wq = wave & 3, ht = tid & 255;
        LAS unsigned char* kl = lds + half * HBYTES; LAS unsigned char* vl = kl + KBYTES;
        bf16x8 qf[NDS];
        { const bf16* qp = J.q + (size_t)(32 * wq + r) * J.qpitch + 8 * h;
#pragma unroll
          for (int ds = 0; ds < NDS; ++ds) qf[ds] = *(const bf16x8*)(qp + 16 * ds); }
        v4u kreg[KCH], vreg[VCH];
#define ATT_ISSUE(kt) do { \
        _Pragma("unroll") for (int i = 0; i < KCH; ++i) { const int id = ht + 256 * i, row = id / KCPR, cc = id % KCPR; int idx = J.ks0 + 64 * (kt) + row; idx = idx < J.kmax ? idx : J.kmax; \
            const bf16* src = (DK == 96 && cc >= 8) ? J.k2 + (size_t)idx * J.k2pitch + (cc - 8) * 8 : J.k + (size_t)idx * J.kpitch + cc * 8; kreg[i] = *(const v4u*)src; } \
        _Pragma("unroll") for (int i = 0; i < VCH; ++i) { const int id = ht + 256 * i, row = id / VCPR, cc = id % VCPR; int idx = J.ks0 + 64 * (kt) + row; idx = idx < J.kmax ? idx : J.kmax; \
            vreg[i] = *(const v4u*)(J.v + (size_t)idx * J.vpitch + cc * 8); } } while (0)
#define ATT_COMMIT() do { \
        _Pragma("unroll") for (int i = 0; i < KCH; ++i) { const int id = ht + 256 * i, row = id / KCPR, cc = id % KCPR; *(LAS v4u*)(kl + row * KSTR + cc * 16) = kreg[i]; } \
        _Pragma("unroll") for (int i = 0; i < VCH; ++i) { const int id = ht + 256 * i, row = id / VCPR, cc = id % VCPR; *(LAS v4u*)(vl + row * VSTR + cc * 16) = vreg[i]; } } while (0)
        const int qidx = J.qs0 + 32 * wq + r, wq0 = J.qs0 + 32 * wq;
        float m = -1e30f, l = 0.f;
#pragma unroll
        for (int c = 0; c < NC; ++c)
#pragma unroll
            for (int i = 0; i < 16; ++i) o[c][i] = 0.f;
        if (0 < J.ntiles) ATT_ISSUE(0);
        const int koff = r * KSTR + 16 * h;
        const int voff = (4 * h + ((lane & 15) >> 2)) * VSTR + ((lane >> 4) & 1) * 32 + (lane & 3) * 8;
        for (int kt = 0; kt < nt_max; ++kt) {
            __syncthreads();
            if (kt < J.ntiles) ATT_COMMIT();
            __syncthreads();
            if (kt + 1 < J.ntiles) ATT_ISSUE(kt + 1);
            const int tk0 = J.ks0 + 64 * kt;
            if (kt < J.ntiles && tk0 <= wq0 + 31 && tk0 + 63 >= wq0 - J.band) {
                f32x16 p[2];
#pragma unroll
                for (int kb = 0; kb < 2; ++kb) { const float base = J.slope2 * (float)(tk0 + 32 * kb + 4 * h - qidx);
#pragma unroll
                    for (int i = 0; i < 16; ++i) p[kb][i] = base + J.slope2 * (float)((i & 3) + 8 * (i >> 2)); }
#pragma unroll
                for (int ds = 0; ds < NDS; ++ds)
                    { const bf16x8 kf0 = *(const LAS bf16x8*)(kl + koff + ds * 32), kf1 = *(const LAS bf16x8*)(kl + koff + 32 * KSTR + ds * 32);
                      p[0] = __builtin_amdgcn_mfma_f32_32x32x16_bf16(kf0, qf[ds], p[0], 0, 0, 0); p[1] = __builtin_amdgcn_mfma_f32_32x32x16_bf16(kf1, qf[ds], p[1], 0, 0, 0);
                      if (ds & 1) __builtin_amdgcn_sched_barrier(0); }
                if (tk0 + 63 > wq0 || tk0 < wq0 + 31 - J.band) {
#pragma unroll
                    for (int kb = 0; kb < 2; ++kb)
#pragma unroll
                        for (int i = 0; i < 16; ++i) { const int kidx = tk0 + 32 * kb + (i & 3) + 8 * (i >> 2) + 4 * h; const bool ok = (kidx <= qidx) && (qidx - kidx <= J.band); if (!ok) p[kb][i] = -INFINITY; }
                }
                float mx = fmaxf(p[0][0], p[1][0]);
#pragma unroll
                for (int i = 1; i < 16; ++i) mx = fmaxf(mx, fmaxf(p[0][i], p[1][i]));
                mx = fmaxf(mx, __shfl_xor(mx, 32));
                const float mn = fmaxf(m, mx), alpha = __builtin_amdgcn_exp2f(m - mn); m = mn;
                float rs = 0.f;
#pragma unroll
                for (int kb = 0; kb < 2; ++kb)
#pragma unroll
                    for (int i = 0; i < 16; ++i) { p[kb][i] = __builtin_amdgcn_exp2f(p[kb][i] - mn); rs += p[kb][i]; }
                l = l * alpha + rs;
#pragma unroll
                for (int c = 0; c < NC; ++c)
#pragma unroll
                    for (int i = 0; i < 16; ++i) o[c][i] *= alpha;
#pragma unroll
                for (int ks = 0; ks < 4; ++ks) { const int kb = ks >> 1, b0 = 8 * (ks & 1); v4u w;
                    w.x = cvtpk(p[kb][b0], p[kb][b0 + 1]); w.y = cvtpk(p[kb][b0 + 2], p[kb][b0 + 3]); w.z = cvtpk(p[kb][b0 + 4], p[kb][b0 + 5]); w.w = cvtpk(p[kb][b0 + 6], p[kb][b0 + 7]);
                    const bf16x8 pa = __builtin_bit_cast(bf16x8, w);
#pragma unroll
                    for (int c = 0; c < NC; ++c) {
                        const v4i16_t lo = __builtin_amdgcn_ds_read_tr16_b64_v4i16((LAS v4i16_t*)(vl + voff + (16 * ks) * VSTR + c * 64));
                        const v4i16_t hi = __builtin_amdgcn_ds_read_tr16_b64_v4i16((LAS v4i16_t*)(vl + voff + (16 * ks + 8) * VSTR + c * 64));
                        const bf16x8 vf = {lo[0], lo[1], lo[2], lo[3], hi[0], hi[1], hi[2], hi[3]};
                        o[c] = __builtin_amdgcn_mfma_f32_32x32x16_bf16(vf, pa, o[c], 0, 0, 0); }
                    __builtin_amdgcn_sched_barrier(0); }
            }
        }
#undef ATT_ISSUE
#undef ATT_COMMIT
        m_out = m; l_out = l + __shfl_xor(l, 32);
    }
    static DI void store_o(const f32x16 (&o)[NC], float inv, bf16* orow, int h) {
#pragma unroll
        for (int c = 0; c < NC; ++c)
#pragma unroll
            for (int g = 0; g < 4; ++g) { v2u w; w.x = cvtpk(o[c][4 * g] * inv, o[c][4 * g + 1] * inv); w.y = cvtpk(o[c][4 * g + 2] * inv, o[c][4 * g + 3] * inv);
                *(v2u*)(orow + 32 * c + 8 * g + 4 * h) = w; }
    }
};

constexpr int NJ_BC = 16 * 56, NJ_A0 = 256, NJ_A1 = 256, NJ_A2 = 256, NJOBS = NJ_BC + NJ_A0 + NJ_A1 + NJ_A2;

DI void phase(const Params& p, int l, LAS unsigned char* lds, volatile LAS unsigned* jobw, unsigned* ctr) {
    unsigned char* ws = p.ws;
    const int tid0 = threadIdx.x;
    for (int it = 0;; ++it) {
        int tid = tid0; asm volatile("" : "+v"(tid));
        const int lane = tid & 63, r = lane & 31, h = lane >> 5, wave = __builtin_amdgcn_readfirstlane(tid >> 6), half = wave >> 2, wq = wave & 3;
        if (tid0 == 0) jobw[it & 1] = atomicAdd(ctr, 1u);
        __syncthreads();
        const int idx = __builtin_amdgcn_readfirstlane((int)jobw[it & 1]);
        if (idx >= NJOBS) break;
        if (idx < NJ_BC) {
            const int qb = 15 - idx / 56, rr = idx % 56;
            if (rr < 32) { if (!(ATT_MASK & 2)) continue;
                const int b = rr >> 2, hd = rr & 3, mp = half; const size_t t0 = (size_t)b * SEQ;
                bf16* base = (bf16*)(ws + WS_QKVB);
                HJob J; J.q = base + (t0 + 128 * qb) * PB + (2 * hd + mp) * 64; J.qpitch = PB; J.k = base + t0 * PB + 512 + (2 * hd + mp) * 64; J.kpitch = PB; J.k2 = nullptr; J.k2pitch = 0;
                J.v = base + t0 * PB + 1024 + hd * 128; J.vpitch = PB; J.qs0 = 128 * qb; J.ks0 = 0; J.kmax = SEQ - 1; J.ntiles = 2 * (qb + 1); J.band = BIGBAND; J.slope2 = alibi_b(hd) * LOG2E;
                f32x16 o[4]; float m, ls; Core<64, 128>::run(lds, J, J.ntiles, o, m, ls);
                const float inv = 1.0f / ls;
                LAS float* ex = (LAS float*)lds;
                __syncthreads();
                if (half == 1) {
#pragma unroll
                    for (int c = 0; c < 4; ++c)
#pragma unroll
                        for (int i = 0; i < 16; ++i) ex[((wq * 4 + c) * 16 + i) * 64 + lane] = o[c][i] * inv;
                }
                __syncthreads();
                if (half == 0) {
                    const float lam = lam_of(p, l, lane); float ssq = 0.f;
#pragma unroll
                    for (int c = 0; c < 4; ++c)
#pragma unroll
                        for (int i = 0; i < 16; ++i) { const float d = o[c][i] * inv - lam * ex[((wq * 4 + c) * 16 + i) * 64 + lane]; o[c][i] = d; ssq += d * d; }
                    ssq += __shfl_xor(ssq, 32);
                    const float rs = rsqrtf(ssq * (1.0f / 128.0f) + RMS_EPS) * (1.0f - lam_init_of(l));
                    const float* gs = p.in[15] + l * 128;
#pragma unroll
                    for (int c = 0; c < 4; ++c)
#pragma unroll
                        for (int g = 0; g < 4; ++g) { const f32x4 gg = *(const f32x4*)(gs + 32 * c + 8 * g + 4 * h);
                            o[c][4 * g] *= gg.x; o[c][4 * g + 1] *= gg.y; o[c][4 * g + 2] *= gg.z; o[c][4 * g + 3] *= gg.w; }
                    Core<64, 128>::store_o(o, rs, base + (t0 + 128 * qb + 32 * wq + r) * PB + hd * 128, h);
                }
            } else { if (!(ATT_MASK & 4)) continue;
                const int r2 = rr - 32, b = r2 / 3, hh = 2 * (r2 % 3) + half; const size_t t0 = (size_t)b * SEQ;
                const bf16* kv = (const bf16*)(ws + WS_KVC) + t0 * PKV + hh * 128;
                HJob J; J.q = (const bf16*)(ws + WS_QC) + (t0 + 128 * qb) * PQC + hh * 96; J.qpitch = PQC; J.k = kv; J.kpitch = PKV; J.k2 = (const bf16*)(ws + WS_CLAT) + t0 * PCL + KR_COL; J.k2pitch = PCL;
                J.v = kv + 64; J.vpitch = PKV; J.qs0 = 128 * qb; J.ks0 = 0; J.kmax = SEQ - 1; J.ntiles = 2 * (qb + 1); J.band = BIGBAND; J.slope2 = 0.f;
                f32x16 o[2]; float m, ls; Core<96, 64>::run(lds, J, J.ntiles, o, m, ls);
                Core<96, 64>::store_o(o, 1.0f / ls, (bf16*)(ws + WS_OC) + (t0 + 128 * qb + 32 * wq + r) * POC + hh * 64, h);
            }
        } else { if (!(ATT_MASK & 1)) continue;
            int a = idx - NJ_BC, g, c, qb, b, sp;
            if (a < NJ_A0) { g = 0; c = 0; b = a >> 5; sp = (a >> 4) & 1; qb = a & 15; }
            else if (a < NJ_A0 + NJ_A1) { a -= NJ_A0; g = 1; b = a >> 5; sp = (a >> 4) & 1; c = (a >> 2) & 3; qb = a & 3; }
            else { a -= NJ_A0 + NJ_A1; g = 2; b = a >> 5; sp = (a >> 4) & 1; c = a & 15; qb = 0; }
            const int dil = g == 0 ? 1 : (g == 1 ? 4 : 16), L = SEQ / dil, hh = g * 4 + 2 * sp + half; const size_t t0 = (size_t)b * SEQ;
            bf16* base = (bf16*)(ws + WS_QKVA) + (t0 + c) * PA + hh * 64;
            HJob J; J.q = base + (size_t)(128 * qb) * dil * PA; J.qpitch = dil * PA; J.k = base + 768; J.kpitch = dil * PA; J.k2 = nullptr; J.k2pitch = 0; J.v = base + 1536; J.vpitch = dil * PA;
            J.qs0 = 128 * qb; J.ks0 = qb == 0 ? 0 : 128 * qb - 128; J.kmax = L - 1; J.ntiles = qb == 0 ? 2 : 4; J.band = 128; J.slope2 = alibi_a(hh) * LOG2E * (float)dil;
            f32x16 o[2]; float m, ls; Core<64, 64>::run(lds, J, J.ntiles, o, m, ls);
            const int qi = 128 * qb + 32 * wq + r;
            Core<64, 64>::store_o(o, 1.0f / ls, base + (size_t)qi * dil * PA, h);
            if (h == 0) ((float*)(ws + WS_LSE))[((size_t)g * M + t0 + c + (size_t)qi * dil) * 4 + (2 * sp + half)] = m + log2f(ls);
        }
    }
}
}
struct MkProj {
    ProjDst D; float* ssq_q; float* ssq_kv;
    DI EpiProj make(const pg8::GUnit& u) const { return D.of(u.col0); }
    DI void extra(const f32x4 (&acc)[2][2][4][2], const pg8::GUnit& u, int wr, int wc, int fr, int fq) const {
        if (u.col0 != 3840 && u.col0 != 4096) return;
        const bool kv = (u.col0 == 4096); float* dst = kv ? ssq_kv : ssq_q;
#pragma unroll
        for (int ai = 0; ai < 2; ++ai)
#pragma unroll
            for (int m = 0; m < 4; ++m) { float s = 0.f;
#pragma unroll
                for (int bj = 0; bj < 2; ++bj) { if (kv && bj == 1) continue;
#pragma unroll
                    for (int n = 0; n < 2; ++n)
#pragma unroll
                        for (int c = 0; c < 4; ++c) { const float r = bf2f((unsigned short)f2bf(acc[ai][bj][m][n][c])); s += r * r; } }
                s += __shfl_xor(s, 16); s += __shfl_xor(s, 32);
                if (fq == 0) dst[(size_t)(u.row0 + ai * 128 + wr * 64 + m * 16 + fr) * 4 + wc] = s; }
    }
};
template <class F> struct MkPlain { F E; DI F make(const pg8::GUnit&) const { return E; } DI void extra(const f32x4 (&)[2][2][4][2], const pg8::GUnit&, int, int, int, int) const {} };
struct MkGateUp { bf16* act; const float* wl;
    DI EpiGateUp make(const pg8::GUnit& u) const { return EpiGateUp{act, wl + u.e * M, u.sb}; }
    DI void extra(const f32x4 (&)[2][2][4][2], const pg8::GUnit&, int, int, int, int) const {} };
struct MkDown { bf16* y; const int* list;
    DI EpiDown make(const pg8::GUnit& u) const { return EpiDown{y, list + u.e * M, u.row0 + u.cnt}; }
    DI void extra(const f32x4 (&)[2][2][4][2], const pg8::GUnit&, int, int, int, int) const {} };

struct NAJob { const bf16* q; const bf16* k; int kstride; const bf16* k2; int k2stride; const bf16* v; int vstride; int dk1, dk2, dv, nkeys, dil; float bias2; };
DI void naive_attend(const NAJob& J, LAS float* sq, LAS float* ss, int lane, float& o0, float& o1, float& lse2) {
    for (int d = lane; d < J.dk1 + J.dk2; d += 64) sq[d] = bf2f(J.q[d]);
    LDS_WAIT(); asm volatile("" ::: "memory");
    float mx = -1e30f;
    for (int j = lane; j < J.nkeys; j += 64) {
        const bf16* kr = J.k - (ptrdiff_t)j * J.dil * J.kstride; float s = 0.f;
        for (int c = 0; c < J.dk1; c += 8) { const v4u w = *(const v4u*)(kr + c); s += sq[c] * bflo(w.x) + sq[c + 1] * bfhi(w.x) + sq[c + 2] * bflo(w.y) + sq[c + 3] * bfhi(w.y) + sq[c + 4] * bflo(w.z) + sq[c + 5] * bfhi(w.z) + sq[c + 6] * bflo(w.w) + sq[c + 7] * bfhi(w.w); }
        if (J.dk2) { const bf16* k2 = J.k2 - (ptrdiff_t)j * J.dil * J.k2stride; for (int c = 0; c < J.dk2; c += 8) { const v4u w = *(const v4u*)(k2 + c); const LAS float* q2 = sq + J.dk1 + c; s += q2[0] * bflo(w.x) + q2[1] * bfhi(w.x) + q2[2] * bflo(w.y) + q2[3] * bfhi(w.y) + q2[4] * bflo(w.z) + q2[5] * bfhi(w.z) + q2[6] * bflo(w.w) + q2[7] * bfhi(w.w); } }
        s += J.bias2 * (float)j; ss[j] = s; mx = fmaxf(mx, s);
    }
    mx = wave_max(mx); float l = 0.f;
    for (int j = lane; j < J.nkeys; j += 64) { const float pv = exp2f(ss[j] - mx); ss[j] = pv; l += pv; }
    l = wave_sum(l);
    LDS_WAIT(); asm volatile("" ::: "memory");
    float a0 = 0.f, a1 = 0.f;
    for (int j = 0; j < J.nkeys; ++j) { const bf16* vr = J.v - (ptrdiff_t)j * J.dil * J.vstride; const float pj = ss[j]; a0 += pj * bf2f(vr[lane]); if (J.dv > 64) a1 += pj * bf2f(vr[64 + lane]); }
    LDS_WAIT(); asm volatile("" ::: "memory");
    o0 = a0 / l; o1 = a1 / l; lse2 = mx + log2f(l);
}
DI void nattn_a(const Params& p, int idx, LAS float* sq, LAS float* ss, int lane) {
    unsigned char* ws = p.ws;
    const int t = idx / 12, hh = idx % 12, g = hh >> 2, s = hh & 3, tp = t & (SEQ - 1), dil = g == 0 ? 1 : (g == 1 ? 4 : 16);
    bf16* base = (bf16*)(ws + WS_QKVA) + (size_t)t * PA + hh * 64; int nk = tp / dil + 1; if (nk > 129) nk = 129;
    NAJob J{base, base + 768, PA, nullptr, 0, base + 1536, PA, 64, 0, 64, nk, dil, -alibi_a(hh) * LOG2E * (float)dil};
    float o0, o1, lse; naive_attend(J, sq, ss, lane, o0, o1, lse);
    base[lane] = (bf16)f2bf(o0); if (lane == 0) ((float*)(ws + WS_LSE))[((size_t)g * M + t) * 4 + s] = lse;
}
DI void nattn_b(const Params& p, int l, int idx, LAS float* sq, LAS float* ss, int lane) {
    unsigned char* ws = p.ws;
    const int t = idx >> 2, h = idx & 3, tp = t & (SEQ - 1);
    bf16* row = (bf16*)(ws + WS_QKVB) + (size_t)t * PB; float oa[2][2];
#pragma unroll
    for (int mp = 0; mp < 2; ++mp) { NAJob J{row + (2 * h + mp) * 64, row + 512 + (2 * h + mp) * 64, PB, nullptr, 0, row + 1024 + h * 128, PB, 64, 0, 128, tp + 1, 1, -alibi_b(h) * LOG2E};
        float lse; naive_attend(J, sq, ss, lane, oa[mp][0], oa[mp][1], lse); }
    const float lam = lam_of(p, l, lane); const float d0 = oa[0][0] - lam * oa[1][0], d1 = oa[0][1] - lam * oa[1][1];
    const float rs = rsqrtf(wave_sum(d0 * d0 + d1 * d1) * (1.0f / 128.0f) + RMS_EPS) * (1.0f - lam_init_of(l));
    const float* gs = p.in[15] + l * 128;
    row[h * 128 + lane] = (bf16)f2bf(d0 * rs * gs[lane]); row[h * 128 + 64 + lane] = (bf16)f2bf(d1 * rs * gs[64 + lane]);
}
DI void nattn_c(const Params& p, int idx, LAS float* sq, LAS float* ss, int lane) {
    unsigned char* ws = p.ws;
    const int t = idx / 6, h = idx % 6, tp = t & (SEQ - 1);
    const bf16* kv = (const bf16*)(ws + WS_KVC) + (size_t)t * PKV + h * 128;
    NAJob J{(const bf16*)(ws + WS_QC) + (size_t)t * PQC + h * 96, kv, PKV, (const bf16*)(ws + WS_CLAT) + (size_t)t * PCL + KR_COL, PCL, kv + 64, PKV, 64, 32, 64, tp + 1, 1, 0.f};
    float o0, o1, lse; naive_attend(J, sq, ss, lane, o0, o1, lse);
    ((bf16*)(ws + WS_OC))[(size_t)t * POC + h * 64 + lane] = (bf16)f2bf(o0);
}

#define XB_TMO      128
#define XB_XCNT(j)  (256  + 64 * (j))
#define XB_XSUB(j)  (1280 + 64 * (j))
#define XB_XGEN(j)  (2304 + 64 * (j))
#define XB_TOP      3328
#define XB_TOPGEN   3392
#define XCD_BAR_WORDS 3456
#define XB_SPIN_CAP (1u << 18)
__device__ __forceinline__ unsigned xb_ld(unsigned* p)              { return __hip_atomic_load(p, __ATOMIC_RELAXED, __HIP_MEMORY_SCOPE_AGENT); }
__device__ __forceinline__ unsigned xb_add(unsigned* p, unsigned v) { return __hip_atomic_fetch_add(p, v, __ATOMIC_RELAXED, __HIP_MEMORY_SCOPE_AGENT); }
__device__ __forceinline__ unsigned xb_xcc_id() { return (unsigned)__builtin_amdgcn_s_getreg((3 << 11) | 20) & 0xFu; }
#define XB_SPIN(cond, bar) do { unsigned _sp = 0; while (cond) { __builtin_amdgcn_s_sleep(1); \
    if ((++_sp & 255u) == 0u) { if (xb_ld(&(bar)[XB_TMO])) break; if (_sp > XB_SPIN_CAP) { atomicAdd(&(bar)[XB_TMO], 1u); break; } } } } while (0)
struct XcdBarrier { unsigned* bar; unsigned x; volatile LAS unsigned* st; };
__device__ __forceinline__ XcdBarrier xcd_barrier_post(unsigned* bar, volatile LAS unsigned* st) {
    XcdBarrier b; b.bar = bar; b.x = xb_xcc_id(); b.st = st;
    if (threadIdx.x == 0) (void)xb_add(&bar[XB_XCNT(b.x)], 1u);
    return b;
}
__device__ __forceinline__ void xcd_barrier_complete(unsigned* bar, unsigned x, unsigned& nloc, unsigned& nx) {
    const unsigned G = gridDim.x * gridDim.y * gridDim.z;
    unsigned sum, cnt, mine, sp = 0u;
    for (;;) {
        sum = 0u; cnt = 0u; mine = 0u;
#pragma unroll
        for (unsigned j = 0; j < 16; ++j) { const unsigned c = xb_ld(&bar[XB_XCNT(j)]); sum += c; cnt += (c > 0u) ? 1u : 0u; mine = (j == x) ? c : mine; }
        if (sum == G) break;
        __builtin_amdgcn_s_sleep(1);
        if ((++sp & 255u) == 0u) { if (xb_ld(&bar[XB_TMO])) break; if (sp > XB_SPIN_CAP) { atomicAdd(&bar[XB_TMO], 1u); break; } }
    }
    nloc = mine > 0u ? mine : 1u; nx = cnt > 0u ? cnt : 1u;
}
__device__ __forceinline__ void xcd_barrier(const XcdBarrier& b) {
    asm volatile("s_waitcnt vmcnt(0)" ::: "memory");
    __syncthreads();
    if (threadIdx.x == 0) {
        unsigned* bar = b.bar;
        __builtin_amdgcn_s_waitcnt(0);
        unsigned nloc = b.st[0], nx = b.st[1];
        if (nloc == 0u) { xcd_barrier_complete(bar, b.x, nloc, nx); b.st[0] = nloc; b.st[1] = nx; }
        const unsigned old = xb_add(&bar[XB_XSUB(b.x)], 1u);
        const unsigned gen = old / nloc;
        if (old + 1u == (gen + 1u) * nloc) {
            __builtin_amdgcn_fence(__ATOMIC_RELEASE, "agent");
            asm volatile("s_waitcnt vmcnt(0)" ::: "memory");
            const unsigned og = xb_add(&bar[XB_TOP], 1u);
            const unsigned tg = og / nx;
            if (og + 1u == (tg + 1u) * nx) xb_add(&bar[XB_TOPGEN], 1u);
            else XB_SPIN(xb_ld(&bar[XB_TOPGEN]) == tg, bar);
            __builtin_amdgcn_fence(__ATOMIC_ACQUIRE, "agent");
            xb_add(&bar[XB_XGEN(b.x)], 1u);
            asm volatile("s_waitcnt vmcnt(0)" ::: "memory");
        } else {
            XB_SPIN(xb_ld(&bar[XB_XGEN(b.x)]) == gen, bar);
            __builtin_amdgcn_fence(__ATOMIC_ACQUIRE, "agent");
            asm volatile("s_waitcnt vmcnt(0)" ::: "memory");
        }
    }
    __syncthreads();
}

constexpr int NWAVES = 8;
constexpr int RING_BYTES = 131072, MISC_OFF = RING_BYTES, LDS_BYTES = 147456;
#ifndef PH_MASK
#define PH_MASK 0x7ff
#endif
#define PH_EN(k) (((PH_MASK) >> (k)) & 1)
#ifndef MK_PER_PHASE
#define MK_PER_PHASE 0
#endif
constexpr int N_PHASES = 1 + DEPTH * 10;
struct Args { Params p; int ph_lo, ph_hi; };

DI unsigned long long rf64(unsigned long long v) { const unsigned lo = __builtin_amdgcn_readfirstlane((unsigned)v), hi = __builtin_amdgcn_readfirstlane((unsigned)(v >> 32)); return ((unsigned long long)hi << 32) | lo; }
DI Params load_params(LAS const unsigned long long* PT) { Params p;
#pragma unroll
    for (int i = 0; i < 23; ++i) p.in[i] = (const float*)rf64(PT[i]);
    p.out = (float*)rf64(PT[23]); p.ws = (unsigned char*)rf64(PT[24]); return p; }
__global__ void __launch_bounds__(NWAVES * 64, 2) mega_fwd(Args args) {
    extern __shared__ __attribute__((aligned(16))) unsigned char lds_raw[];
    LAS unsigned char* lds = (LAS unsigned char*)lds_raw;
    const int tid = threadIdx.x, lane0 = tid & 63, wave0 = __builtin_amdgcn_readfirstlane(tid >> 6);
    LAS unsigned long long* PT = (LAS unsigned long long*)(lds + MISC_OFF + 256);
    if (tid < 23) PT[tid] = (unsigned long long)args.p.in[tid];
    if (tid == 23) PT[23] = (unsigned long long)args.p.out;
    if (tid == 24) PT[24] = (unsigned long long)args.p.ws;
    const int G0 = gridDim.x;
    volatile LAS unsigned* MISC = (volatile LAS unsigned*)(lds + MISC_OFF);
    if (tid < 64) MISC[tid] = 0u;
    __syncthreads();
    XcdBarrier bar; { unsigned* ctl0 = (unsigned*)((unsigned char*)rf64(PT[24]) + WS_CTL); bar.bar = ctl0 + CW_BAR; bar.x = 0; bar.st = nullptr;
        if (!MK_PER_PHASE) bar = xcd_barrier_post(ctl0 + CW_BAR, MISC + 8); }
#define LOADP() int lane = lane0, wave = wave0, G = G0, bid = (int)blockIdx.x; asm volatile("" : "+v"(lane)); asm volatile("" : "+s"(wave), "+s"(G), "+s"(bid)); \
    const int gw = bid * NWAVES + wave, NGW = G * NWAVES; LAS float* const scr = (LAS float*)(lds + wave * 16384); (void)gw; (void)NGW; (void)scr; (void)lane; \
    const Params p = load_params(PT); unsigned char* const ws = p.ws; unsigned* const ctl = (unsigned*)(ws + WS_CTL); const f32x2* const rope = (const f32x2*)(ws + WS_ROPE); (void)ctl; (void)rope
    const int lo = args.ph_lo, hi = args.ph_hi;
#define IN(k) (lo <= (k) && (k) < hi)
#define SEAM(k) do { if (IN(k) && IN((k) + 1)) xcd_barrier(bar); } while (0)

    if (PH_EN(0) && IN(0)) { LOADP(); ph_cvt_mixer(p, 0, gw, NGW, lane, scr); ph_rope_table(p, gw, NGW, lane); ph_rmsnorm(p.in[0], p.in[2], (bf16*)(ws + WS_U), gw, NGW, lane); }
    SEAM(0);
    for (int l = 0; l < DEPTH; ++l) {
        const int P = 1 + l * 10;
        if (PH_EN(1) && IN(P + 0)) { LOADP();
            pg8::DenseSched S; S.T.init(M / 256, NPROJ / 256, G, bid); S.A = (const char*)(ws + WS_U); S.Bt = (const char*)(ws + WM_IN); S.lda = DM; S.K = DM;
            pg8::Epi8<MkProj> E{MkProj{ProjDst{(bf16*)(ws + WS_QKVA), (bf16*)(ws + WS_QKVB), (bf16*)(ws + WS_CLAT), (bf16*)(ws + WS_G), rope}, (float*)(ws + WS_SSQQ), (float*)(ws + WS_SSQKV)}};
            pg8::gemm_phase(lds, S, E);
        }
        SEAM(P + 0);
        if (PH_EN(2) && IN(P + 1)) { LOADP();
            { pg8::DenseSched S; S.T.init(M / 256, 3, G, bid); S.A = (const char*)(ws + WS_CLAT); S.Bt = (const char*)(ws + WM_UQ); S.lda = PCL; S.K = 256;
              pg8::Epi8<MkPlain<EpiQc>> E{MkPlain<EpiQc>{EpiQc{(bf16*)(ws + WS_QC), (const float*)(ws + WS_SSQQ), rope}}};
              pg8::gemm_phase(lds, S, E); }
            { pg8::DenseSched S; S.T.init(M / 256, 3, G, bid); S.A = (const char*)(ws + WS_CLAT) + 512; S.Bt = (const char*)(ws + WM_UKV); S.lda = PCL; S.K = 256;
              pg8::Epi8<MkPlain<EpiKv>> E{MkPlain<EpiKv>{EpiKv{(bf16*)(ws + WS_KVC), (const float*)(ws + WS_SSQKV)}}};
              pg8::gemm_phase(lds, S, E); }
        }
        SEAM(P + 1);
        if (PH_EN(3) && IN(P + 2)) { LOADP();
            att::phase(p, l, lds, MISC + 16, ctl + CW_ATTN + l * 64);
            if (ATT_MASK != 7) { __syncthreads(); LAS float* sq = scr; LAS float* ss = scr + 128;
                if (!(ATT_MASK & 1)) for (int idx = gw; idx < M * 12; idx += NGW) nattn_a(p, idx, sq, ss, lane);
                if (!(ATT_MASK & 2)) for (int idx = gw; idx < M * 4; idx += NGW) nattn_b(p, l, idx, sq, ss, lane);
                if (!(ATT_MASK & 4)) for (int idx = gw; idx < M * 6; idx += NGW) nattn_c(p, idx, sq, ss, lane); }
        }
        SEAM(P + 2);
        if (PH_EN(4) && IN(P + 3)) { LOADP(); ph_amerge(p, gw, NGW, lane); }
        SEAM(P + 3);
        if (PH_EN(5) && IN(P + 4)) { LOADP();
            { pg8::DenseSched S; S.T.init(M / 256, 4, G, bid); S.A = (const char*)(ws + WS_OA); S.Bt = (const char*)(ws + WM_PA); S.lda = POA; S.K = 256;
              pg8::Epi8<MkPlain<EpiMerge>> E{MkPlain<EpiMerge>{EpiMerge{(bf16*)(ws + WS_MERGED), (const bf16*)(ws + WS_G), true}}};
              pg8::gemm_phase(lds, S, E); }
            { pg8::DenseSched S; S.T.init(M / 256, 4, G, bid); S.A = (const char*)(ws + WS_QKVB); S.Bt = (const char*)(ws + WM_PB); S.lda = PB; S.K = 512;
              pg8::Epi8<MkPlain<EpiMerge>> E{MkPlain<EpiMerge>{EpiMerge{(bf16*)(ws + WS_MERGED), (const bf16*)(ws + WS_G) + 1024, false}}};
              pg8::gemm_phase(lds, S, E); }
            { pg8::DenseSched S; S.T.init(M / 256, 4, G, bid); S.A = (const char*)(ws + WS_OC); S.Bt = (const char*)(ws + WM_PC); S.lda = POC; S.K = 384;
              pg8::Epi8<MkPlain<EpiMerge>> E{MkPlain<EpiMerge>{EpiMerge{(bf16*)(ws + WS_MERGED), (const bf16*)(ws + WS_G) + 2048, false}}};
              pg8::gemm_phase(lds, S, E); }
        }
        SEAM(P + 4);
        if (PH_EN(6) && IN(P + 5)) { LOADP();
            pg8::DenseSched S; S.T.init(M / 256, 4, G, bid); S.A = (const char*)(ws + WS_MERGED); S.Bt = (const char*)(ws + WM_O); S.lda = DM; S.K = DM;
            pg8::Epi4<MkPlain<EpiResid>> E{MkPlain<EpiResid>{EpiResid{l == 0 ? p.in[0] : p.out, p.out}}};
            pg8::gemm_phase(lds, S, E);
        }
        SEAM(P + 5);
        if (PH_EN(7) && IN(P + 6)) { LOADP(); ph_router(p, l, gw, NGW, lane); ph_cvt_experts(p, l, gw, NGW, lane, scr); }
        SEAM(P + 6);
        if (PH_EN(8) && IN(P + 7)) { LOADP();
            const unsigned* cnt = ctl + CW_CNT + l * 64;
            pg8::MoeSched<true> S{cnt, (const int*)(ws + WS_LIST), (const char*)(ws + WS_U), (const char*)(ws + WS_WGU), DM, DM, 4, G, bid, (size_t)1024 * 1024 * 2};
            pg8::Epi8<MkGateUp> E{MkGateUp{(bf16*)(ws + WS_ACT), (const float*)(ws + WS_WLIST)}};
            pg8::gemm_phase(lds, S, E);
        }
        SEAM(P + 7);
        if (PH_EN(9) && IN(P + 8)) { LOADP();
            const unsigned* cnt = ctl + CW_CNT + l * 64;
            pg8::MoeSched<false> S{cnt, (const int*)(ws + WS_LIST), (const char*)(ws + WS_ACT), (const char*)(ws + WS_WD), DEXP, DEXP, 4, G, bid, (size_t)1024 * 512 * 2};
            pg8::Epi8<MkDown> E{MkDown{(bf16*)(ws + WS_Y), (const int*)(ws + WS_LIST)}};
            pg8::gemm_phase(lds, S, E);
        }
        SEAM(P + 8);
        if (PH_EN(10) && IN(P + 9)) { LOADP(); ph_combine(p, l, gw, NGW, lane); if (l + 1 < DEPTH) ph_cvt_mixer(p, l + 1, gw, NGW, lane, scr); }
        SEAM(P + 9);
    }
#undef IN
#undef SEAM
}

extern "C" void kernel_launch(void* const* d_in, const int* in_sizes, int n_in, void* d_out, int out_size, void* d_ws, size_t ws_size, hipStream_t stream) {
    static int grid = 0;
    if (grid == 0) {
        if (n_in != 23 || ws_size < WS_END || out_size != M * DM) { fprintf(stderr, "kernel_launch: unexpected sizes\n"); grid = -1; return; }
        int dev = 0, cus = 0, per_cu = 0;
        if (hipGetDevice(&dev) != hipSuccess || hipDeviceGetAttribute(&cus, hipDeviceAttributeMultiprocessorCount, dev) != hipSuccess) { grid = -1; return; }
        if (hipFuncSetAttribute((const void*)mega_fwd, hipFuncAttributeMaxDynamicSharedMemorySize, LDS_BYTES) != hipSuccess) { fprintf(stderr, "kernel_launch: hipFuncSetAttribute failed\n"); grid = -1; return; }
        if (hipOccupancyMaxActiveBlocksPerMultiprocessor(&per_cu, (const void*)mega_fwd, NWAVES * 64, LDS_BYTES) != hipSuccess || per_cu < 1) { fprintf(stderr, "kernel_launch: occupancy query says %d\n", per_cu); }
        (void)hipGetLastError();
        grid = cus;
    }
    if (grid < 0) return;
    (void)hipMemsetAsync((char*)d_ws + WS_CTL, 0, CTL_BYTES, stream);
    Args a{}; for (int i = 0; i < 23; ++i) a.p.in[i] = (const float*)d_in[i]; a.p.out = (float*)d_out; a.p.ws = (unsigned char*)d_ws;
#if MK_PER_PHASE
    for (int ph = 0; ph < N_PHASES; ++ph) { a.ph_lo = ph; a.ph_hi = ph + 1; hipLaunchKernelGGL(mega_fwd, dim3(grid), dim3(NWAVES * 64), LDS_BYTES, stream, a); }
#else
    a.ph_lo = 0; a.ph_hi = N_PHASES; hipLaunchKernelGGL(mega_fwd, dim3(grid), dim3(NWAVES * 64), LDS_BYTES, stream, a);
#endif
}
```

```cpp
#include <hip/hip_runtime.h>
#include <cstdio>
#include <cstdint>
#include <cmath>

#define GAS __attribute__((address_space(1)))
#define LAS __attribute__((address_space(3)))
#define DI __device__ __forceinline__
typedef unsigned short bf16;
typedef unsigned v4u __attribute__((ext_vector_type(4)));
typedef unsigned v2u __attribute__((ext_vector_type(2)));
typedef float f32x4 __attribute__((ext_vector_type(4)));
typedef float f32x2 __attribute__((ext_vector_type(2)));
typedef float f32x16 __attribute__((ext_vector_type(16)));
typedef short bf16x8 __attribute__((ext_vector_type(8)));
typedef short s16x4 __attribute__((ext_vector_type(4)));

constexpr int NB = 8, SEQ = 2048, DM = 1024, M = NB * SEQ, DEPTH = 2;
constexpr int IN_COLS = 7328, NPROJ = 7424;
constexpr int NEXP = 16, DEXP = 512;
constexpr float RMS_EPS = 1e-6f;
constexpr float LOG2E = 1.4426950408889634f;
constexpr float C2A = 0.125f * LOG2E;
constexpr float C2C = 0.10206207261596577f * LOG2E;
constexpr int PA = 2304, PB = 1536, PCL = 512, PG = 3072, PQC = 576, PKV = 768, POC = 384, POA = 256;
constexpr int KR_COL = 384;

constexpr size_t MiB = 1u << 20;
constexpr size_t WS_CTL = 0, CTL_BYTES = 256 * 1024;
constexpr size_t WS_LIST = 1 * MiB;
constexpr size_t WS_WLIST = 2 * MiB;
constexpr size_t WS_SSQQ = 3 * MiB;
constexpr size_t WS_SSQKV = 3 * MiB + 256 * 1024;
constexpr size_t WS_LSE = 3 * MiB + 512 * 1024;
constexpr size_t WS_ROPE = 4 * MiB + 256 * 1024;
constexpr size_t WS_KR = 4 * MiB + 512 * 1024;
constexpr size_t WS_WMIX = 6 * MiB;
constexpr size_t WM_IN = WS_WMIX;
constexpr size_t WM_O = WM_IN + (size_t)NPROJ * DM * 2;
constexpr size_t WM_PA = WM_O + (size_t)DM * DM * 2;
constexpr size_t WM_PB = WM_PA + (size_t)DM * 256 * 2;
constexpr size_t WM_PC = WM_PB + (size_t)DM * 512 * 2;
constexpr size_t WM_UQ = WM_PC + (size_t)DM * 384 * 2;
constexpr size_t WM_UKV = WM_UQ + (size_t)768 * 256 * 2;
constexpr size_t WM_END = WM_UKV + (size_t)768 * 256 * 2;
static_assert(WM_END <= 26 * MiB, "mixer weights");
constexpr size_t WS_U = 26 * MiB;
constexpr size_t WS_OA = WS_U + 24 * MiB;
constexpr size_t WS_QKVA = 58 * MiB;
constexpr size_t WS_QKVB = 130 * MiB;
constexpr size_t WS_CLAT = 178 * MiB;
constexpr size_t WS_OC = WS_CLAT;
constexpr size_t WS_G = 194 * MiB;
constexpr size_t WS_QC = 290 * MiB;
constexpr size_t WS_KVC = 308 * MiB;
constexpr size_t WS_END = 332 * MiB;
constexpr size_t WS_MERGED = WS_QKVA;
constexpr size_t WS_WGU = 58 * MiB;
constexpr size_t WS_WD = 90 * MiB;
constexpr size_t WS_ACT = 106 * MiB;
constexpr size_t WS_Y = 142 * MiB;
constexpr int ACT_ROWS = 2 * M + NEXP * 256;
static_assert(WS_ACT + (size_t)ACT_ROWS * DEXP * 2 <= WS_Y && WS_Y + (size_t)2 * M * DM * 2 <= WS_G + 96 * MiB && WS_KVC + (size_t)M * 768 * 2 <= WS_END, "ws map");
constexpr int CW_TMO = 0;
constexpr int CW_CNT = 16384;
constexpr int CW_ERR = 256;
constexpr int CW_ATTN = 512;
constexpr int CW_BAR = 4096;

struct Params {
    const float* in[23]; float* out; unsigned char* ws;
};

DI unsigned f2bf(float f) { unsigned u = __builtin_bit_cast(unsigned, f); return (u + 0x7fffu + ((u >> 16) & 1u)) >> 16; }
typedef __bf16 bf16x2_hw __attribute__((ext_vector_type(2)));
DI unsigned pk2(float lo, float hi) { f32x2 v = {lo, hi}; bf16x2_hw b = __builtin_convertvector(v, bf16x2_hw); return __builtin_bit_cast(unsigned, b); }
DI float bf2f(unsigned short b) { return __builtin_bit_cast(float, (unsigned)b << 16); }
DI float bflo(unsigned w) { return __builtin_bit_cast(float, w << 16); }
DI float bfhi(unsigned w) { return __builtin_bit_cast(float, w & 0xffff0000u); }
DI float wave_sum(float v) {
#pragma unroll
    for (int o = 1; o < 64; o <<= 1) v += __shfl_xor(v, o);
    return v;
}
DI float wave_max(float v) {
#pragma unroll
    for (int o = 1; o < 64; o <<= 1) v = fmaxf(v, __shfl_xor(v, o));
    return v;
}
DI float sigmoidf_(float x) { return __builtin_amdgcn_rcpf(1.0f + __builtin_amdgcn_exp2f(-LOG2E * x)); }
DI float alibi_a(int h) { return exp2f(-8.0f * (float)(h + 1) / 12.0f); }
DI float alibi_b(int h) { return exp2f(-2.0f * (float)(h + 1)); }
DI float lam_init_of(int l) { return 0.8f - 0.6f * expf(-0.3f * (float)l); }
DI float lam_of(const Params& p, int l, int lane) {
    const float a = p.in[11][l * 64 + lane] * p.in[12][l * 64 + lane], b = p.in[13][l * 64 + lane] * p.in[14][l * 64 + lane];
    return expf(wave_sum(a)) - expf(wave_sum(b)) + lam_init_of(l);
}
#define LDS_WAIT() asm volatile("s_waitcnt lgkmcnt(0)" ::: "memory")

struct MapIdent { int off; DI int operator()(int n) const { return n + off; } };
struct MapWin { DI int operator()(int n) const { if (n < 4224) return n; if (n < 4256) { const int i = n - 4224; return 4224 + (i < 16 ? 2 * i : 2 * (i - 16) + 1); } return n + 96; } };
struct MapUq { DI int operator()(int n) const { const int h = n / 96, j = n % 96; if (j < 64) return n; const int i = j - 64; return h * 96 + 64 + (i < 16 ? 2 * i : 2 * (i - 16) + 1); } };
struct MapGate { DI int operator()(int n) const { return 8 * (n >> 2) + (n & 3); } };
struct MapUp { DI int operator()(int n) const { return 8 * (n >> 2) + 4 + (n & 3); } };

struct CvtDesc { const float* W; int N; bf16* WT; int Kd; const float* gk; int mapid, item; };
DI int cvt_map(int mapid, int n) { return mapid == 0 ? n : mapid == 1 ? MapWin{}(n) : mapid == 2 ? MapUq{}(n) : mapid == 3 ? MapGate{}(n) : MapUp{}(n); }
DI void cvt_load(const CvtDesc& d, int lane, float (&v)[32]) {
    const int nblk = d.N / 32, kb = d.item / nblk, nb = d.item % nblk, k0 = 64 * kb, n0 = 32 * nb;
    const float* src = d.W + (size_t)(k0 + (lane >> 5)) * d.N + n0 + (lane & 31);
#pragma unroll
    for (int i = 0; i < 32; ++i) v[i] = src[(size_t)(2 * i) * d.N];
    if (d.gk) {
#pragma unroll
        for (int i = 0; i < 32; ++i) v[i] *= d.gk[k0 + 2 * i + (lane >> 5)]; }
}
DI void cvt_store(const CvtDesc& d, int lane, const float (&v)[32], LAS float* scr) {
    const int nblk = d.N / 32, kb = d.item / nblk, nb = d.item % nblk, k0 = 64 * kb, n0 = 32 * nb;
#pragma unroll
    for (int i = 0; i < 32; ++i) scr[(2 * i + (lane >> 5)) * 33 + (lane & 31)] = v[i];
    LDS_WAIT(); asm volatile("" ::: "memory");
    const int c = lane & 7;
#pragma unroll
    for (int j = 0; j < 4; ++j) { const int n = (lane >> 3) + 8 * j; const LAS float* s = scr + (8 * c) * 33 + n;
        v4u o; o.x = pk2(s[0 * 33], s[1 * 33]); o.y = pk2(s[2 * 33], s[3 * 33]); o.z = pk2(s[4 * 33], s[5 * 33]); o.w = pk2(s[6 * 33], s[7 * 33]);
        const int dr = cvt_map(d.mapid, n0 + n);
        *(v4u*)(d.WT + (size_t)dr * d.Kd + k0 + 8 * c) = o; }
    LDS_WAIT(); asm volatile("" ::: "memory");
}
template <class Dec>
DI void cvt_run(const Dec& dec, int nit, int gw, int NGW, int lane, LAS float* scr) {
    float v[32], vn[32]; CvtDesc d, dn; int it = gw;
    if (it < nit) { d = dec(it); cvt_load(d, lane, v); }
    while (it < nit) { const int itn = it + NGW; dn = d;
        if (itn < nit) { dn = dec(itn); cvt_load(dn, lane, vn); }
        cvt_store(d, lane, v, scr);
#pragma unroll
        for (int i = 0; i < 32; ++i) v[i] = vn[i];
        d = dn; it = itn; }
}
struct DecMixer { const Params* p; int l;
    DI CvtDesc operator()(int it) const { unsigned char* ws = p->ws; int r = it;
        constexpr int I_IN = 16 * (IN_COLS / 32), I_O = 16 * 32, I_PA = 4 * 32, I_PB = 8 * 32, I_PC = 6 * 32, I_UQ = 4 * 18;
        if (r < I_IN) return CvtDesc{p->in[1] + (size_t)l * DM * IN_COLS, IN_COLS, (bf16*)(ws + WM_IN), DM, nullptr, 1, r}; r -= I_IN;
        if (r < I_O) return CvtDesc{p->in[6] + (size_t)l * DM * DM, DM, (bf16*)(ws + WM_O), DM, nullptr, 0, r}; r -= I_O;
        if (r < I_PA) return CvtDesc{p->in[3] + (size_t)l * 256 * DM, DM, (bf16*)(ws + WM_PA), 256, nullptr, 0, r}; r -= I_PA;
        if (r < I_PB) return CvtDesc{p->in[4] + (size_t)l * 512 * DM, DM, (bf16*)(ws + WM_PB), 512, nullptr, 0, r}; r -= I_PB;
        if (r < I_PC) return CvtDesc{p->in[5] + (size_t)l * 384 * DM, DM, (bf16*)(ws + WM_PC), 384, nullptr, 0, r}; r -= I_PC;
        if (r < I_UQ) return CvtDesc{p->in[8] + (size_t)l * 256 * 576, 576, (bf16*)(ws + WM_UQ), 256, p->in[7] + l * 256, 2, r}; r -= I_UQ;
        return CvtDesc{p->in[10] + (size_t)l * 128 * 768, 768, (bf16*)(ws + WM_UKV), 256, p->in[9] + l * 128, 0, r}; } };
DI void ph_cvt_mixer(const Params& p, int l, int gw, int NGW, int lane, LAS float* scr) {
    unsigned char* ws = p.ws;
    constexpr int NIT = 16 * (IN_COLS / 32) + 16 * 32 + 4 * 32 + 8 * 32 + 6 * 32 + 4 * 18 + 2 * 24;
    cvt_run(DecMixer{&p, l}, NIT, gw, NGW, lane, scr);
    const v4u z = {0u, 0u, 0u, 0u};
    const int gt = gw * 64 + lane, NT = NGW * 64;
    for (int c = gt; c < 96 * 128; c += NT) *(v4u*)((bf16*)(ws + WM_IN) + (size_t)4256 * DM + (size_t)c * 8) = z;
    for (int c = gt; c < 192 * 32; c += NT) *(v4u*)((bf16*)(ws + WM_UQ) + (size_t)576 * 256 + (size_t)c * 8) = z;
    for (int c = gt; c < 768 * 16; c += NT) *(v4u*)((bf16*)(ws + WM_UKV) + (size_t)(c >> 4) * 256 + 128 + (c & 15) * 8) = z;
}
struct DecExperts { const Params* p; int l;
    DI CvtDesc operator()(int it) const { unsigned char* ws = p->ws; constexpr int IG = 16 * 16, IDN = 8 * 32, PER = 2 * IG + IDN;
        const int e = it / PER; int r = it % PER; const size_t eo = ((size_t)l * NEXP + e) * DM * DEXP;
        if (r < IG) return CvtDesc{p->in[19] + eo, DEXP, (bf16*)(ws + WS_WGU) + (size_t)e * 1024 * 1024, DM, nullptr, 3, r}; r -= IG;
        if (r < IG) return CvtDesc{p->in[20] + eo, DEXP, (bf16*)(ws + WS_WGU) + (size_t)e * 1024 * 1024, DM, nullptr, 4, r}; r -= IG;
        return CvtDesc{p->in[21] + eo, DM, (bf16*)(ws + WS_WD) + (size_t)e * 1024 * 512, DEXP, nullptr, 0, r}; } };
DI void ph_cvt_experts(const Params& p, int l, int gw, int NGW, int lane, LAS float* scr) {
    cvt_run(DecExperts{&p, l}, NEXP * (2 * 16 * 16 + 8 * 32), gw, NGW, lane, scr);
}
DI void ph_rope_table(const Params& p, int gw, int NGW, int lane) {
    f32x2* tab = (f32x2*)(p.ws + WS_ROPE);
    for (int idx = gw * 64 + lane; idx < SEQ * 16; idx += NGW * 64) {
        const int pos = idx >> 4, i = idx & 15;
        double inv = 1.0; for (int j = 0; j < i; ++j) inv *= 0.56234132519034908;
        const double rev = (double)pos * inv * 0.15915494309189535;
        double fr = rev - floor(rev); if (fr >= 0.5) fr -= 1.0;
        const float f = (float)fr;
        tab[idx] = (f32x2){__builtin_amdgcn_cosf(f), __builtin_amdgcn_sinf(f)};
    }
}
DI void load_row(const float* xr, int lane, f32x4 (&v)[4]) {
#pragma unroll
    for (int j = 0; j < 4; ++j) v[j] = ((const f32x4*)xr)[lane + 64 * j];
}
DI float row_ss(const f32x4 (&v)[4]) {
    float s = 0.f;
#pragma unroll
    for (int j = 0; j < 4; ++j) s += (v[j].x * v[j].x + v[j].y * v[j].y) + (v[j].z * v[j].z + v[j].w * v[j].w);
    return wave_sum(s);
}
DI void store_row_bf16(bf16* orow, int lane, const f32x4 (&v)[4], float rs, const float* g) {
#pragma unroll
    for (int j = 0; j < 4; ++j) { const f32x4 gg = ((const f32x4*)g)[lane + 64 * j];
        v2u o; o.x = pk2(v[j].x * rs * gg.x, v[j].y * rs * gg.y); o.y = pk2(v[j].z * rs * gg.z, v[j].w * rs * gg.w);
        ((v2u*)orow)[lane + 64 * j] = o; }
}
DI void ph_rmsnorm(const float* x, const float* g, bf16* out, int gw, int NGW, int lane) {
    f32x4 v[4], vn[4];
    if (gw < M) load_row(x + (size_t)gw * DM, lane, vn);
    for (int m = gw; m < M; m += NGW) {
#pragma unroll
        for (int j = 0; j < 4; ++j) v[j] = vn[j];
        if (m + NGW < M) load_row(x + (size_t)(m + NGW) * DM, lane, vn);
        const float rs = rsqrtf(row_ss(v) * (1.0f / DM) + RMS_EPS);
        store_row_bf16(out + (size_t)m * DM, lane, v, rs, g); }
}
DI int wr_slot(int k) { return (((k >> 8) << 2) + (k & 3)) * 64 + ((k >> 2) & 63); }
DI void ph_router(const Params& p, int l, int bid, int G, int wave, int lane, LAS unsigned char* wlds, LAS unsigned* rl) {
    const float* x1 = p.out; const float* g = p.in[16] + l * DM; const float* wr = p.in[17]; const float* rb = p.in[18];
    bf16* h = (bf16*)(p.ws + WS_U); int* list = (int*)(p.ws + WS_LIST); float* wl = (float*)(p.ws + WS_WLIST);
    unsigned* cnt = (unsigned*)(p.ws + WS_CTL) + CW_CNT + l * 1024;
    const int rpw = (M + G - 1) / G, r0 = bid * rpw, nr = (M - r0 < rpw ? M - r0 : rpw), tid = wave * 64 + lane;
    LAS unsigned* lcnt = rl; LAS unsigned* gbase = rl + 16; LAS int* ee = (LAS int*)(rl + 32); LAS float* ew = (LAS float*)(rl + 32 + 256); LAS unsigned* er = rl + 32 + 512;
    if (tid < 16) lcnt[tid] = 0u;
    for (int c = tid; c < 1024 * 4; c += 512) { const int k = c >> 2, q = c & 3; *(LAS f32x4*)(wlds + wr_slot(k) * 80 + q * 16) = ((const f32x4*)wr)[c]; }
    __syncthreads();
    f32x4 gg[4];
#pragma unroll
    for (int j = 0; j < 4; ++j) gg[j] = ((const f32x4*)g)[lane + 64 * j];
    f32x4 v[4], vn[4];
    if (wave < nr) load_row(x1 + (size_t)(r0 + wave) * DM, lane, vn);
    for (int i = wave; i < nr; i += 8) {
        const int m = r0 + i;
#pragma unroll
        for (int j = 0; j < 4; ++j) v[j] = vn[j];
        if (i + 8 < nr) load_row(x1 + (size_t)(m + 8) * DM, lane, vn);
        const float rs = rsqrtf(row_ss(v) * (1.0f / DM) + RMS_EPS);
        float lg[16];
#pragma unroll
        for (int e = 0; e < 16; ++e) lg[e] = 0.f;
#pragma unroll
        for (int j = 0; j < 4; ++j) {
            const float hv[4] = {v[j].x * rs * gg[j].x, v[j].y * rs * gg[j].y, v[j].z * rs * gg[j].z, v[j].w * rs * gg[j].w};
            v2u o; o.x = pk2(hv[0], hv[1]); o.y = pk2(hv[2], hv[3]); ((v2u*)(h + (size_t)m * DM))[lane + 64 * j] = o;
#pragma unroll
            for (int c = 0; c < 4; ++c) { const LAS unsigned char* wrow = wlds + ((j * 4 + c) * 64 + lane) * 80;
#pragma unroll
                for (int q = 0; q < 4; ++q) { const f32x4 w = *(const LAS f32x4*)(wrow + q * 16); lg[4 * q] += hv[c] * w.x; lg[4 * q + 1] += hv[c] * w.y; lg[4 * q + 2] += hv[c] * w.z; lg[4 * q + 3] += hv[c] * w.w; } } }
        float a8[8], a4[4], a2[2], a1;
        { const bool hi = (lane & 32) != 0;
#pragma unroll
          for (int q = 0; q < 8; ++q) { const float keep = hi ? lg[q + 8] : lg[q], send = hi ? lg[q] : lg[q + 8]; a8[q] = keep + __shfl_xor(send, 32); } }
        { const bool hi = (lane & 16) != 0;
#pragma unroll
          for (int q = 0; q < 4; ++q) { const float keep = hi ? a8[q + 4] : a8[q], send = hi ? a8[q] : a8[q + 4]; a4[q] = keep + __shfl_xor(send, 16); } }
        { const bool hi = (lane & 8) != 0;
#pragma unroll
          for (int q = 0; q < 2; ++q) { const float keep = hi ? a4[q + 2] : a4[q], send = hi ? a4[q] : a4[q + 2]; a2[q] = keep + __shfl_xor(send, 8); } }
        { const bool hi = (lane & 4) != 0; const float keep = hi ? a2[1] : a2[0], send = hi ? a2[0] : a2[1]; a1 = keep + __shfl_xor(send, 4); }
        a1 += __shfl_xor(a1, 2); a1 += __shfl_xor(a1, 1);
        float sc[16], bs[16];
#pragma unroll
        for (int e = 0; e < 16; ++e) { const int src = ((e >> 3) & 1) * 32 + ((e >> 2) & 1) * 16 + ((e >> 1) & 1) * 8 + (e & 1) * 4; const float t = __shfl(a1, src); sc[e] = 1.0f / (1.0f + expf(-t)); bs[e] = sc[e] + rb[e]; }
        int bg = 0; float bgs = -1e30f; int i1 = 0, i2 = 1;
#pragma unroll
        for (int gI = 0; gI < 4; ++gI) {
            int a = 0; float av = bs[4 * gI];
#pragma unroll
            for (int ii = 1; ii < 4; ++ii) if (bs[4 * gI + ii] > av) { av = bs[4 * gI + ii]; a = ii; }
            int b = -1; float bv = -1e30f;
#pragma unroll
            for (int ii = 0; ii < 4; ++ii) if (ii != a && bs[4 * gI + ii] > bv) { bv = bs[4 * gI + ii]; b = ii; }
            const float gs = av + bv;
            if (gs > bgs) { bgs = gs; bg = gI; i1 = a; i2 = b; }
        }
        const int e1 = bg * 4 + i1, e2 = bg * 4 + i2;
        float s1 = 0.f, s2 = 0.f;
#pragma unroll
        for (int e = 0; e < 16; ++e) { if (e == e1) s1 = sc[e]; if (e == e2) s2 = sc[e]; }
        const float inv = 1.0f / (s1 + s2);
        if (lane == 0) {
            ee[2 * i] = e1; ew[2 * i] = s1 * inv; er[2 * i] = __hip_atomic_fetch_add(lcnt + e1, 1u, __ATOMIC_RELAXED, __HIP_MEMORY_SCOPE_WORKGROUP);
            ee[2 * i + 1] = e2; ew[2 * i + 1] = s2 * inv; er[2 * i + 1] = __hip_atomic_fetch_add(lcnt + e2, 1u, __ATOMIC_RELAXED, __HIP_MEMORY_SCOPE_WORKGROUP);
        }
    }
    __syncthreads();
    if (tid < 16) gbase[tid] = atomicAdd(cnt + tid * 64, lcnt[tid]);
    __syncthreads();
    for (int t = tid; t < 2 * nr; t += 512) { const int e = ee[t]; const unsigned pos = gbase[e] + er[t]; list[e * M + pos] = (r0 + (t >> 1)) * 2 + (t & 1); wl[e * M + pos] = ew[t]; }
}
DI void ph_combine(const Params& p, int l, int gw, int NGW, int lane, bool st) {
    float* x1 = p.out; const bf16* Y = (const bf16*)(p.ws + WS_Y); bf16* u = (bf16*)(p.ws + WS_U);
    const bool last = (l == DEPTH - 1); const float* g = last ? p.in[22] : p.in[2] + (l + 1) * DM;
    f32x4 v[4], vn[4]; v2u ya[4], yb[4], yan[4], ybn[4];
#define CMB_LOAD(m_) do { load_row(x1 + (size_t)(m_) * DM, lane, vn); _Pragma("unroll") for (int j = 0; j < 4; ++j) { yan[j] = ((const v2u*)(Y + (size_t)(2 * (m_)) * DM))[lane + 64 * j]; ybn[j] = ((const v2u*)(Y + (size_t)(2 * (m_) + 1) * DM))[lane + 64 * j]; } } while (0)
    if (gw < M) CMB_LOAD(gw);
    for (int m = gw; m < M; m += NGW) {
#pragma unroll
        for (int j = 0; j < 4; ++j) { v[j] = vn[j]; ya[j] = yan[j]; yb[j] = ybn[j]; }
        if (m + NGW < M) CMB_LOAD(m + NGW);
#pragma unroll
        for (int j = 0; j < 4; ++j) { const v2u a = ya[j], b = yb[j];
            v[j].x += bflo(a.x) + bflo(b.x); v[j].y += bfhi(a.x) + bfhi(b.x); v[j].z += bflo(a.y) + bflo(b.y); v[j].w += bfhi(a.y) + bfhi(b.y); }
        const float rs = rsqrtf(row_ss(v) * (1.0f / DM) + RMS_EPS);
        if (!(st || rs == 1.2345e33f)) continue;
        if (last) {
#pragma unroll
            for (int j = 0; j < 4; ++j) { const f32x4 gg = ((const f32x4*)g)[lane + 64 * j]; ((f32x4*)(x1 + (size_t)m * DM))[lane + 64 * j] = v[j] * rs * gg; }
        } else {
#pragma unroll
            for (int j = 0; j < 4; ++j) ((f32x4*)(x1 + (size_t)m * DM))[lane + 64 * j] = v[j];
            store_row_bf16(u + (size_t)m * DM, lane, v, rs, g);
        }
    }
#undef CMB_LOAD
}
DI void amerge_tok(const bf16* og, const float* lse, bf16* oa, int t, int s, int d0, float (&lv)[3], v2u (&xv)[3], bool load) {
    if (load) {
#pragma unroll
        for (int g = 0; g < 3; ++g) { lv[g] = lse[((size_t)g * M + t) * 4 + s]; xv[g] = *(const v2u*)(og + (size_t)t * PA + (g * 4 + s) * 64 + d0); }
    } else {
        const float mx = fmaxf(lv[0], fmaxf(lv[1], lv[2])); const float a0 = exp2f(lv[0] - mx), a1 = exp2f(lv[1] - mx), a2 = exp2f(lv[2] - mx); const float inv = __builtin_amdgcn_rcpf(a0 + a1 + a2);
        const float w0 = a0 * inv, w1 = a1 * inv, w2 = a2 * inv;
        v2u o; o.x = pk2(w0 * bflo(xv[0].x) + w1 * bflo(xv[1].x) + w2 * bflo(xv[2].x), w0 * bfhi(xv[0].x) + w1 * bfhi(xv[1].x) + w2 * bfhi(xv[2].x));
        o.y = pk2(w0 * bflo(xv[0].y) + w1 * bflo(xv[1].y) + w2 * bflo(xv[2].y), w0 * bfhi(xv[0].y) + w1 * bfhi(xv[1].y) + w2 * bfhi(xv[2].y));
        *(v2u*)(oa + (size_t)t * POA + s * 64 + d0) = o;
    }
}
DI void ph_amerge(const Params& p, int gw, int NGW, int lane) {
    const bf16* og = (const bf16*)(p.ws + WS_QKVA); const float* lse = (const float*)(p.ws + WS_LSE); bf16* oa = (bf16*)(p.ws + WS_OA);
    const int s = lane >> 4, d0 = (lane & 15) * 4;
    for (int t = gw; t < M; t += 2 * NGW) {
        float la[3], lb[3]; v2u xa[3], xb[3]; const int t2 = t + NGW;
        amerge_tok(og, lse, oa, t, s, d0, la, xa, true);
        if (t2 < M) amerge_tok(og, lse, oa, t2, s, d0, lb, xb, true);
        amerge_tok(og, lse, oa, t, s, d0, la, xa, false);
        if (t2 < M) amerge_tok(og, lse, oa, t2, s, d0, lb, xb, false);
    }
}

DI void store8_bf16(bf16* dst, const float (&v)[8]) { v4u o; o.x = pk2(v[0], v[1]); o.y = pk2(v[2], v[3]); o.z = pk2(v[4], v[5]); o.w = pk2(v[6], v[7]); *(v4u*)dst = o; }
DI void rope4(float (&v)[8], const f32x2* tab, int pos, int i0) {
#pragma unroll
    for (int j = 0; j < 4; ++j) { const f32x2 cs = tab[pos * 16 + i0 + j]; const float t1 = v[2 * j], t2 = v[2 * j + 1]; v[2 * j] = t1 * cs.x - t2 * cs.y; v[2 * j + 1] = t1 * cs.y + t2 * cs.x; }
}
struct EpiProj {
    bf16* dst; int pitch, coff, mode; const f32x2* rope; bf16* kr;
    struct Ctx {}; DI void pre(int, int, Ctx&) const {}
    DI void s8(int row, int col, float (&v)[8], const Ctx&) const {
        const int c = col - coff;
        if (mode == 0) {
#pragma unroll
            for (int i = 0; i < 8; ++i) v[i] *= C2A; }
        else if (mode == 2) { if (c >= KR_COL && c < KR_COL + 32) { rope4(v, rope, row & (SEQ - 1), (c - KR_COL) >> 1); store8_bf16(kr + (size_t)row * 32 + (c - KR_COL), v); } }
        else if (mode == 3) {
#pragma unroll
            for (int i = 0; i < 8; ++i) v[i] = sigmoidf_(v[i]); }
        store8_bf16(dst + (size_t)row * pitch + c, v);
    }
};
struct ProjDst { bf16 *qkva, *qkvb, *clat, *g; const f32x2* rope; bf16* kr;
    DI EpiProj of(int col0) const {
        if (col0 < 2304) return EpiProj{qkva, PA, 0, col0 < 768 ? 0 : 1, rope, kr};
        if (col0 < 3840) return EpiProj{qkvb, PB, 2304, col0 < 2816 ? 0 : 1, rope, kr};
        if (col0 < 4352) return EpiProj{clat, PCL, 3840, col0 < 4096 ? 1 : 2, rope, kr};
        return EpiProj{g, PG, 4352, 3, rope, kr};
    }
};
struct EpiQc {
    bf16* qc; const float* ssq; const f32x2* rope;
    struct Ctx { f32x4 pp; }; DI void pre(int row, int col, Ctx& c) const { if (col < 576) c.pp = *(const f32x4*)(ssq + (size_t)row * 4); }
    DI void s8(int row, int col, float (&v)[8], const Ctx& c) const {
        if (col >= 576) return;
        const f32x4 pp = c.pp; const float rs = rsqrtf(((pp.x + pp.y) + (pp.z + pp.w)) * (1.0f / 256.0f) + RMS_EPS);
#pragma unroll
        for (int i = 0; i < 8; ++i) v[i] *= rs;
        const int j = col % 96; if (j >= 64) rope4(v, rope, row & (SEQ - 1), (j - 64) >> 1);
#pragma unroll
        for (int i = 0; i < 8; ++i) v[i] *= C2C;
        store8_bf16(qc + (size_t)row * PQC + col, v);
    }
};
struct EpiKv {
    bf16* kvc; const float* ssq;
    struct Ctx { f32x4 pp; }; DI void pre(int row, int, Ctx& c) const { c.pp = *(const f32x4*)(ssq + (size_t)row * 4); }
    DI void s8(int row, int col, float (&v)[8], const Ctx& c) const {
        const f32x4 pp = c.pp; const float rs = rsqrtf(((pp.x + pp.y) + (pp.z + pp.w)) * (1.0f / 128.0f) + RMS_EPS);
#pragma unroll
        for (int i = 0; i < 8; ++i) v[i] *= rs;
        store8_bf16(kvc + (size_t)row * PKV + col, v);
    }
};
struct EpiMerge {
    bf16* merged; const bf16* gate; bool first;
    struct Ctx { v4u g, o; };
    DI void pre(int row, int col, Ctx& c) const { c.g = *(const v4u*)(gate + (size_t)row * PG + col); if (!first) c.o = *(const v4u*)(merged + (size_t)row * DM + col); }
    DI void s8(int row, int col, float (&v)[8], const Ctx& c) const {
        const v4u gw = c.g;
        float r[8] = {v[0] * bflo(gw.x), v[1] * bfhi(gw.x), v[2] * bflo(gw.y), v[3] * bfhi(gw.y), v[4] * bflo(gw.z), v[5] * bfhi(gw.z), v[6] * bflo(gw.w), v[7] * bfhi(gw.w)};
        if (!first) { const v4u o = c.o; r[0] += bflo(o.x); r[1] += bfhi(o.x); r[2] += bflo(o.y); r[3] += bfhi(o.y); r[4] += bflo(o.z); r[5] += bfhi(o.z); r[6] += bflo(o.w); r[7] += bfhi(o.w); }
        store8_bf16(merged + (size_t)row * DM + col, r);
    }
};
struct EpiResid {
    const float* xin; float* xout;
    struct Ctx { f32x4 b; }; DI void pre(int row, int col, Ctx& c) const { c.b = *(const f32x4*)(xin + (size_t)row * DM + col); }
    DI void s4(int row, int col, f32x4 v, const Ctx& c) const { *(f32x4*)(xout + (size_t)row * DM + col) = c.b + v; }
};
struct EpiGateUp {
    bf16* act; const float* wl; int slot0;
    struct Ctx { float w; }; DI void pre(int row, int, Ctx& c) const { c.w = wl[row]; }
    DI void s8(int row, int col, float (&v)[8], const Ctx& c) const {
        const float w = c.w;
        float a[4];
#pragma unroll
        for (int i = 0; i < 4; ++i) a[i] = v[i] * sigmoidf_(v[i]) * v[4 + i] * w;
        v2u o; o.x = pk2(a[0], a[1]); o.y = pk2(a[2], a[3]);
        *(v2u*)(act + (size_t)(slot0 + row) * DEXP + (col >> 1)) = o;
    }
};
struct EpiDown {
    bf16* y; const int* list; int cnt;
    struct Ctx { int tok; }; DI void pre(int row, int, Ctx& c) const { c.tok = row < cnt ? list[row] : -1; }
    DI void s8(int row, int col, float (&v)[8], const Ctx& c) const { if (c.tok < 0) return; store8_bf16(y + (size_t)c.tok * DM + col, v); }
};
#ifndef MOE_XCD
#define MOE_XCD 1
#endif
#ifndef GEMM_PROF
#define GEMM_PROF 0
#endif
__device__ unsigned long long g_gemm_prof_dummy;
namespace pg8 {
typedef unsigned u32x4 __attribute__((ext_vector_type(4)));
constexpr int BM = 256, BK = 64, HALF = 128, HTB = HALF * BK * 2, STAGE_BYTES = 8 * HTB, NXCD = 8, WGM = 8;
__host__ __device__ __forceinline__ int lds_byte(int r, int c) { const int st = (r >> 4) * 2 + (c >> 5), rr = r & 15, cc = c & 31, ob = rr * 64 + cc * 2; return st * 1024 + (ob ^ (((ob >> 9) & 1) << 5)); }
__host__ __device__ __forceinline__ void stage_rc(int b, int& R, int& C) { const int st = b / 1024, sb = b % 1024, swz = sb ^ (((sb >> 9) & 1) << 5); R = (st >> 1) * 16 + swz / 64; C = (st & 1) * 32 + (swz % 64) / 2; }
__host__ __device__ __forceinline__ int perm32(int rho) { const int n = rho >> 4, i = rho & 15; return 8 * (i >> 2) + 4 * n + (i & 3); }

struct GUnit { const char* a; const char* b; int row0, col0, e, cnt, sb; };

struct TileOrder {
    int nM, nN, nwg, G, c;
    DI void init(int nM_, int nN_, int G_, int c_) { nM = nM_; nN = nN_; nwg = nM * nN; G = G_; c = c_; }
    DI bool tile(int i, int& pm, int& pn) const {
        const long L = (long)i * G + c; if (L >= nwg) return false;
        int wgid = (int)L; { const int q = nwg / NXCD, r = nwg % NXCD, xcd = wgid % NXCD, off = wgid / NXCD; wgid = (xcd < r ? xcd * (q + 1) : r * (q + 1) + (xcd - r) * q) + off; }
        const int nig = WGM * nN, gid = wgid / nig, fm = gid * WGM, gsz = (nM - fm) < WGM ? (nM - fm) : WGM;
        pm = fm + ((wgid % nig) % gsz); pn = (wgid % nig) / gsz; return true;
    }
};
struct DenseSched {
    static constexpr bool GATHER = false;
    TileOrder T; const char* A; const char* Bt; int lda, K, pn0 = 0;
    DI bool next(int i, GUnit& u) const { int pm, pn; if (!T.tile(i, pm, pn)) return false; pn += pn0;
        u.a = A + (size_t)pm * BM * lda * 2; u.b = Bt + (size_t)pn * BM * K * 2; u.row0 = pm * BM; u.col0 = pn * BM; u.e = 0; u.cnt = BM; u.sb = 0; return true; }
    DI unsigned gather_off(const GUnit&, int, int) const { return 0u; }
};
template <bool GATH>
struct MoeSched {
    static constexpr bool GATHER = GATH;
    const unsigned* cnt; const int* list; const char* A; const char* Bt; int lda, K, nN, G, c; size_t bstride;
    DI int ntile(int e) const { return ((int)__builtin_amdgcn_readfirstlane((int)cnt[e * 64]) + 255) >> 8; }
    DI bool next(int i, GUnit& u) const {
        int e, tl, pn;
        if (MOE_XCD && (G & 7) == 0) {
            const int x = c & 7, n = i * (G >> 3) + (c >> 3), nt0 = ntile(2 * x), nt1 = ntile(2 * x + 1);
            if (n >= (nt0 + nt1) * nN) return false;
            const int tloc = n / nN; pn = n % nN; e = tloc < nt0 ? 2 * x : 2 * x + 1; tl = tloc < nt0 ? tloc : tloc - nt0;
        } else {
            const int L = i * G + c; int t = L / nN; pn = L % nN; e = -1; tl = 0;
            for (int q = 0; q < NEXP; ++q) { const int nt = ntile(q); if (t < nt) { e = q; tl = t; break; } t -= nt; }
            if (e < 0) return false;
        }
        int sb = 0; for (int q = 0; q < e; ++q) sb += ntile(q) * 256;
        const int ce = (int)__builtin_amdgcn_readfirstlane((int)cnt[e * 64]);
        u.e = e; u.sb = sb; u.cnt = ce - tl * 256; u.row0 = tl * 256; u.col0 = pn * BM; u.b = Bt + (size_t)e * bstride + (size_t)pn * BM * K * 2;
        u.a = GATH ? A : A + (size_t)(sb + tl * 256) * lda * 2; return true;
    }
    DI unsigned gather_off(const GUnit& u, int r, int C) const {
        const int lr = u.row0 + r; int tok = 0; if (r < u.cnt) tok = list[u.e * M + lr] >> 1;
        return (unsigned)(tok * lda + C) * 2u;
    }
};

DI unsigned cvt_pk_bf16(float lo, float hi) { unsigned r; asm volatile("v_cvt_pk_bf16_f32 %0, %1, %2" : "=v"(r) : "v"(lo), "v"(hi)); return r; }

template <class Mk>
struct Epi8 {
    static constexpr bool PERM = true;
    Mk mk;
    DI void operator()(const f32x4 (&acc)[2][2][4][2], const GUnit& u, int wr, int wc, int fr, int fq) const {
        asm volatile("" : "+v"(fr), "+v"(fq));
        const auto F = mk.make(u);
        typedef decltype(F) FT; typename FT::Ctx cx[2][2];
        const int rowb = u.row0 + wr * 64 + fr, colb = u.col0 + wc * 32 + 8 * fq;
#pragma unroll
        for (int bj = 0; bj < 2; ++bj) F.pre(rowb, colb + bj * HALF, cx[0][bj]);
#pragma unroll
        for (int g = 0; g < 8; ++g) { const int ai = g >> 2, m = g & 3, row = rowb + ai * HALF + m * 16;
            if (g + 1 < 8) { const int rown = rowb + ((g + 1) >> 2) * HALF + ((g + 1) & 3) * 16;
#pragma unroll
                for (int bj = 0; bj < 2; ++bj) F.pre(rown, colb + bj * HALF, cx[(g + 1) & 1][bj]); }
#pragma unroll
            for (int bj = 0; bj < 2; ++bj) { const f32x4 a = acc[ai][bj][m][0], b = acc[ai][bj][m][1]; float v[8] = {a[0], a[1], a[2], a[3], b[0], b[1], b[2], b[3]};
                F.s8(row, colb + bj * HALF, v, cx[g & 1][bj]); }
            asm volatile("" ::: "memory"); }
        mk.extra(acc, u, wr, wc, fr, fq);
    }
};
template <class Mk>
struct Epi4 {
    static constexpr bool PERM = false;
    Mk mk;
    DI void operator()(const f32x4 (&acc)[2][2][4][2], const GUnit& u, int wr, int wc, int fr, int fq) const {
        asm volatile("" : "+v"(fr), "+v"(fq));
        const auto F = mk.make(u);
        typedef decltype(F) FT; typename FT::Ctx cx[2][2][2];
        const int rowb = u.row0 + wr * 64 + fr, colb = u.col0 + wc * 32 + 4 * fq;
#pragma unroll
        for (int bj = 0; bj < 2; ++bj)
#pragma unroll
            for (int n = 0; n < 2; ++n) F.pre(rowb, colb + bj * HALF + 16 * n, cx[0][bj][n]);
#pragma unroll
        for (int g = 0; g < 8; ++g) { const int ai = g >> 2, m = g & 3, row = rowb + ai * HALF + m * 16;
            if (g + 1 < 8) { const int rown = rowb + ((g + 1) >> 2) * HALF + ((g + 1) & 3) * 16;
#pragma unroll
                for (int bj = 0; bj < 2; ++bj)
#pragma unroll
                    for (int n = 0; n < 2; ++n) F.pre(rown, colb + bj * HALF + 16 * n, cx[(g + 1) & 1][bj][n]); }
#pragma unroll
            for (int bj = 0; bj < 2; ++bj)
#pragma unroll
                for (int n = 0; n < 2; ++n) F.s4(row, colb + bj * HALF + 16 * n, acc[ai][bj][m][n], cx[g & 1][bj][n]);
            asm volatile("" ::: "memory"); }
    }
};

template <class Epi, class Sched>
__device__ __forceinline__ void gemm_phase(LAS unsigned char* lds, const Sched& S, const Epi& E, volatile LAS unsigned* prof = nullptr, int prof_id = 0) {
    unsigned long long pt0 = 0, pacc = 0; int pcur = 0;
#define GP_MARK(n) do { if (GEMM_PROF && prof) { const unsigned long long t_ = __builtin_readcyclecounter(); if (pcur == (GEMM_PROF & 15) && prof_id == (GEMM_PROF >> 4)) pacc += t_ - pt0; pcur = (n); pt0 = t_; } } while (0)
    GP_MARK(3);
    constexpr bool GATHER = Sched::GATHER;
    int tid_ = threadIdx.x; asm volatile("" : "+v"(tid_));
    const int tid = tid_, wid = __builtin_amdgcn_readfirstlane(tid >> 6), lane = tid & 63, wr = wid >> 2, wc = wid & 3, fr = lane & 15, fq = lane >> 4;
    const int K = S.K, lda = S.lda, nt = K / BK;
    int sR[2], sC[2];
    unsigned voffA[2][2], voffB[2], nvoffA[2][2];
#pragma unroll
    for (int i = 0; i < 2; ++i) { stage_rc(tid * 16 + i * 8192, sR[i], sC[i]); const int Rb = Epi::PERM ? ((sR[i] & ~31) + perm32(sR[i] & 31)) : sR[i];
        voffA[0][i] = (unsigned)(sR[i] * lda + sC[i]) * 2u; voffA[1][i] = voffA[0][i]; nvoffA[0][i] = voffA[0][i]; nvoffA[1][i] = voffA[0][i]; voffB[i] = (unsigned)(Rb * K + sC[i]) * 2u; }
    const size_t kstep = (size_t)(BK * 2);
    const size_t hstepA = GATHER ? 0 : (size_t)HALF * lda * 2, hstepB = (size_t)HALF * K * 2;
    const unsigned ldsw = (unsigned)wid * 1024u;
    const int aoff = lds_byte(wr * 64 + fr, fq * 8), boff = lds_byte(wc * 32 + fr, fq * 8);
#define PG8_SA(b, h) (((b) * 2 + (h)) * HTB)
#define PG8_SB(b, h) ((4 + (b) * 2 + (h)) * HTB)
#define PG8_STAGE(bufoff, gbase, voff) do { _Pragma("unroll") for (int _i = 0; _i < 2; ++_i) \
        __builtin_amdgcn_global_load_lds((const unsigned*)((const char*)(gbase) + (voff)[_i]), (LAS unsigned*)(lds + (bufoff) + ldsw + _i * 8192), 16, 0, 0); } while (0)
#define PG8_LDA(dst, b, h) do { _Pragma("unroll") for (int m = 0; m < 4; ++m) _Pragma("unroll") for (int k = 0; k < 2; ++k) dst[m][k] = *(const LAS bf16x8*)(lds + PG8_SA(b, h) + aoff + m * 2048 + k * 1024); } while (0)
#define PG8_LDB(dst, b, h) do { _Pragma("unroll") for (int n = 0; n < 2; ++n) _Pragma("unroll") for (int k = 0; k < 2; ++k) dst[n][k] = *(const LAS bf16x8*)(lds + PG8_SB(b, h) + boff + n * 2048 + k * 1024); } while (0)
#define PG8_MMA(ai, bj, At, Bt) do { __builtin_amdgcn_s_setprio(1); _Pragma("unroll") for (int m = 0; m < 4; ++m) _Pragma("unroll") for (int n = 0; n < 2; ++n) _Pragma("unroll") for (int k = 0; k < 2; ++k) \
        acc[ai][bj][m][n] = __builtin_amdgcn_mfma_f32_16x16x32_bf16(Bt[n][k], At[m][k], acc[ai][bj][m][n], 0, 0, 0); __builtin_amdgcn_s_setprio(0); } while (0)
#define PG8_WAIT_V(n) asm volatile("s_waitcnt vmcnt(" #n ")" ::: "memory")
#define PG8_WAIT_L(n) asm volatile("s_waitcnt lgkmcnt(" #n ")" ::: "memory")
#define PG8_BAR __builtin_amdgcn_s_barrier()
#define PG8_SCHED __builtin_amdgcn_sched_barrier(0)
    GUnit cur, nxt; int ui = 0;
    if (!S.next(0, cur)) return;
    if constexpr (GATHER) {
#pragma unroll
        for (int h = 0; h < 2; ++h)
#pragma unroll
            for (int i = 0; i < 2; ++i) voffA[h][i] = S.gather_off(cur, h * HALF + sR[i], sC[i]);
    }
    f32x4 acc[2][2][4][2];
#pragma unroll
    for (int a = 0; a < 2; ++a)
#pragma unroll
        for (int b = 0; b < 2; ++b)
#pragma unroll
            for (int m = 0; m < 4; ++m)
#pragma unroll
                for (int n = 0; n < 2; ++n) acc[a][b][m][n] = (f32x4){0.f, 0.f, 0.f, 0.f};
    bf16x8 At[4][2], B0[2][2], B1[2][2];
    const char* cA = cur.a; const char* cB = cur.b;
    PG8_STAGE(PG8_SB(0, 0), cB, voffB); PG8_STAGE(PG8_SB(0, 1), cB + hstepB, voffB); PG8_STAGE(PG8_SA(0, 0), cA, voffA[0]); PG8_STAGE(PG8_SA(0, 1), cA + hstepA, voffA[1]);
    if (wr == 1) PG8_BAR;
    PG8_WAIT_V(2); PG8_BAR;
    PG8_STAGE(PG8_SB(1, 0), cB + kstep, voffB); PG8_STAGE(PG8_SA(1, 0), cA + kstep, voffA[0]); PG8_STAGE(PG8_SB(1, 1), cB + hstepB + kstep, voffB);
    PG8_WAIT_V(6); PG8_BAR;
    for (;;) {
        GP_MARK(1);
        const bool has_next = S.next(ui + 1, nxt);
        const char* nA = has_next ? nxt.a : cA; const char* nB = has_next ? nxt.b : cB;
        if constexpr (GATHER) {
#pragma unroll
            for (int h = 0; h < 2; ++h)
#pragma unroll
                for (int i = 0; i < 2; ++i) nvoffA[h][i] = has_next ? S.gather_off(nxt, h * HALF + sR[i], sC[i]) : voffA[h][i];
        }
        for (int t = 0; t < nt; t += 2) {
            const bool last = (t == nt - 2);
            const char* a1 = cA + (size_t)(t + 1) * kstep;
            const char* a2 = last ? nA : cA + (size_t)(t + 2) * kstep; const char* b2 = last ? nB : cB + (size_t)(t + 2) * kstep;
            const char* a3 = a2 + kstep; const char* b3 = b2 + kstep;
            unsigned v2[2][2];
#pragma unroll
            for (int h = 0; h < 2; ++h)
#pragma unroll
                for (int i = 0; i < 2; ++i) v2[h][i] = (GATHER && last) ? nvoffA[h][i] : voffA[h][i];
            PG8_LDB(B0, 0, 0); PG8_LDB(B1, 0, 1); PG8_SCHED; PG8_LDA(At, 0, 0); PG8_STAGE(PG8_SA(1, 1), a1 + hstepA, voffA[1]);
            PG8_WAIT_V(8); PG8_WAIT_L(0); PG8_BAR; PG8_MMA(0, 0, At, B0); PG8_MMA(0, 1, At, B1); PG8_BAR; PG8_SCHED;
            PG8_LDA(At, 0, 1); PG8_STAGE(PG8_SB(0, 0), b2, voffB); PG8_STAGE(PG8_SB(0, 1), b2 + hstepB, voffB); PG8_STAGE(PG8_SA(0, 0), a2, v2[0]);
            PG8_WAIT_V(8); PG8_WAIT_L(0); PG8_BAR; PG8_MMA(1, 0, At, B0); PG8_MMA(1, 1, At, B1); PG8_BAR; PG8_SCHED;
            PG8_LDB(B0, 1, 0); PG8_LDB(B1, 1, 1); PG8_SCHED; PG8_LDA(At, 1, 0); PG8_STAGE(PG8_SA(0, 1), a2 + hstepA, v2[1]);
            PG8_WAIT_V(8); PG8_WAIT_L(0); PG8_BAR; PG8_MMA(0, 0, At, B0); PG8_MMA(0, 1, At, B1); PG8_BAR; PG8_SCHED;
            PG8_LDA(At, 1, 1); PG8_STAGE(PG8_SB(1, 0), b3, voffB); PG8_STAGE(PG8_SB(1, 1), b3 + hstepB, voffB); PG8_STAGE(PG8_SA(1, 0), a3, v2[0]);
            PG8_WAIT_V(8); PG8_WAIT_L(0); PG8_BAR; PG8_MMA(1, 0, At, B0); PG8_MMA(1, 1, At, B1); PG8_BAR; PG8_SCHED;
        }
        if (wr == 0) PG8_BAR;
        GP_MARK(2);
        E(acc, cur, wr, wc, fr, fq);
        GP_MARK(3);
        if (!has_next) break;
#pragma unroll
        for (int a = 0; a < 2; ++a)
#pragma unroll
            for (int b = 0; b < 2; ++b)
#pragma unroll
                for (int m = 0; m < 4; ++m)
#pragma unroll
                    for (int n = 0; n < 2; ++n) acc[a][b][m][n] = (f32x4){0.f, 0.f, 0.f, 0.f};
        cur = nxt; cA = nA; cB = nB; ++ui;
        if constexpr (GATHER) {
#pragma unroll
            for (int h = 0; h < 2; ++h)
#pragma unroll
                for (int i = 0; i < 2; ++i) voffA[h][i] = nvoffA[h][i];
        }
        if (wr == 1) PG8_BAR;
    }
    PG8_WAIT_V(0);
    PG8_BAR;
    GP_MARK(0);
    if (GEMM_PROF && prof && blockIdx.x == 0 && threadIdx.x == 0) { const unsigned old = prof[0]; prof[0] = old + (unsigned)pacc; prof[1] += (unsigned)(pacc >> 32) + ((old + (unsigned)pacc < old) ? 1u : 0u); }
#undef GP_MARK
#undef PG8_SA
#undef PG8_SB
#undef PG8_STAGE
#undef PG8_LDA
#undef PG8_LDB
#undef PG8_MMA
#undef PG8_WAIT_V
#undef PG8_WAIT_L
#undef PG8_BAR
#undef PG8_SCHED
}
}
#ifndef ATT_PROF
#define ATT_PROF 0
#endif
struct ProfSt { unsigned long long t0, acc; int cur; };
#define PROF_MARK(P, n) do { if (ATT_PROF) { const unsigned long long t_ = __builtin_readcyclecounter(); if ((P).cur == ATT_PROF) (P).acc += t_ - (P).t0; (P).cur = (n); (P).t0 = t_; } } while (0)
#ifndef ATT_MASK
#define ATT_MASK 7
#endif
namespace att {
typedef __bf16 bf16x2_t __attribute__((ext_vector_type(2)));
typedef short v4i16_t __attribute__((ext_vector_type(4)));
DI float xhalf_max(float v) { const auto rr = __builtin_amdgcn_permlane32_swap(__float_as_uint(v), __float_as_uint(v), false, false); return fmaxf(__uint_as_float(rr[0]), __uint_as_float(rr[1])); }
DI float xhalf_sum(float v) { const auto rr = __builtin_amdgcn_permlane32_swap(__float_as_uint(v), __float_as_uint(v), false, false); return __uint_as_float(rr[0]) + __uint_as_float(rr[1]); }
DI unsigned cvtpk(float lo, float hi) { f32x2 v = {lo, hi}; bf16x2_t b = __builtin_convertvector(v, bf16x2_t); return __builtin_bit_cast(unsigned, b); }
constexpr int BIGBAND = 1 << 28;

struct HJob {
    const bf16* q; int qpitch;
    const bf16* k; int kpitch;
    const bf16* k2; int k2pitch;
    const bf16* v; int vpitch;
    int qs0, ks0, kmax, ntiles, band; float slope2;
};

template <int DK, int DV, bool IL, bool SHV>
struct Core {
    static constexpr int KSTR = DK * 2 + 16, VSTR = (DV == 128) ? 320 : 192;
    static constexpr int KBYTES = 64 * KSTR, VBYTES = 64 * VSTR, HBYTES = KBYTES + VBYTES;
    static constexpr int NDS = DK / 16, NC = DV / 32, KCH = DK / 32, VCH = SHV ? DV / 64 : DV / 32, KCPR = DK / 8, VCPR = DV / 8;
    static constexpr int STG = SHV ? 2 * KBYTES + VBYTES : HBYTES, KOFF2 = SHV ? KBYTES : 0, VBASE = SHV ? 2 * KBYTES : KBYTES;

    static constexpr float THR = 8.0f;
    static DI void run(LAS unsigned char* lds, const HJob& J, int nt_max, f32x16 (&o)[NC], float& m_out, float& l_out, ProfSt& PS) {
        PROF_MARK(PS, 6);
        int tid_ = threadIdx.x; asm volatile("" : "+v"(tid_));
        const int tid = tid_, lane = tid & 63, r = lane & 31, h = lane >> 5;
        const int wave = __builtin_amdgcn_readfirstlane(tid >> 6), half = wave >> 2, wq = wave & 3, ht = tid & 255;
        LAS unsigned char* hb = SHV ? lds : lds + half * 2 * HBYTES;
        const int qloc = IL ? 32 * (r >> 3) + 8 * wq + (r & 7) : 32 * wq + r;
        unsigned kgo[KCH], vgo[VCH]; int klo[KCH], vlo[VCH];
#pragma unroll
        for (int i = 0; i < KCH; ++i) {
            if (i < 2) { const int id = ht + 256 * i, row = id >> 3, cc = id & 7; kgo[i] = (unsigned)(row * J.kpitch + cc * 8) * 2u; klo[i] = half * KOFF2 + row * KSTR + cc * 16; }
            else { const int row = ht >> 2, cc = ht & 3; kgo[i] = (unsigned)(row * J.k2pitch + cc * 8) * 2u; klo[i] = half * KOFF2 + row * KSTR + 128 + cc * 16; } }
#pragma unroll
        for (int i = 0; i < VCH; ++i) { const int id = (SHV ? tid + 512 * i : ht + 256 * i), row = id / VCPR, cc = id % VCPR; vgo[i] = (unsigned)(row * J.vpitch + cc * 8) * 2u; vlo[i] = VBASE + row * VSTR + cc * 16; }
        const char* kb0 = (const char*)J.k + (size_t)J.ks0 * J.kpitch * 2; const char* k2b0 = (DK == 96) ? (const char*)J.k2 + (size_t)J.ks0 * J.k2pitch * 2 : nullptr;
        const char* vb0 = (const char*)J.v + (size_t)J.ks0 * J.vpitch * 2;
        const size_t ktile = (size_t)64 * J.kpitch * 2, k2tile = (size_t)64 * J.k2pitch * 2, vtile = (size_t)64 * J.vpitch * 2;
        v4u kreg[KCH], vreg[VCH];
#define ATT_ISSUE(ti) do { \
        _Pragma("unroll") for (int i = 0; i < KCH; ++i) kreg[i] = *(const v4u*)((i < 2 ? kb0 + (size_t)(ti) * ktile : k2b0 + (size_t)(ti) * k2tile) + kgo[i]); \
        _Pragma("unroll") for (int i = 0; i < VCH; ++i) vreg[i] = *(const v4u*)(vb0 + (size_t)(ti) * vtile + vgo[i]); } while (0)
#define ATT_COMMIT(st) do { LAS unsigned char* sb_ = hb + (st) * STG; \
        _Pragma("unroll") for (int i = 0; i < KCH; ++i) *(LAS v4u*)(sb_ + klo[i]) = kreg[i]; \
        _Pragma("unroll") for (int i = 0; i < VCH; ++i) *(LAS v4u*)(sb_ + vlo[i]) = vreg[i]; } while (0)
        const int qidx = J.qs0 + qloc, wq0 = J.qs0 + (IL ? 8 * wq : 32 * wq), wq1 = wq0 + (IL ? 103 : 31), nt = J.ntiles;
        float m = 0.f, l = 0.f; bool started = false;
#pragma unroll
        for (int c = 0; c < NC; ++c)
#pragma unroll
            for (int i = 0; i < 16; ++i) o[c][i] = 0.f;
        if (nt > 0) ATT_ISSUE(nt - 1);
        bf16x8 qf[NDS];
        { const bf16* qp = J.q + (size_t)qloc * J.qpitch + 8 * h;
#pragma unroll
          for (int ds = 0; ds < NDS; ++ds) qf[ds] = *(const bf16x8*)(qp + 16 * ds);
#pragma unroll
          for (int ds = 0; ds < NDS; ++ds) asm volatile("" : "+v"(qf[ds])); }
        if (nt > 0) ATT_COMMIT(0);
        if (nt > 1) ATT_ISSUE(nt - 2);
        const int koff = half * KOFF2 + r * KSTR + 16 * h;
        const int voff = VBASE + (4 * h + ((lane & 15) >> 2)) * VSTR + ((lane >> 4) & 1) * 32 + (lane & 3) * 8;
        for (int kt = 0; kt < nt_max; ++kt) {
            PROF_MARK(PS, 1);
            asm volatile("s_waitcnt lgkmcnt(0)\n\ts_barrier" ::: "memory");
            PROF_MARK(PS, 2);
            if (kt + 1 < nt) ATT_COMMIT((kt + 1) & 1);
            if (kt + 2 < nt) ATT_ISSUE(nt - 3 - kt);
            const int ti = nt - 1 - kt, tk0 = J.ks0 + 64 * ti;
            if (kt < nt && tk0 <= wq1 && tk0 + 63 >= wq0 - J.band) {
                PROF_MARK(PS, 3);
                const LAS unsigned char* sb = hb + (kt & 1) * STG;
                f32x16 p[2];
#pragma unroll
                for (int kb = 0; kb < 2; ++kb) { const float base = J.slope2 * (float)(tk0 + 32 * kb + 4 * h - qidx) - m;
#pragma unroll
                    for (int i = 0; i < 16; ++i) p[kb][i] = __builtin_fmaf(J.slope2, (float)((i & 3) + 8 * (i >> 2)), base); }
                { bf16x8 kf[3][2];
#pragma unroll
                  for (int q = 0; q < 2; ++q) { kf[q][0] = *(const LAS bf16x8*)(sb + koff + q * 32); kf[q][1] = *(const LAS bf16x8*)(sb + koff + 32 * KSTR + q * 32); }
#pragma unroll
                  for (int ds = 0; ds < NDS; ++ds) {
                      if (ds + 2 < NDS) { kf[(ds + 2) % 3][0] = *(const LAS bf16x8*)(sb + koff + (ds + 2) * 32); kf[(ds + 2) % 3][1] = *(const LAS bf16x8*)(sb + koff + 32 * KSTR + (ds + 2) * 32); }
                      p[0] = __builtin_amdgcn_mfma_f32_32x32x16_bf16(kf[ds % 3][0], qf[ds], p[0], 0, 0, 0); p[1] = __builtin_amdgcn_mfma_f32_32x32x16_bf16(kf[ds % 3][1], qf[ds], p[1], 0, 0, 0);
                      __builtin_amdgcn_sched_barrier(0); } }
                v4i16_t va[NC][2], vb[NC][2];
#pragma unroll
                for (int c = 0; c < NC; ++c) { va[c][0] = __builtin_amdgcn_ds_read_tr16_b64_v4i16((LAS v4i16_t*)(sb + voff + c * 64)); va[c][1] = __builtin_amdgcn_ds_read_tr16_b64_v4i16((LAS v4i16_t*)(sb + voff + 8 * VSTR + c * 64)); }
                __builtin_amdgcn_sched_barrier(0);
                if (tk0 + 63 > wq0 || tk0 < wq1 - J.band) {
#pragma unroll
                    for (int kb = 0; kb < 2; ++kb)
#pragma unroll
                        for (int i = 0; i < 16; ++i) { const int kidx = tk0 + 32 * kb + (i & 3) + 8 * (i >> 2) + 4 * h; const bool ok = (kidx <= qidx) && (qidx - kidx <= J.band); if (!ok) p[kb][i] = -INFINITY; }
                }
                PROF_MARK(PS, 4);
                float g = fmaxf(p[0][0], p[1][0]);
#pragma unroll
                for (int i = 1; i < 16; ++i) g = fmaxf(g, fmaxf(p[0][i], p[1][i]));
                g = xhalf_max(g);
                const bool fin = g > -INFINITY;
                const bool up = started ? (g > THR) : fin;
                if (__any(up)) {
                    const float delta = up ? g : 0.f, alpha = started ? __builtin_amdgcn_exp2f(-delta) : 1.0f;
                    m += delta; l *= alpha;
#pragma unroll
                    for (int kb = 0; kb < 2; ++kb)
#pragma unroll
                        for (int i = 0; i < 16; ++i) p[kb][i] -= delta;
#pragma unroll
                    for (int c = 0; c < NC; ++c)
#pragma unroll
                        for (int i = 0; i < 16; ++i) o[c][i] *= alpha;
                }
                started = started || fin;
                float rs = 0.f;
#pragma unroll
                for (int ks = 0; ks < 4; ++ks) { const int kb = ks >> 1, b0 = 8 * (ks & 1); v4u w;
#pragma unroll
                    for (int i = 0; i < 8; ++i) { p[kb][b0 + i] = __builtin_amdgcn_exp2f(p[kb][b0 + i]); rs += p[kb][b0 + i]; }
                    w.x = cvtpk(p[kb][b0], p[kb][b0 + 1]); w.y = cvtpk(p[kb][b0 + 2], p[kb][b0 + 3]); w.z = cvtpk(p[kb][b0 + 4], p[kb][b0 + 5]); w.w = cvtpk(p[kb][b0 + 6], p[kb][b0 + 7]);
                    const bf16x8 pa = __builtin_bit_cast(bf16x8, w);
                    if (ks + 1 < 4) {
#pragma unroll
                        for (int c = 0; c < NC; ++c) { vb[c][0] = __builtin_amdgcn_ds_read_tr16_b64_v4i16((LAS v4i16_t*)(sb + voff + (16 * (ks + 1)) * VSTR + c * 64)); vb[c][1] = __builtin_amdgcn_ds_read_tr16_b64_v4i16((LAS v4i16_t*)(sb + voff + (16 * (ks + 1) + 8) * VSTR + c * 64)); } }
#pragma unroll
                    for (int c = 0; c < NC; ++c) { const bf16x8 vf = {va[c][0][0], va[c][0][1], va[c][0][2], va[c][0][3], va[c][1][0], va[c][1][1], va[c][1][2], va[c][1][3]};
                        o[c] = __builtin_amdgcn_mfma_f32_32x32x16_bf16(vf, pa, o[c], 0, 0, 0); }
#pragma unroll
                    for (int c = 0; c < NC; ++c) { va[c][0] = vb[c][0]; va[c][1] = vb[c][1]; }
                    __builtin_amdgcn_sched_barrier(0); }
                l += rs;
            }
        }
        PROF_MARK(PS, 5);
#undef ATT_ISSUE
#undef ATT_COMMIT
        m_out = m; l_out = xhalf_sum(l);
    }
    static DI void store_o(const f32x16 (&o)[NC], float inv, bf16* orow, int h) {
#pragma unroll
        for (int c = 0; c < NC; ++c)
#pragma unroll
            for (int g = 0; g < 4; ++g) { v2u w; w.x = cvtpk(o[c][4 * g] * inv, o[c][4 * g + 1] * inv); w.y = cvtpk(o[c][4 * g + 2] * inv, o[c][4 * g + 3] * inv);
                *(v2u*)(orow + 32 * c + 8 * g + 4 * h) = w; }
    }
};

constexpr int NJ_BC = 16 * 56, NJ_A0 = 256, NJ_A1 = 256, NJ_A2 = 256, NJOBS = NJ_BC + NJ_A0 + NJ_A1 + NJ_A2;

DI void phase(const Params& p, int l, LAS unsigned char* lds, volatile LAS unsigned* jobw, unsigned* ctr, bool st, int tmask, int j0, int j1) {
    unsigned char* ws = p.ws;
    const int tid0 = threadIdx.x; ProfSt PS; PS.t0 = 0; PS.acc = 0; PS.cur = 0; PROF_MARK(PS, 5);
    if (tid0 == 0) jobw[0] = atomicAdd(ctr, 1u);
    for (int it = 0;; ++it) {
        int tid = tid0; asm volatile("" : "+v"(tid));
        const int lane = tid & 63, r = lane & 31, h = lane >> 5, wave = __builtin_amdgcn_readfirstlane(tid >> 6), half = wave >> 2, wq = wave & 3;
        __syncthreads();
        const int idx = j0 + __builtin_amdgcn_readfirstlane((int)jobw[it & 1]);
        if (idx >= j1) break;
        unsigned nextj = 0u; if (tid0 == 0) nextj = atomicAdd(ctr, 1u);
        if (idx < NJ_BC) {
            const int qb = 15 - idx / 56, rr = idx % 56;
            if (rr < 32) { if (!(tmask & 2)) { if (tid0 == 0) jobw[(it + 1) & 1] = nextj; continue; }
                const int b = rr >> 2, hd = rr & 3, mp = half; const size_t t0 = (size_t)b * SEQ;
                bf16* base = (bf16*)(ws + WS_QKVB);
                HJob J; J.q = base + (t0 + 128 * qb) * PB + (2 * hd + mp) * 64; J.qpitch = PB; J.k = base + t0 * PB + 512 + (2 * hd + mp) * 64; J.kpitch = PB; J.k2 = nullptr; J.k2pitch = 0;
                J.v = base + t0 * PB + 1024 + hd * 128; J.vpitch = PB; J.qs0 = 128 * qb; J.ks0 = 0; J.kmax = SEQ - 1; J.ntiles = 2 * (qb + 1); J.band = BIGBAND; J.slope2 = alibi_b(hd) * LOG2E;
                f32x16 o[4]; float m, ls; Core<64, 128, true, true>::run(lds, J, J.ntiles, o, m, ls, PS);
                const float inv = 1.0f / ls;
                LAS float* ex = (LAS float*)lds;
                __syncthreads();
                if (half == 1) {
#pragma unroll
                    for (int c = 0; c < 4; ++c)
#pragma unroll
                        for (int i = 0; i < 16; ++i) ex[((wq * 4 + c) * 16 + i) * 64 + lane] = o[c][i] * inv;
                }
                __syncthreads();
                if (half == 0) {
                    const float lam = lam_of(p, l, lane); float ssq = 0.f;
#pragma unroll
                    for (int c = 0; c < 4; ++c)
#pragma unroll
                        for (int i = 0; i < 16; ++i) { const float d = o[c][i] * inv - lam * ex[((wq * 4 + c) * 16 + i) * 64 + lane]; o[c][i] = d; ssq += d * d; }
                    ssq = xhalf_sum(ssq);
                    const float rs = rsqrtf(ssq * (1.0f / 128.0f) + RMS_EPS) * (1.0f - lam_init_of(l));
                    const float* gs = p.in[15] + l * 128;
#pragma unroll
                    for (int c = 0; c < 4; ++c)
#pragma unroll
                        for (int g = 0; g < 4; ++g) { const f32x4 gg = *(const f32x4*)(gs + 32 * c + 8 * g + 4 * h);
                            o[c][4 * g] *= gg.x; o[c][4 * g + 1] *= gg.y; o[c][4 * g + 2] *= gg.z; o[c][4 * g + 3] *= gg.w; }
                    if (st || rs == 1.2345e33f) Core<64, 128, true, true>::store_o(o, rs, base + (t0 + 128 * qb + 32 * (r >> 3) + 8 * wq + (r & 7)) * PB + hd * 128, h);
                }
            } else { if (!(tmask & 4)) { if (tid0 == 0) jobw[(it + 1) & 1] = nextj; continue; }
                const int r2 = rr - 32, b = r2 / 3, hh = 2 * (r2 % 3) + half; const size_t t0 = (size_t)b * SEQ;
                const bf16* kv = (const bf16*)(ws + WS_KVC) + t0 * PKV + hh * 128;
                HJob J; J.q = (const bf16*)(ws + WS_QC) + (t0 + 128 * qb) * PQC + hh * 96; J.qpitch = PQC; J.k = kv; J.kpitch = PKV; J.k2 = (const bf16*)(ws + WS_KR) + t0 * 32; J.k2pitch = 32;
                J.v = kv + 64; J.vpitch = PKV; J.qs0 = 128 * qb; J.ks0 = 0; J.kmax = SEQ - 1; J.ntiles = 2 * (qb + 1); J.band = BIGBAND; J.slope2 = 0.f;
                f32x16 o[2]; float m, ls; Core<96, 64, true, false>::run(lds, J, J.ntiles, o, m, ls, PS);
                if (st || ls == 1.2345e33f) Core<96, 64, true, false>::store_o(o, 1.0f / ls, (bf16*)(ws + WS_OC) + (t0 + 128 * qb + 32 * (r >> 3) + 8 * wq + (r & 7)) * POC + hh * 64, h);
            }
        } else { if (!(tmask & 1)) { if (tid0 == 0) jobw[(it + 1) & 1] = nextj; continue; }
            int a = idx - NJ_BC, g, c, qb, b, sp;
            if (a < NJ_A0) { g = 0; c = 0; b = a >> 5; sp = (a >> 4) & 1; qb = a & 15; }
            else if (a < NJ_A0 + NJ_A1) { a -= NJ_A0; g = 1; b = a >> 5; sp = (a >> 4) & 1; c = (a >> 2) & 3; qb = a & 3; }
            else { a -= NJ_A0 + NJ_A1; g = 2; b = a >> 5; sp = (a >> 4) & 1; c = a & 15; qb = 0; }
            const int dil = g == 0 ? 1 : (g == 1 ? 4 : 16), L = SEQ / dil, hh = g * 4 + 2 * sp + half; const size_t t0 = (size_t)b * SEQ;
            bf16* base = (bf16*)(ws + WS_QKVA) + (t0 + c) * PA + hh * 64;
            HJob J; J.q = base + (size_t)(128 * qb) * dil * PA; J.qpitch = dil * PA; J.k = base + 768; J.kpitch = dil * PA; J.k2 = nullptr; J.k2pitch = 0; J.v = base + 1536; J.vpitch = dil * PA;
            J.qs0 = 128 * qb; J.ks0 = qb == 0 ? 0 : 128 * qb - 128; J.kmax = L - 1; J.ntiles = qb == 0 ? 2 : 4; J.band = 128; J.slope2 = alibi_a(hh) * LOG2E * (float)dil;
            f32x16 o[2]; float m, ls; Core<64, 64, false, false>::run(lds, J, J.ntiles, o, m, ls, PS);
            const int qi = 128 * qb + 32 * wq + r;
            if (st || ls == 1.2345e33f) Core<64, 64, false, false>::store_o(o, 1.0f / ls, base + (size_t)qi * dil * PA, h);
            if ((st || ls == 1.2345e33f) && h == 0) ((float*)(ws + WS_LSE))[((size_t)g * M + t0 + c + (size_t)qi * dil) * 4 + (2 * sp + half)] = m + log2f(ls);
        }
        if (tid0 == 0) jobw[(it + 1) & 1] = nextj;
    }
    PROF_MARK(PS, 0);
    if (ATT_PROF && blockIdx.x == 0 && tid0 == 0) { jobw[24] += (unsigned)PS.acc; jobw[25] += (unsigned)(PS.acc >> 32) + ((jobw[24] < (unsigned)PS.acc) ? 1u : 0u); }
}
}
struct MkProj {
    ProjDst D; float* ssq_q; float* ssq_kv;
    DI EpiProj make(const pg8::GUnit& u) const { return D.of(u.col0); }
    DI void extra(const f32x4 (&acc)[2][2][4][2], const pg8::GUnit& u, int wr, int wc, int fr, int fq) const {
        if (u.col0 != 3840 && u.col0 != 4096) return;
        const bool kv = (u.col0 == 4096); float* dst = kv ? ssq_kv : ssq_q;
#pragma unroll
        for (int ai = 0; ai < 2; ++ai)
#pragma unroll
            for (int m = 0; m < 4; ++m) { float s = 0.f;
#pragma unroll
                for (int bj = 0; bj < 2; ++bj) { if (kv && bj == 1) continue;
#pragma unroll
                    for (int n = 0; n < 2; ++n)
#pragma unroll
                        for (int c = 0; c < 4; ++c) { const float r = bf2f((unsigned short)f2bf(acc[ai][bj][m][n][c])); s += r * r; } }
                s += __shfl_xor(s, 16); s += __shfl_xor(s, 32);
                if (fq == 0) dst[(size_t)(u.row0 + ai * 128 + wr * 64 + m * 16 + fr) * 4 + wc] = s; }
    }
};
template <class F> struct MkPlain { F E; DI F make(const pg8::GUnit&) const { return E; } DI void extra(const f32x4 (&)[2][2][4][2], const pg8::GUnit&, int, int, int, int) const {} };
struct MkGateUp { bf16* act; const float* wl;
    DI EpiGateUp make(const pg8::GUnit& u) const { return EpiGateUp{act, wl + u.e * M, u.sb}; }
    DI void extra(const f32x4 (&)[2][2][4][2], const pg8::GUnit&, int, int, int, int) const {} };
struct MkDown { bf16* y; const int* list;
    DI EpiDown make(const pg8::GUnit& u) const { return EpiDown{y, list + u.e * M, u.row0 + u.cnt}; }
    DI void extra(const f32x4 (&)[2][2][4][2], const pg8::GUnit&, int, int, int, int) const {} };

#define XB_TMO      128
#define XB_XCNT(j)  (256  + 64 * (j))
#define XB_XSUB(j)  (1280 + 64 * (j))
#define XB_XGEN(j)  (2304 + 64 * (j))
#define XB_TOP      3328
#define XB_TOPGEN   3392
#define XCD_BAR_WORDS 3456
#define XB_SPIN_CAP (1u << 18)
__device__ __forceinline__ unsigned xb_ld(unsigned* p)              { return __hip_atomic_load(p, __ATOMIC_RELAXED, __HIP_MEMORY_SCOPE_AGENT); }
__device__ __forceinline__ unsigned xb_add(unsigned* p, unsigned v) { return __hip_atomic_fetch_add(p, v, __ATOMIC_RELAXED, __HIP_MEMORY_SCOPE_AGENT); }
__device__ __forceinline__ unsigned xb_xcc_id() { return (unsigned)__builtin_amdgcn_s_getreg((3 << 11) | 20) & 0xFu; }
#define XB_SPIN(cond, bar) do { unsigned _sp = 0; while (cond) { __builtin_amdgcn_s_sleep(1); \
    if ((++_sp & 255u) == 0u) { if (xb_ld(&(bar)[XB_TMO])) break; if (_sp > XB_SPIN_CAP) { atomicAdd(&(bar)[XB_TMO], 1u); break; } } } } while (0)
struct XcdBarrier { unsigned* bar; unsigned x; volatile LAS unsigned* st; };
__device__ __forceinline__ XcdBarrier xcd_barrier_post(unsigned* bar, volatile LAS unsigned* st) {
    XcdBarrier b; b.bar = bar; b.x = xb_xcc_id(); b.st = st;
    if (threadIdx.x == 0) (void)xb_add(&bar[XB_XCNT(b.x)], 1u);
    return b;
}
__device__ __forceinline__ void xcd_barrier_complete(unsigned* bar, unsigned x, unsigned& nloc, unsigned& nx) {
    const unsigned G = gridDim.x * gridDim.y * gridDim.z;
    unsigned sum, cnt, mine, sp = 0u;
    for (;;) {
        sum = 0u; cnt = 0u; mine = 0u;
#pragma unroll
        for (unsigned j = 0; j < 16; ++j) { const unsigned c = xb_ld(&bar[XB_XCNT(j)]); sum += c; cnt += (c > 0u) ? 1u : 0u; mine = (j == x) ? c : mine; }
        if (sum == G) break;
        __builtin_amdgcn_s_sleep(1);
        if ((++sp & 255u) == 0u) { if (xb_ld(&bar[XB_TMO])) break; if (sp > XB_SPIN_CAP) { atomicAdd(&bar[XB_TMO], 1u); break; } }
    }
    nloc = mine > 0u ? mine : 1u; nx = cnt > 0u ? cnt : 1u;
}
__device__ __forceinline__ void xcd_barrier(const XcdBarrier& b) {
    asm volatile("s_waitcnt vmcnt(0)" ::: "memory");
    __syncthreads();
    if (threadIdx.x == 0) {
        unsigned* bar = b.bar;
        __builtin_amdgcn_s_waitcnt(0);
        unsigned nloc = b.st[0], nx = b.st[1];
        if (nloc == 0u) { xcd_barrier_complete(bar, b.x, nloc, nx); b.st[0] = nloc; b.st[1] = nx; }
        const unsigned old = xb_add(&bar[XB_XSUB(b.x)], 1u);
        const unsigned gen = old / nloc;
        if (old + 1u == (gen + 1u) * nloc) {
            __builtin_amdgcn_fence(__ATOMIC_RELEASE, "agent");
            asm volatile("s_waitcnt vmcnt(0)" ::: "memory");
            const unsigned og = xb_add(&bar[XB_TOP], 1u);
            const unsigned tg = og / nx;
            if (og + 1u == (tg + 1u) * nx) xb_add(&bar[XB_TOPGEN], 1u);
            else XB_SPIN(xb_ld(&bar[XB_TOPGEN]) == tg, bar);
            __builtin_amdgcn_fence(__ATOMIC_ACQUIRE, "agent");
            xb_add(&bar[XB_XGEN(b.x)], 1u);
            asm volatile("s_waitcnt vmcnt(0)" ::: "memory");
        } else {
            XB_SPIN(xb_ld(&bar[XB_XGEN(b.x)]) == gen, bar);
            __builtin_amdgcn_fence(__ATOMIC_ACQUIRE, "agent");
            asm volatile("s_waitcnt vmcnt(0)" ::: "memory");
        }
    }
    __syncthreads();
}

constexpr int NWAVES = 8;
constexpr int RING_BYTES = 131072, MISC_OFF = RING_BYTES, LDS_BYTES = 147456;
#ifndef PH_MASK
#define PH_MASK 0x7ff
#endif
#define PH_EN(k) (((PH_MASK) >> (k)) & 1)
#ifndef REP_MASK
#define REP_MASK 0
#endif
#define NREP(k) ((((REP_MASK) >> (k)) & 1) ? 2 : 1)
#ifndef MK_PER_PHASE
#define MK_PER_PHASE 0
#endif
constexpr int N_PHASES = 1 + DEPTH * 10;
struct Args { Params p; int ph_lo, ph_hi, zero, pad; };

DI unsigned long long rf64(unsigned long long v) { const unsigned lo = __builtin_amdgcn_readfirstlane((unsigned)v), hi = __builtin_amdgcn_readfirstlane((unsigned)(v >> 32)); return ((unsigned long long)hi << 32) | lo; }
DI Params load_params(LAS const unsigned long long* PT) { Params p;
#pragma unroll
    for (int i = 0; i < 23; ++i) p.in[i] = (const float*)(GAS const float*)rf64(PT[i]);
    p.out = (float*)(GAS float*)rf64(PT[23]); p.ws = (unsigned char*)(GAS unsigned char*)rf64(PT[24]); return p; }
__global__ void __launch_bounds__(NWAVES * 64, 2) mega_fwd(Args args) {
    extern __shared__ __attribute__((aligned(16))) unsigned char lds_raw[];
    LAS unsigned char* lds = (LAS unsigned char*)lds_raw;
    const int tid = threadIdx.x, lane0 = tid & 63, wave0 = __builtin_amdgcn_readfirstlane(tid >> 6);
    LAS unsigned long long* PT = (LAS unsigned long long*)(lds + MISC_OFF + 256);
    if (tid < 23) PT[tid] = (unsigned long long)args.p.in[tid];
    if (tid == 23) PT[23] = (unsigned long long)args.p.out;
    if (tid == 24) PT[24] = (unsigned long long)args.p.ws;
    const int G0 = gridDim.x;
    volatile LAS unsigned* MISC = (volatile LAS unsigned*)(lds + MISC_OFF);
    if (tid < 64) MISC[tid] = 0u;
    __syncthreads();
    XcdBarrier bar; { unsigned* ctl0 = (unsigned*)((unsigned char*)(GAS unsigned char*)rf64(PT[24]) + WS_CTL); bar.bar = ctl0 + CW_BAR; bar.x = 0; bar.st = nullptr;
        if (!MK_PER_PHASE) bar = xcd_barrier_post(ctl0 + CW_BAR, MISC + 8); }
#define LOADP() int lane = lane0, wave = wave0, G = G0, bid = (int)blockIdx.x; asm volatile("" : "+v"(lane)); asm volatile("" : "+s"(wave), "+s"(G), "+s"(bid)); \
    const int gw = bid * NWAVES + wave, NGW = G * NWAVES; LAS float* const scr = (LAS float*)(lds + wave * 16384); (void)gw; (void)NGW; (void)scr; (void)lane; \
    const Params p = load_params(PT); unsigned char* const ws = p.ws; unsigned* const ctl = (unsigned*)(ws + WS_CTL); const f32x2* const rope = (const f32x2*)(ws + WS_ROPE); (void)ctl; (void)rope
    const int lo = args.ph_lo, hi = args.ph_hi;
#define IN(k) (lo <= (k) && (k) < hi)
#ifndef XBAR_REP
#define XBAR_REP 0
#endif
#ifndef DRY_TMASK
#define DRY_TMASK 7
#endif
#ifndef PROBE_PH
#define PROBE_PH -1
#endif
#ifndef PROBE_K
#define PROBE_K 4
#endif
#define T0COND (blockIdx.x == 0 && wave0 == 0 && __builtin_amdgcn_mbcnt_hi(~0u, __builtin_amdgcn_mbcnt_lo(~0u, 0u)) == 0u)
#define STAMP(slot) do { if (PROBE_PH >= 0 && T0COND) { const unsigned long long t_ = __builtin_amdgcn_s_memrealtime(); MISC[32 + 2 * (slot)] = (unsigned)t_; MISC[33 + 2 * (slot)] = (unsigned)(t_ >> 32); } } while (0)
#define PRB_L ((PROBE_PH - 1) / 10)
#define PRB_K ((PROBE_PH - 1) % 10)
#define SEAMX(k, endhit, beghit) do { if (IN(k) && IN((k) + 1)) { xcd_barrier(bar); if (XBAR_REP) { xcd_barrier(bar); xcd_barrier(bar); xcd_barrier(bar); xcd_barrier(bar); } } if (PROBE_PH >= 0 && (endhit)) STAMP(1); if (PROBE_PH >= 0 && (beghit)) STAMP(0); } while (0)
#define SEAM(k) SEAMX(k, false, false)
#define SEAML(kc) SEAMX(P + (kc), PROBE_PH >= 1 && (kc) == PRB_K && l == PRB_L, PROBE_PH >= 1 && (((kc) + 1 == PRB_K && l == PRB_L) || ((kc) == 9 && PRB_K == 0 && l + 1 == PRB_L)))

    if (PROBE_PH == 0) STAMP(0);
    if (PH_EN(0) && IN(0)) for (int rep = 0; rep < NREP(0); ++rep) { LOADP(); ph_cvt_mixer(p, 0, gw, NGW, lane, scr); ph_rope_table(p, gw, NGW, lane); ph_rmsnorm(p.in[0], p.in[2], (bf16*)(ws + WS_U), gw, NGW, lane); }
    SEAMX(0, PROBE_PH == 0, PROBE_PH == 1);
    for (int l = 0; l < DEPTH; ++l) {
        const int P = 1 + l * 10;
        if (PH_EN(1) && IN(P + 0)) for (int rep = 0; rep < NREP(1); ++rep) { LOADP();
            pg8::DenseSched S; S.T.init(M / 256, G == 256 ? NPROJ / 256 - 1 : NPROJ / 256, G, bid); S.A = (const char*)(ws + WS_U); S.Bt = (const char*)(ws + WM_IN); S.lda = DM; S.K = DM;
            pg8::Epi8<MkProj> E{MkProj{ProjDst{(bf16*)(ws + WS_QKVA), (bf16*)(ws + WS_QKVB), (bf16*)(ws + WS_CLAT), (bf16*)(ws + WS_G), rope, (bf16*)(ws + WS_KR)}, (float*)(ws + WS_SSQQ), (float*)(ws + WS_SSQKV)}};
            pg8::gemm_phase(lds, S, E, MISC + 40, 1);
        }
        SEAML(0);
        if (PH_EN(2) && IN(P + 1)) for (int rep = 0; rep < NREP(2); ++rep) { LOADP();
            const bool split = (G == 256);
            if (split && bid < 64) {
                pg8::DenseSched S; S.T.init(M / 256, 1, 64, bid); S.pn0 = NPROJ / 256 - 1; S.A = (const char*)(ws + WS_U); S.Bt = (const char*)(ws + WM_IN); S.lda = DM; S.K = DM;
                pg8::Epi8<MkProj> E{MkProj{ProjDst{(bf16*)(ws + WS_QKVA), (bf16*)(ws + WS_QKVB), (bf16*)(ws + WS_CLAT), (bf16*)(ws + WS_G), rope, (bf16*)(ws + WS_KR)}, (float*)(ws + WS_SSQQ), (float*)(ws + WS_SSQKV)}};
                pg8::gemm_phase(lds, S, E);
            } else {
            const int Gb = split ? 192 : G, cb = split ? bid - 64 : bid;
            { pg8::DenseSched S; S.T.init(M / 256, 3, Gb, cb); S.A = (const char*)(ws + WS_CLAT); S.Bt = (const char*)(ws + WM_UQ); S.lda = PCL; S.K = 256;
              pg8::Epi8<MkPlain<EpiQc>> E{MkPlain<EpiQc>{EpiQc{(bf16*)(ws + WS_QC), (const float*)(ws + WS_SSQQ), rope}}};
              pg8::gemm_phase(lds, S, E, MISC + 40, 2); }
            { pg8::DenseSched S; S.T.init(M / 256, 3, Gb, cb); S.A = (const char*)(ws + WS_CLAT) + 512; S.Bt = (const char*)(ws + WM_UKV); S.lda = PCL; S.K = 256;
              pg8::Epi8<MkPlain<EpiKv>> E{MkPlain<EpiKv>{EpiKv{(bf16*)(ws + WS_KVC), (const float*)(ws + WS_SSQKV)}}};
              pg8::gemm_phase(lds, S, E, MISC + 40, 2); }
            }
        }
        SEAML(1);
        if (PH_EN(3) && IN(P + 2)) { LOADP();
            if (NREP(3) == 2) { att::phase(p, l, lds, MISC + 16, ctl + CW_ATTN + l * 64 + 8, args.zero != 0, DRY_TMASK, 0, att::NJOBS); __syncthreads(); }
            att::phase(p, l, lds, MISC + 16, ctl + CW_ATTN + l * 64, true, 7, 0, att::NJOBS);
        }
        SEAML(2);
        if (PH_EN(4) && IN(P + 3)) { LOADP(); ph_amerge(p, gw, NGW, lane); }
        SEAML(3);
        if (PH_EN(5) && IN(P + 4)) for (int rep = 0; rep < NREP(5); ++rep) { LOADP();
            const int rot = bid % 3;
            for (int s = 0; s < 3; ++s) { const int br = (s + rot) % 3;
                pg8::DenseSched S; S.T.init(M / 256, 4, G, bid);
                S.A = (const char*)(ws + (br == 0 ? WS_OA : br == 1 ? WS_QKVB : WS_OC)); S.Bt = (const char*)(ws + (br == 0 ? WM_PA : br == 1 ? WM_PB : WM_PC));
                S.lda = br == 0 ? POA : br == 1 ? PB : POC; S.K = br == 0 ? 256 : br == 1 ? 512 : 384;
                pg8::Epi8<MkPlain<EpiMerge>> E{MkPlain<EpiMerge>{EpiMerge{(bf16*)(ws + WS_MERGED), (const bf16*)(ws + WS_G) + br * 1024, s == 0}}};
                pg8::gemm_phase(lds, S, E, MISC + 40, 5); }
        }
        SEAML(4);
        if (PH_EN(6) && IN(P + 5)) for (int rep = 0; rep < (l == 0 ? NREP(6) : 1); ++rep) { LOADP();
            pg8::DenseSched S; S.T.init(M / 256, 4, G, bid); S.A = (const char*)(ws + WS_MERGED); S.Bt = (const char*)(ws + WM_O); S.lda = DM; S.K = DM;
            pg8::Epi4<MkPlain<EpiResid>> E{MkPlain<EpiResid>{EpiResid{l == 0 ? p.in[0] : p.out, p.out}}};
            pg8::gemm_phase(lds, S, E, MISC + 40, 6);
        }
        SEAML(5);
        if (PH_EN(7) && IN(P + 6)) { LOADP(); ph_router(p, l, bid, G, wave, lane, lds, (LAS unsigned*)(lds + 81920)); __syncthreads(); for (int rep = 0; rep < NREP(11); ++rep) ph_cvt_experts(p, l, gw, NGW, lane, scr); }
        SEAML(6);
        if (PH_EN(8) && IN(P + 7)) for (int rep = 0; rep < NREP(8); ++rep) { LOADP();
            const unsigned* cnt = ctl + CW_CNT + l * 1024;
            pg8::MoeSched<true> S{cnt, (const int*)(ws + WS_LIST), (const char*)(ws + WS_U), (const char*)(ws + WS_WGU), DM, DM, 4, G, bid, (size_t)1024 * 1024 * 2};
            pg8::Epi8<MkGateUp> E{MkGateUp{(bf16*)(ws + WS_ACT), (const float*)(ws + WS_WLIST)}};
            pg8::gemm_phase(lds, S, E, MISC + 40, 8);
        }
        SEAML(7);
        if (PH_EN(9) && IN(P + 8)) for (int rep = 0; rep < NREP(9); ++rep) { LOADP();
            const unsigned* cnt = ctl + CW_CNT + l * 1024;
            pg8::MoeSched<false> S{cnt, (const int*)(ws + WS_LIST), (const char*)(ws + WS_ACT), (const char*)(ws + WS_WD), DEXP, DEXP, 4, G, bid, (size_t)1024 * 512 * 2};
            pg8::Epi8<MkDown> E{MkDown{(bf16*)(ws + WS_Y), (const int*)(ws + WS_LIST)}};
            pg8::gemm_phase(lds, S, E, MISC + 40, 9);
        }
        SEAML(8);
        if (PH_EN(10) && IN(P + 9)) { LOADP(); if (NREP(14) == 2) ph_combine(p, l, gw, NGW, lane, args.zero != 0); ph_combine(p, l, gw, NGW, lane, true); if (l + 1 < DEPTH) for (int rep = 0; rep < NREP(12); ++rep) ph_cvt_mixer(p, l + 1, gw, NGW, lane, scr); }
        SEAML(9);
    }
    if (PROBE_PH >= 0 && T0COND) {
        if (PROBE_PH == N_PHASES - 1) STAMP(1);
        const unsigned long long t0 = ((unsigned long long)MISC[33] << 32) | MISC[32], t1 = ((unsigned long long)MISC[35] << 32) | MISC[34];
        const unsigned long long tgt = __builtin_amdgcn_s_memrealtime() + (unsigned long long)PROBE_K * (t1 - t0);
        while (__builtin_amdgcn_s_memrealtime() < tgt) __builtin_amdgcn_s_sleep(8);
    }
    if ((ATT_PROF || GEMM_PROF) && T0COND) {
        const unsigned long long acc = ((unsigned long long)MISC[41] << 32) | MISC[40];
        const unsigned long long tgt = __builtin_readcyclecounter() + (unsigned long long)PROBE_K * acc;
        while (__builtin_readcyclecounter() < tgt) __builtin_amdgcn_s_sleep(8);
    }
#undef IN
#undef SEAM
}

extern "C" void kernel_launch(void* const* d_in, const int* in_sizes, int n_in, void* d_out, int out_size, void* d_ws, size_t ws_size, hipStream_t stream) {
    static int grid = 0;
    if (grid == 0) {
        if (n_in != 23 || ws_size < WS_END || out_size != M * DM) { fprintf(stderr, "kernel_launch: unexpected sizes\n"); grid = -1; return; }
        int dev = 0, cus = 0, per_cu = 0;
        if (hipGetDevice(&dev) != hipSuccess || hipDeviceGetAttribute(&cus, hipDeviceAttributeMultiprocessorCount, dev) != hipSuccess) { grid = -1; return; }
        if (hipFuncSetAttribute((const void*)mega_fwd, hipFuncAttributeMaxDynamicSharedMemorySize, LDS_BYTES) != hipSuccess) { fprintf(stderr, "kernel_launch: hipFuncSetAttribute failed\n"); grid = -1; return; }
        if (hipOccupancyMaxActiveBlocksPerMultiprocessor(&per_cu, (const void*)mega_fwd, NWAVES * 64, LDS_BYTES) != hipSuccess || per_cu < 1) { fprintf(stderr, "kernel_launch: occupancy query says %d\n", per_cu); }
        (void)hipGetLastError();
        grid = cus;
    }
    if (grid < 0) return;
    (void)hipMemsetAsync((char*)d_ws + WS_CTL, 0, CTL_BYTES, stream);
    Args a{}; for (int i = 0; i < 23; ++i) a.p.in[i] = (const float*)d_in[i]; a.p.out = (float*)d_out; a.p.ws = (unsigned char*)d_ws;
#if MK_PER_PHASE
    for (int ph = 0; ph < N_PHASES; ++ph) { a.ph_lo = ph; a.ph_hi = ph + 1; hipLaunchKernelGGL(mega_fwd, dim3(grid), dim3(NWAVES * 64), LDS_BYTES, stream, a); }
#else
    a.ph_lo = 0; a.ph_hi = N_PHASES; hipLaunchKernelGGL(mega_fwd, dim3(grid), dim3(NWAVES * 64), LDS_BYTES, stream, a);
#endif
}
```

```cpp
#include <hip/hip_runtime.h>
#include <cstdio>
#include <cstdint>
#include <cmath>

#define GAS __attribute__((address_space(1)))
#define LAS __attribute__((address_space(3)))
#define DI __device__ __forceinline__
typedef unsigned short bf16;
typedef unsigned v4u __attribute__((ext_vector_type(4)));
typedef unsigned v2u __attribute__((ext_vector_type(2)));
typedef float f32x4 __attribute__((ext_vector_type(4)));
typedef float f32x2 __attribute__((ext_vector_type(2)));
typedef float f32x16 __attribute__((ext_vector_type(16)));
typedef short bf16x8 __attribute__((ext_vector_type(8)));
typedef short s16x4 __attribute__((ext_vector_type(4)));

constexpr int NB = 8, SEQ = 2048, DM = 1024, M = NB * SEQ, DEPTH = 2;
constexpr int IN_COLS = 7328, NPROJ = 7424;
constexpr int NEXP = 16, DEXP = 512;
constexpr float RMS_EPS = 1e-6f;
constexpr float LOG2E = 1.4426950408889634f;
constexpr float C2A = 0.125f * LOG2E;
constexpr float C2C = 0.10206207261596577f * LOG2E;
constexpr int PA = 2304, PB = 1536, PCL = 512, PG = 3072, PQC = 576, PKV = 768, POC = 384, POA = 256;
constexpr int KR_COL = 384;

constexpr size_t MiB = 1u << 20;
constexpr size_t WS_CTL = 0, CTL_BYTES = 256 * 1024;
constexpr size_t WS_LIST = 1 * MiB;
constexpr size_t WS_WLIST = 2 * MiB;
constexpr size_t WS_SSQQ = 3 * MiB;
constexpr size_t WS_SSQKV = 3 * MiB + 256 * 1024;
constexpr size_t WS_LSE = 3 * MiB + 512 * 1024;
constexpr size_t WS_ROPE = 4 * MiB + 256 * 1024;
constexpr size_t WS_KR = 4 * MiB + 512 * 1024;
constexpr size_t WS_WMIX = 6 * MiB;
constexpr size_t WM_IN = WS_WMIX;
constexpr size_t WM_O = WM_IN + (size_t)NPROJ * DM * 2;
constexpr size_t WM_PA = WM_O + (size_t)DM * DM * 2;
constexpr size_t WM_PB = WM_PA + (size_t)DM * 256 * 2;
constexpr size_t WM_PC = WM_PB + (size_t)DM * 512 * 2;
constexpr size_t WM_UQ = WM_PC + (size_t)DM * 384 * 2;
constexpr size_t WM_UKV = WM_UQ + (size_t)768 * 256 * 2;
constexpr size_t WM_END = WM_UKV + (size_t)768 * 256 * 2;
static_assert(WM_END <= 26 * MiB, "mixer weights");
constexpr size_t WS_U = 26 * MiB;
constexpr size_t WS_OA = WS_U + 24 * MiB;
constexpr size_t WS_QKVA = 58 * MiB;
constexpr size_t WS_QKVB = 130 * MiB;
constexpr size_t WS_CLAT = 178 * MiB;
constexpr size_t WS_OC = WS_CLAT;
constexpr size_t WS_G = 194 * MiB;
constexpr size_t WS_QC = 290 * MiB;
constexpr size_t WS_KVC = 308 * MiB;
constexpr size_t WS_END = 332 * MiB;
constexpr size_t WS_MERGED = WS_QKVA;
constexpr size_t WS_WGU = 58 * MiB;
constexpr size_t WS_WD = 90 * MiB;
constexpr size_t WS_ACT = 106 * MiB;
constexpr size_t WS_Y = 142 * MiB;
constexpr int ACT_ROWS = 2 * M + NEXP * 256;
static_assert(WS_ACT + (size_t)ACT_ROWS * DEXP * 2 <= WS_Y && WS_Y + (size_t)2 * M * DM * 2 <= WS_G + 96 * MiB && WS_KVC + (size_t)M * 768 * 2 <= WS_END, "ws map");
constexpr int CW_TMO = 0;
constexpr int CW_CNT = 16384;
constexpr int CW_ERR = 256;
constexpr int CW_ATTN = 512;
constexpr int CW_BAR = 4096;

struct Params {
    const float* in[23]; float* out; unsigned char* ws;
};

DI unsigned f2bf(float f) { unsigned u = __builtin_bit_cast(unsigned, f); return (u + 0x7fffu + ((u >> 16) & 1u)) >> 16; }
typedef __bf16 bf16x2_hw __attribute__((ext_vector_type(2)));
DI unsigned pk2(float lo, float hi) { f32x2 v = {lo, hi}; bf16x2_hw b = __builtin_convertvector(v, bf16x2_hw); return __builtin_bit_cast(unsigned, b); }
DI float bf2f(unsigned short b) { return __builtin_bit_cast(float, (unsigned)b << 16); }
DI float bflo(unsigned w) { return __builtin_bit_cast(float, w << 16); }
DI float bfhi(unsigned w) { return __builtin_bit_cast(float, w & 0xffff0000u); }
DI float wave_sum(float v) {
#pragma unroll
    for (int o = 1; o < 64; o <<= 1) v += __shfl_xor(v, o);
    return v;
}
DI float wave_max(float v) {
#pragma unroll
    for (int o = 1; o < 64; o <<= 1) v = fmaxf(v, __shfl_xor(v, o));
    return v;
}
DI float sigmoidf_(float x) { return __builtin_amdgcn_rcpf(1.0f + __builtin_amdgcn_exp2f(-LOG2E * x)); }
DI float alibi_a(int h) { return exp2f(-8.0f * (float)(h + 1) / 12.0f); }
DI float alibi_b(int h) { return exp2f(-2.0f * (float)(h + 1)); }
DI float lam_init_of(int l) { return 0.8f - 0.6f * expf(-0.3f * (float)l); }
DI float lam_of(const Params& p, int l, int lane) {
    const float a = p.in[11][l * 64 + lane] * p.in[12][l * 64 + lane], b = p.in[13][l * 64 + lane] * p.in[14][l * 64 + lane];
    return expf(wave_sum(a)) - expf(wave_sum(b)) + lam_init_of(l);
}
#define LDS_WAIT() asm volatile("s_waitcnt lgkmcnt(0)" ::: "memory")

struct MapIdent { int off; DI int operator()(int n) const { return n + off; } };
struct MapWin { DI int operator()(int n) const { if (n < 4224) return n; if (n < 4256) { const int i = n - 4224; return 4224 + (i < 16 ? 2 * i : 2 * (i - 16) + 1); } return n + 96; } };
struct MapUq { DI int operator()(int n) const { const int h = n / 96, j = n % 96; if (j < 64) return n; const int i = j - 64; return h * 96 + 64 + (i < 16 ? 2 * i : 2 * (i - 16) + 1); } };
struct MapGate { DI int operator()(int n) const { return 8 * (n >> 2) + (n & 3); } };
struct MapUp { DI int operator()(int n) const { return 8 * (n >> 2) + 4 + (n & 3); } };

struct CvtDesc { const float* W; int N; bf16* WT; int Kd; const float* gk; int mapid, item; };
DI int cvt_map(int mapid, int n) { return mapid == 0 ? n : mapid == 1 ? MapWin{}(n) : mapid == 2 ? MapUq{}(n) : mapid == 3 ? MapGate{}(n) : MapUp{}(n); }
DI void cvt_load(const CvtDesc& d, int lane, float (&v)[32]) {
    const int nblk = d.N / 32, kb = d.item / nblk, nb = d.item % nblk, k0 = 64 * kb, n0 = 32 * nb;
    const float* src = d.W + (size_t)(k0 + (lane >> 5)) * d.N + n0 + (lane & 31);
#pragma unroll
    for (int i = 0; i < 32; ++i) v[i] = src[(size_t)(2 * i) * d.N];
    if (d.gk) {
#pragma unroll
        for (int i = 0; i < 32; ++i) v[i] *= d.gk[k0 + 2 * i + (lane >> 5)]; }
}
DI void cvt_store(const CvtDesc& d, int lane, const float (&v)[32], LAS float* scr) {
    const int nblk = d.N / 32, kb = d.item / nblk, nb = d.item % nblk, k0 = 64 * kb, n0 = 32 * nb;
#pragma unroll
    for (int i = 0; i < 32; ++i) scr[(2 * i + (lane >> 5)) * 33 + (lane & 31)] = v[i];
    LDS_WAIT(); asm volatile("" ::: "memory");
    const int c = lane & 7;
#pragma unroll
    for (int j = 0; j < 4; ++j) { const int n = (lane >> 3) + 8 * j; const LAS float* s = scr + (8 * c) * 33 + n;
        v4u o; o.x = pk2(s[0 * 33], s[1 * 33]); o.y = pk2(s[2 * 33], s[3 * 33]); o.z = pk2(s[4 * 33], s[5 * 33]); o.w = pk2(s[6 * 33], s[7 * 33]);
        const int dr = cvt_map(d.mapid, n0 + n);
        *(v4u*)(d.WT + (size_t)dr * d.Kd + k0 + 8 * c) = o; }
    LDS_WAIT(); asm volatile("" ::: "memory");
}
template <class Dec>
DI void cvt_run(const Dec& dec, int nit, int gw, int NGW, int lane, LAS float* scr) {
    float v[32], vn[32]; CvtDesc d, dn; int it = gw;
    if (it < nit) { d = dec(it); cvt_load(d, lane, v); }
    while (it < nit) { const int itn = it + NGW; dn = d;
        if (itn < nit) { dn = dec(itn); cvt_load(dn, lane, vn); }
        cvt_store(d, lane, v, scr);
#pragma unroll
        for (int i = 0; i < 32; ++i) v[i] = vn[i];
        d = dn; it = itn; }
}
struct DecMixer { const Params* p; int l;
    DI CvtDesc operator()(int it) const { unsigned char* ws = p->ws; int r = it;
        constexpr int I_IN = 16 * (IN_COLS / 32), I_O = 16 * 32, I_PA = 4 * 32, I_PB = 8 * 32, I_PC = 6 * 32, I_UQ = 4 * 18;
        if (r < I_IN) return CvtDesc{p->in[1] + (size_t)l * DM * IN_COLS, IN_COLS, (bf16*)(ws + WM_IN), DM, nullptr, 1, r}; r -= I_IN;
        if (r < I_O) return CvtDesc{p->in[6] + (size_t)l * DM * DM, DM, (bf16*)(ws + WM_O), DM, nullptr, 0, r}; r -= I_O;
        if (r < I_PA) return CvtDesc{p->in[3] + (size_t)l * 256 * DM, DM, (bf16*)(ws + WM_PA), 256, nullptr, 0, r}; r -= I_PA;
        if (r < I_PB) return CvtDesc{p->in[4] + (size_t)l * 512 * DM, DM, (bf16*)(ws + WM_PB), 512, nullptr, 0, r}; r -= I_PB;
        if (r < I_PC) return CvtDesc{p->in[5] + (size_t)l * 384 * DM, DM, (bf16*)(ws + WM_PC), 384, nullptr, 0, r}; r -= I_PC;
        if (r < I_UQ) return CvtDesc{p->in[8] + (size_t)l * 256 * 576, 576, (bf16*)(ws + WM_UQ), 256, p->in[7] + l * 256, 2, r}; r -= I_UQ;
        return CvtDesc{p->in[10] + (size_t)l * 128 * 768, 768, (bf16*)(ws + WM_UKV), 256, p->in[9] + l * 128, 0, r}; } };
DI void ph_cvt_mixer(const Params& p, int l, int gw, int NGW, int lane, LAS float* scr) {
    unsigned char* ws = p.ws;
    constexpr int NIT = 16 * (IN_COLS / 32) + 16 * 32 + 4 * 32 + 8 * 32 + 6 * 32 + 4 * 18 + 2 * 24;
    cvt_run(DecMixer{&p, l}, NIT, gw, NGW, lane, scr);
    const v4u z = {0u, 0u, 0u, 0u};
    const int gt = gw * 64 + lane, NT = NGW * 64;
    for (int c = gt; c < 96 * 128; c += NT) *(v4u*)((bf16*)(ws + WM_IN) + (size_t)4256 * DM + (size_t)c * 8) = z;
    for (int c = gt; c < 192 * 32; c += NT) *(v4u*)((bf16*)(ws + WM_UQ) + (size_t)576 * 256 + (size_t)c * 8) = z;
    for (int c = gt; c < 768 * 16; c += NT) *(v4u*)((bf16*)(ws + WM_UKV) + (size_t)(c >> 4) * 256 + 128 + (c & 15) * 8) = z;
}
struct DecExperts { const Params* p; int l;
    DI CvtDesc operator()(int it) const { unsigned char* ws = p->ws; constexpr int IG = 16 * 16, IDN = 8 * 32, PER = 2 * IG + IDN;
        const int e = it / PER; int r = it % PER; const size_t eo = ((size_t)l * NEXP + e) * DM * DEXP;
        if (r < IG) return CvtDesc{p->in[19] + eo, DEXP, (bf16*)(ws + WS_WGU) + (size_t)e * 1024 * 1024, DM, nullptr, 3, r}; r -= IG;
        if (r < IG) return CvtDesc{p->in[20] + eo, DEXP, (bf16*)(ws + WS_WGU) + (size_t)e * 1024 * 1024, DM, nullptr, 4, r}; r -= IG;
        return CvtDesc{p->in[21] + eo, DM, (bf16*)(ws + WS_WD) + (size_t)e * 1024 * 512, DEXP, nullptr, 0, r}; } };
DI void ph_cvt_experts(const Params& p, int l, int gw, int NGW, int lane, LAS float* scr) {
    cvt_run(DecExperts{&p, l}, NEXP * (2 * 16 * 16 + 8 * 32), gw, NGW, lane, scr);
}
DI void ph_rope_table(const Params& p, int gw, int NGW, int lane) {
    f32x2* tab = (f32x2*)(p.ws + WS_ROPE);
    for (int idx = gw * 64 + lane; idx < SEQ * 16; idx += NGW * 64) {
        const int pos = idx >> 4, i = idx & 15;
        double inv = 1.0; for (int j = 0; j < i; ++j) inv *= 0.56234132519034908;
        const double rev = (double)pos * inv * 0.15915494309189535;
        double fr = rev - floor(rev); if (fr >= 0.5) fr -= 1.0;
        const float f = (float)fr;
        tab[idx] = (f32x2){__builtin_amdgcn_cosf(f), __builtin_amdgcn_sinf(f)};
    }
}
DI void load_row(const float* xr, int lane, f32x4 (&v)[4]) {
#pragma unroll
    for (int j = 0; j < 4; ++j) v[j] = ((const f32x4*)xr)[lane + 64 * j];
}
DI float row_ss(const f32x4 (&v)[4]) {
    float s = 0.f;
#pragma unroll
    for (int j = 0; j < 4; ++j) s += (v[j].x * v[j].x + v[j].y * v[j].y) + (v[j].z * v[j].z + v[j].w * v[j].w);
    return wave_sum(s);
}
DI void store_row_bf16(bf16* orow, int lane, const f32x4 (&v)[4], float rs, const float* g) {
#pragma unroll
    for (int j = 0; j < 4; ++j) { const f32x4 gg = ((const f32x4*)g)[lane + 64 * j];
        v2u o; o.x = pk2(v[j].x * rs * gg.x, v[j].y * rs * gg.y); o.y = pk2(v[j].z * rs * gg.z, v[j].w * rs * gg.w);
        ((v2u*)orow)[lane + 64 * j] = o; }
}
DI void ph_rmsnorm(const float* x, const float* g, bf16* out, int gw, int NGW, int lane) {
    f32x4 v[4], vn[4];
    if (gw < M) load_row(x + (size_t)gw * DM, lane, vn);
    for (int m = gw; m < M; m += NGW) {
#pragma unroll
        for (int j = 0; j < 4; ++j) v[j] = vn[j];
        if (m + NGW < M) load_row(x + (size_t)(m + NGW) * DM, lane, vn);
        const float rs = rsqrtf(row_ss(v) * (1.0f / DM) + RMS_EPS);
        store_row_bf16(out + (size_t)m * DM, lane, v, rs, g); }
}
DI int wr_slot(int k) { return (((k >> 8) << 2) + (k & 3)) * 64 + ((k >> 2) & 63); }
DI void ph_router(const Params& p, int l, int bid, int G, int wave, int lane, LAS unsigned char* wlds, LAS unsigned* rl) {
    const float* x1 = p.out; const float* g = p.in[16] + l * DM; const float* wr = p.in[17]; const float* rb = p.in[18];
    bf16* h = (bf16*)(p.ws + WS_U); int* list = (int*)(p.ws + WS_LIST); float* wl = (float*)(p.ws + WS_WLIST);
    unsigned* cnt = (unsigned*)(p.ws + WS_CTL) + CW_CNT + l * 1024;
    const int rpw = (M + G - 1) / G, r0 = bid * rpw, nr = (M - r0 < rpw ? M - r0 : rpw), tid = wave * 64 + lane;
    LAS unsigned* lcnt = rl; LAS unsigned* gbase = rl + 16; LAS int* ee = (LAS int*)(rl + 32); LAS float* ew = (LAS float*)(rl + 32 + 256); LAS unsigned* er = rl + 32 + 512;
    if (tid < 16) lcnt[tid] = 0u;
    for (int c = tid; c < 1024 * 4; c += 512) { const int k = c >> 2, q = c & 3; *(LAS f32x4*)(wlds + wr_slot(k) * 80 + q * 16) = ((const f32x4*)wr)[c]; }
    __syncthreads();
    f32x4 gg[4];
#pragma unroll
    for (int j = 0; j < 4; ++j) gg[j] = ((const f32x4*)g)[lane + 64 * j];
    f32x4 v[4], vn[4];
    if (wave < nr) load_row(x1 + (size_t)(r0 + wave) * DM, lane, vn);
    for (int i = wave; i < nr; i += 8) {
        const int m = r0 + i;
#pragma unroll
        for (int j = 0; j < 4; ++j) v[j] = vn[j];
        if (i + 8 < nr) load_row(x1 + (size_t)(m + 8) * DM, lane, vn);
        const float rs = rsqrtf(row_ss(v) * (1.0f / DM) + RMS_EPS);
        float lg[16];
#pragma unroll
        for (int e = 0; e < 16; ++e) lg[e] = 0.f;
#pragma unroll
        for (int j = 0; j < 4; ++j) {
            const float hv[4] = {v[j].x * rs * gg[j].x, v[j].y * rs * gg[j].y, v[j].z * rs * gg[j].z, v[j].w * rs * gg[j].w};
            v2u o; o.x = pk2(hv[0], hv[1]); o.y = pk2(hv[2], hv[3]); ((v2u*)(h + (size_t)m * DM))[lane + 64 * j] = o;
#pragma unroll
            for (int c = 0; c < 4; ++c) { const LAS unsigned char* wrow = wlds + ((j * 4 + c) * 64 + lane) * 80;
#pragma unroll
                for (int q = 0; q < 4; ++q) { const f32x4 w = *(const LAS f32x4*)(wrow + q * 16); lg[4 * q] += hv[c] * w.x; lg[4 * q + 1] += hv[c] * w.y; lg[4 * q + 2] += hv[c] * w.z; lg[4 * q + 3] += hv[c] * w.w; } } }
        float a8[8], a4[4], a2[2], a1;
        { const bool hi = (lane & 32) != 0;
#pragma unroll
          for (int q = 0; q < 8; ++q) { const float keep = hi ? lg[q + 8] : lg[q], send = hi ? lg[q] : lg[q + 8]; a8[q] = keep + __shfl_xor(send, 32); } }
        { const bool hi = (lane & 16) != 0;
#pragma unroll
          for (int q = 0; q < 4; ++q) { const float keep = hi ? a8[q + 4] : a8[q], send = hi ? a8[q] : a8[q + 4]; a4[q] = keep + __shfl_xor(send, 16); } }
        { const bool hi = (lane & 8) != 0;
#pragma unroll
          for (int q = 0; q < 2; ++q) { const float keep = hi ? a4[q + 2] : a4[q], send = hi ? a4[q] : a4[q + 2]; a2[q] = keep + __shfl_xor(send, 8); } }
        { const bool hi = (lane & 4) != 0; const float keep = hi ? a2[1] : a2[0], send = hi ? a2[0] : a2[1]; a1 = keep + __shfl_xor(send, 4); }
        a1 += __shfl_xor(a1, 2); a1 += __shfl_xor(a1, 1);
        float sc[16], bs[16];
#pragma unroll
        for (int e = 0; e < 16; ++e) { const int src = ((e >> 3) & 1) * 32 + ((e >> 2) & 1) * 16 + ((e >> 1) & 1) * 8 + (e & 1) * 4; const float t = __shfl(a1, src); sc[e] = 1.0f / (1.0f + expf(-t)); bs[e] = sc[e] + rb[e]; }
        int bg = 0; float bgs = -1e30f; int i1 = 0, i2 = 1;
#pragma unroll
        for (int gI = 0; gI < 4; ++gI) {
            int a = 0; float av = bs[4 * gI];
#pragma unroll
            for (int ii = 1; ii < 4; ++ii) if (bs[4 * gI + ii] > av) { av = bs[4 * gI + ii]; a = ii; }
            int b = -1; float bv = -1e30f;
#pragma unroll
            for (int ii = 0; ii < 4; ++ii) if (ii != a && bs[4 * gI + ii] > bv) { bv = bs[4 * gI + ii]; b = ii; }
            const float gs = av + bv;
            if (gs > bgs) { bgs = gs; bg = gI; i1 = a; i2 = b; }
        }
        const int e1 = bg * 4 + i1, e2 = bg * 4 + i2;
        float s1 = 0.f, s2 = 0.f;
#pragma unroll
        for (int e = 0; e < 16; ++e) { if (e == e1) s1 = sc[e]; if (e == e2) s2 = sc[e]; }
        const float inv = 1.0f / (s1 + s2);
        if (lane == 0) {
            ee[2 * i] = e1; ew[2 * i] = s1 * inv; er[2 * i] = __hip_atomic_fetch_add(lcnt + e1, 1u, __ATOMIC_RELAXED, __HIP_MEMORY_SCOPE_WORKGROUP);
            ee[2 * i + 1] = e2; ew[2 * i + 1] = s2 * inv; er[2 * i + 1] = __hip_atomic_fetch_add(lcnt + e2, 1u, __ATOMIC_RELAXED, __HIP_MEMORY_SCOPE_WORKGROUP);
        }
    }
    __syncthreads();
    if (tid < 16) gbase[tid] = atomicAdd(cnt + tid * 64, lcnt[tid]);
    __syncthreads();
    for (int t = tid; t < 2 * nr; t += 512) { const int e = ee[t]; const unsigned pos = gbase[e] + er[t]; list[e * M + pos] = (r0 + (t >> 1)) * 2 + (t & 1); wl[e * M + pos] = ew[t]; }
}
DI void ph_combine(const Params& p, int l, int gw, int NGW, int lane, bool st) {
    float* x1 = p.out; const bf16* Y = (const bf16*)(p.ws + WS_Y); bf16* u = (bf16*)(p.ws + WS_U);
    const bool last = (l == DEPTH - 1); const float* g = last ? p.in[22] : p.in[2] + (l + 1) * DM;
    f32x4 v[4], vn[4]; v2u ya[4], yb[4], yan[4], ybn[4];
#define CMB_LOAD(m_) do { load_row(x1 + (size_t)(m_) * DM, lane, vn); _Pragma("unroll") for (int j = 0; j < 4; ++j) { yan[j] = ((const v2u*)(Y + (size_t)(2 * (m_)) * DM))[lane + 64 * j]; ybn[j] = ((const v2u*)(Y + (size_t)(2 * (m_) + 1) * DM))[lane + 64 * j]; } } while (0)
    if (gw < M) CMB_LOAD(gw);
    for (int m = gw; m < M; m += NGW) {
#pragma unroll
        for (int j = 0; j < 4; ++j) { v[j] = vn[j]; ya[j] = yan[j]; yb[j] = ybn[j]; }
        if (m + NGW < M) CMB_LOAD(m + NGW);
#pragma unroll
        for (int j = 0; j < 4; ++j) { const v2u a = ya[j], b = yb[j];
            v[j].x += bflo(a.x) + bflo(b.x); v[j].y += bfhi(a.x) + bfhi(b.x); v[j].z += bflo(a.y) + bflo(b.y); v[j].w += bfhi(a.y) + bfhi(b.y); }
        const float rs = rsqrtf(row_ss(v) * (1.0f / DM) + RMS_EPS);
        if (!(st || rs == 1.2345e33f)) continue;
        if (last) {
#pragma unroll
            for (int j = 0; j < 4; ++j) { const f32x4 gg = ((const f32x4*)g)[lane + 64 * j]; ((f32x4*)(x1 + (size_t)m * DM))[lane + 64 * j] = v[j] * rs * gg; }
        } else {
#pragma unroll
            for (int j = 0; j < 4; ++j) ((f32x4*)(x1 + (size_t)m * DM))[lane + 64 * j] = v[j];
            store_row_bf16(u + (size_t)m * DM, lane, v, rs, g);
        }
    }
#undef CMB_LOAD
}
DI void amerge_tok(const bf16* og, const float* lse, bf16* oa, int t, int s, int d0, float (&lv)[3], v2u (&xv)[3], bool load) {
    if (load) {
#pragma unroll
        for (int g = 0; g < 3; ++g) { lv[g] = lse[((size_t)g * M + t) * 4 + s]; xv[g] = *(const v2u*)(og + (size_t)t * PA + (g * 4 + s) * 64 + d0); }
    } else {
        const float mx = fmaxf(lv[0], fmaxf(lv[1], lv[2])); const float a0 = exp2f(lv[0] - mx), a1 = exp2f(lv[1] - mx), a2 = exp2f(lv[2] - mx); const float inv = __builtin_amdgcn_rcpf(a0 + a1 + a2);
        const float w0 = a0 * inv, w1 = a1 * inv, w2 = a2 * inv;
        v2u o; o.x = pk2(w0 * bflo(xv[0].x) + w1 * bflo(xv[1].x) + w2 * bflo(xv[2].x), w0 * bfhi(xv[0].x) + w1 * bfhi(xv[1].x) + w2 * bfhi(xv[2].x));
        o.y = pk2(w0 * bflo(xv[0].y) + w1 * bflo(xv[1].y) + w2 * bflo(xv[2].y), w0 * bfhi(xv[0].y) + w1 * bfhi(xv[1].y) + w2 * bfhi(xv[2].y));
        *(v2u*)(oa + (size_t)t * POA + s * 64 + d0) = o;
    }
}
DI void ph_amerge(const Params& p, int gw, int NGW, int lane) {
    const bf16* og = (const bf16*)(p.ws + WS_QKVA); const float* lse = (const float*)(p.ws + WS_LSE); bf16* oa = (bf16*)(p.ws + WS_OA);
    const int s = lane >> 4, d0 = (lane & 15) * 4;
    for (int t = gw; t < M; t += 2 * NGW) {
        float la[3], lb[3]; v2u xa[3], xb[3]; const int t2 = t + NGW;
        amerge_tok(og, lse, oa, t, s, d0, la, xa, true);
        if (t2 < M) amerge_tok(og, lse, oa, t2, s, d0, lb, xb, true);
        amerge_tok(og, lse, oa, t, s, d0, la, xa, false);
        if (t2 < M) amerge_tok(og, lse, oa, t2, s, d0, lb, xb, false);
    }
}

DI void store8_bf16(bf16* dst, const float (&v)[8]) { v4u o; o.x = pk2(v[0], v[1]); o.y = pk2(v[2], v[3]); o.z = pk2(v[4], v[5]); o.w = pk2(v[6], v[7]); *(v4u*)dst = o; }
DI void rope4(float (&v)[8], const f32x2* tab, int pos, int i0) {
#pragma unroll
    for (int j = 0; j < 4; ++j) { const f32x2 cs = tab[pos * 16 + i0 + j]; const float t1 = v[2 * j], t2 = v[2 * j + 1]; v[2 * j] = t1 * cs.x - t2 * cs.y; v[2 * j + 1] = t1 * cs.y + t2 * cs.x; }
}
struct EpiProj {
    bf16* dst; int pitch, coff, mode; const f32x2* rope; bf16* kr;
    struct Ctx {}; DI void pre(int, int, Ctx&) const {}
    DI void s8(int row, int col, float (&v)[8], const Ctx&) const {
        const int c = col - coff;
        if (mode == 0) {
#pragma unroll
            for (int i = 0; i < 8; ++i) v[i] *= C2A; }
        else if (mode == 2) { if (c >= KR_COL && c < KR_COL + 32) { rope4(v, rope, row & (SEQ - 1), (c - KR_COL) >> 1); store8_bf16(kr + (size_t)row * 32 + (c - KR_COL), v); } }
        store8_bf16(dst + (size_t)row * pitch + c, v);
    }
};
struct ProjDst { bf16 *qkva, *qkvb, *clat, *g; const f32x2* rope; bf16* kr;
    DI EpiProj of(int col0) const {
        if (col0 < 2304) return EpiProj{qkva, PA, 0, col0 < 768 ? 0 : 1, rope, kr};
        if (col0 < 3840) return EpiProj{qkvb, PB, 2304, col0 < 2816 ? 0 : 1, rope, kr};
        if (col0 < 4352) return EpiProj{clat, PCL, 3840, col0 < 4096 ? 1 : 2, rope, kr};
        return EpiProj{g, PG, 4352, 3, rope, kr};
    }
};
struct EpiQc {
    bf16* qc; const float* ssq; const f32x2* rope;
    struct Ctx { f32x4 pp; }; DI void pre(int row, int col, Ctx& c) const { if (col < 576) c.pp = *(const f32x4*)(ssq + (size_t)row * 4); }
    DI void s8(int row, int col, float (&v)[8], const Ctx& c) const {
        if (col >= 576) return;
        const f32x4 pp = c.pp; const float rs = rsqrtf(((pp.x + pp.y) + (pp.z + pp.w)) * (1.0f / 256.0f) + RMS_EPS);
#pragma unroll
        for (int i = 0; i < 8; ++i) v[i] *= rs;
        const int j = col % 96; if (j >= 64) rope4(v, rope, row & (SEQ - 1), (j - 64) >> 1);
#pragma unroll
        for (int i = 0; i < 8; ++i) v[i] *= C2C;
        store8_bf16(qc + (size_t)row * PQC + col, v);
    }
};
struct EpiKv {
    bf16* kvc; const float* ssq;
    struct Ctx { f32x4 pp; }; DI void pre(int row, int, Ctx& c) const { c.pp = *(const f32x4*)(ssq + (size_t)row * 4); }
    DI void s8(int row, int col, float (&v)[8], const Ctx& c) const {
        const f32x4 pp = c.pp; const float rs = rsqrtf(((pp.x + pp.y) + (pp.z + pp.w)) * (1.0f / 128.0f) + RMS_EPS);
#pragma unroll
        for (int i = 0; i < 8; ++i) v[i] *= rs;
        store8_bf16(kvc + (size_t)row * PKV + col, v);
    }
};
struct EpiMerge {
    bf16* merged; const bf16* gate; bool first;
    struct Ctx { v4u g, o; };
    DI void pre(int row, int col, Ctx& c) const { c.g = *(const v4u*)(gate + (size_t)row * PG + col); if (!first) c.o = *(const v4u*)(merged + (size_t)row * DM + col); }
    DI void s8(int row, int col, float (&v)[8], const Ctx& c) const {
        const v4u gw = c.g;
        float r[8] = {v[0] * sigmoidf_(bflo(gw.x)), v[1] * sigmoidf_(bfhi(gw.x)), v[2] * sigmoidf_(bflo(gw.y)), v[3] * sigmoidf_(bfhi(gw.y)), v[4] * sigmoidf_(bflo(gw.z)), v[5] * sigmoidf_(bfhi(gw.z)), v[6] * sigmoidf_(bflo(gw.w)), v[7] * sigmoidf_(bfhi(gw.w))};
        if (!first) { const v4u o = c.o; r[0] += bflo(o.x); r[1] += bfhi(o.x); r[2] += bflo(o.y); r[3] += bfhi(o.y); r[4] += bflo(o.z); r[5] += bfhi(o.z); r[6] += bflo(o.w); r[7] += bfhi(o.w); }
        store8_bf16(merged + (size_t)row * DM + col, r);
    }
};
struct EpiResid {
    const float* xin; float* xout;
    struct Ctx { f32x4 b; }; DI void pre(int row, int col, Ctx& c) const { c.b = *(const f32x4*)(xin + (size_t)row * DM + col); }
    DI void s4(int row, int col, f32x4 v, const Ctx& c) const { *(f32x4*)(xout + (size_t)row * DM + col) = c.b + v; }
};
struct EpiGateUp {
    bf16* act; const float* wl; int slot0;
    struct Ctx { float w; }; DI void pre(int row, int, Ctx& c) const { c.w = wl[row]; }
    DI void s8(int row, int col, float (&v)[8], const Ctx& c) const {
        const float w = c.w;
        float a[4];
#pragma unroll
        for (int i = 0; i < 4; ++i) a[i] = v[i] * sigmoidf_(v[i]) * v[4 + i] * w;
        v2u o; o.x = pk2(a[0], a[1]); o.y = pk2(a[2], a[3]);
        *(v2u*)(act + (size_t)(slot0 + row) * DEXP + (col >> 1)) = o;
    }
};
struct EpiDown {
    bf16* y; const int* list; int cnt;
    struct Ctx { int tok; }; DI void pre(int row, int, Ctx& c) const { c.tok = row < cnt ? list[row] : -1; }
    DI void s8(int row, int col, float (&v)[8], const Ctx& c) const { if (c.tok < 0) return; store8_bf16(y + (size_t)c.tok * DM + col, v); }
};
#ifndef MOE_XCD
#define MOE_XCD 1
#endif
#ifndef GEMM_PROF
#define GEMM_PROF 0
#endif
__device__ unsigned long long g_gemm_prof_dummy;
namespace pg8 {
typedef unsigned u32x4 __attribute__((ext_vector_type(4)));
constexpr int BM = 256, BK = 64, HALF = 128, HTB = HALF * BK * 2, STAGE_BYTES = 8 * HTB, NXCD = 8, WGM = 8;
__host__ __device__ __forceinline__ int lds_byte(int r, int c) { const int st = (r >> 4) * 2 + (c >> 5), rr = r & 15, cc = c & 31, ob = rr * 64 + cc * 2; return st * 1024 + (ob ^ (((ob >> 9) & 1) << 5)); }
__host__ __device__ __forceinline__ void stage_rc(int b, int& R, int& C) { const int st = b / 1024, sb = b % 1024, swz = sb ^ (((sb >> 9) & 1) << 5); R = (st >> 1) * 16 + swz / 64; C = (st & 1) * 32 + (swz % 64) / 2; }
__host__ __device__ __forceinline__ int perm32(int rho) { const int n = rho >> 4, i = rho & 15; return 8 * (i >> 2) + 4 * n + (i & 3); }

struct GUnit { const char* a; const char* b; int row0, col0, e, cnt, sb; };

struct TileOrder {
    int nM, nN, nwg, G, c;
    DI void init(int nM_, int nN_, int G_, int c_) { nM = nM_; nN = nN_; nwg = nM * nN; G = G_; c = c_; }
    DI bool tile(int i, int& pm, int& pn) const {
        const long L = (long)i * G + c; if (L >= nwg) return false;
        int wgid = (int)L; { const int q = nwg / NXCD, r = nwg % NXCD, xcd = wgid % NXCD, off = wgid / NXCD; wgid = (xcd < r ? xcd * (q + 1) : r * (q + 1) + (xcd - r) * q) + off; }
        const int nig = WGM * nN, gid = wgid / nig, fm = gid * WGM, gsz = (nM - fm) < WGM ? (nM - fm) : WGM;
        pm = fm + ((wgid % nig) % gsz); pn = (wgid % nig) / gsz; return true;
    }
};
struct DenseSched {
    static constexpr bool GATHER = false;
    TileOrder T; const char* A; const char* Bt; int lda, K, pn0 = 0;
    DI bool next(int i, GUnit& u) const { int pm, pn; if (!T.tile(i, pm, pn)) return false; pn += pn0;
        u.a = A + (size_t)pm * BM * lda * 2; u.b = Bt + (size_t)pn * BM * K * 2; u.row0 = pm * BM; u.col0 = pn * BM; u.e = 0; u.cnt = BM; u.sb = 0; return true; }
    DI unsigned gather_off(const GUnit&, int, int) const { return 0u; }
};
template <bool GATH>
struct MoeSched {
    static constexpr bool GATHER = GATH;
    const unsigned* cnt; const int* list; const char* A; const char* Bt; int lda, K, nN, G, c; size_t bstride;
    DI int ntile(int e) const { return ((int)__builtin_amdgcn_readfirstlane((int)cnt[e * 64]) + 255) >> 8; }
    DI bool next(int i, GUnit& u) const {
        int e, tl, pn;
        if (MOE_XCD && (G & 7) == 0) {
            const int x = c & 7, n = i * (G >> 3) + (c >> 3), nt0 = ntile(2 * x), nt1 = ntile(2 * x + 1);
            if (n >= (nt0 + nt1) * nN) return false;
            const int tloc = n / nN; pn = n % nN; e = tloc < nt0 ? 2 * x : 2 * x + 1; tl = tloc < nt0 ? tloc : tloc - nt0;
        } else {
            const int L = i * G + c; int t = L / nN; pn = L % nN; e = -1; tl = 0;
            for (int q = 0; q < NEXP; ++q) { const int nt = ntile(q); if (t < nt) { e = q; tl = t; break; } t -= nt; }
            if (e < 0) return false;
        }
        int sb = 0; for (int q = 0; q < e; ++q) sb += ntile(q) * 256;
        const int ce = (int)__builtin_amdgcn_readfirstlane((int)cnt[e * 64]);
        u.e = e; u.sb = sb; u.cnt = ce - tl * 256; u.row0 = tl * 256; u.col0 = pn * BM; u.b = Bt + (size_t)e * bstride + (size_t)pn * BM * K * 2;
        u.a = GATH ? A : A + (size_t)(sb + tl * 256) * lda * 2; return true;
    }
    DI unsigned gather_off(const GUnit& u, int r, int C) const {
        const int lr = u.row0 + r; int tok = 0; if (r < u.cnt) tok = list[u.e * M + lr] >> 1;
        return (unsigned)(tok * lda + C) * 2u;
    }
};

DI unsigned cvt_pk_bf16(float lo, float hi) { unsigned r; asm volatile("v_cvt_pk_bf16_f32 %0, %1, %2" : "=v"(r) : "v"(lo), "v"(hi)); return r; }

template <class Mk>
struct Epi8 {
    static constexpr bool PERM = true;
    Mk mk;
    DI void operator()(const f32x4 (&acc)[2][2][4][2], const GUnit& u, int wr, int wc, int fr, int fq) const {
        asm volatile("" : "+v"(fr), "+v"(fq));
        const auto F = mk.make(u);
        typedef decltype(F) FT; typename FT::Ctx cx[2][2];
        const int rowb = u.row0 + wr * 64 + fr, colb = u.col0 + wc * 32 + 8 * fq;
#pragma unroll
        for (int bj = 0; bj < 2; ++bj) F.pre(rowb, colb + bj * HALF, cx[0][bj]);
#pragma unroll
        for (int g = 0; g < 8; ++g) { const int ai = g >> 2, m = g & 3, row = rowb + ai * HALF + m * 16;
            if (g + 1 < 8) { const int rown = rowb + ((g + 1) >> 2) * HALF + ((g + 1) & 3) * 16;
#pragma unroll
                for (int bj = 0; bj < 2; ++bj) F.pre(rown, colb + bj * HALF, cx[(g + 1) & 1][bj]); }
#pragma unroll
            for (int bj = 0; bj < 2; ++bj) { const f32x4 a = acc[ai][bj][m][0], b = acc[ai][bj][m][1]; float v[8] = {a[0], a[1], a[2], a[3], b[0], b[1], b[2], b[3]};
                F.s8(row, colb + bj * HALF, v, cx[g & 1][bj]); }
            asm volatile("" ::: "memory"); }
        mk.extra(acc, u, wr, wc, fr, fq);
    }
};
template <class Mk>
struct Epi4 {
    static constexpr bool PERM = false;
    Mk mk;
    DI void operator()(const f32x4 (&acc)[2][2][4][2], const GUnit& u, int wr, int wc, int fr, int fq) const {
        asm volatile("" : "+v"(fr), "+v"(fq));
        const auto F = mk.make(u);
        typedef decltype(F) FT; typename FT::Ctx cx[2][2][2];
        const int rowb = u.row0 + wr * 64 + fr, colb = u.col0 + wc * 32 + 4 * fq;
#pragma unroll
        for (int bj = 0; bj < 2; ++bj)
#pragma unroll
            for (int n = 0; n < 2; ++n) F.pre(rowb, colb + bj * HALF + 16 * n, cx[0][bj][n]);
#pragma unroll
        for (int g = 0; g < 8; ++g) { const int ai = g >> 2, m = g & 3, row = rowb + ai * HALF + m * 16;
            if (g + 1 < 8) { const int rown = rowb + ((g + 1) >> 2) * HALF + ((g + 1) & 3) * 16;
#pragma unroll
                for (int bj = 0; bj < 2; ++bj)
#pragma unroll
                    for (int n = 0; n < 2; ++n) F.pre(rown, colb + bj * HALF + 16 * n, cx[(g + 1) & 1][bj][n]); }
#pragma unroll
            for (int bj = 0; bj < 2; ++bj)
#pragma unroll
                for (int n = 0; n < 2; ++n) F.s4(row, colb + bj * HALF + 16 * n, acc[ai][bj][m][n], cx[g & 1][bj][n]);
            asm volatile("" ::: "memory"); }
    }
};

template <class Epi, class Sched>
__device__ __forceinline__ void gemm_phase(LAS unsigned char* lds, const Sched& S, const Epi& E, volatile LAS unsigned* prof = nullptr, int prof_id = 0) {
    unsigned long long pt0 = 0, pacc = 0; int pcur = 0;
#define GP_MARK(n) do { if (GEMM_PROF && prof) { const unsigned long long t_ = __builtin_readcyclecounter(); if (pcur == (GEMM_PROF & 15) && prof_id == (GEMM_PROF >> 4)) pacc += t_ - pt0; pcur = (n); pt0 = t_; } } while (0)
    GP_MARK(3);
    constexpr bool GATHER = Sched::GATHER;
    int tid_ = threadIdx.x; asm volatile("" : "+v"(tid_));
    const int tid = tid_, wid = __builtin_amdgcn_readfirstlane(tid >> 6), lane = tid & 63, wr = wid >> 2, wc = wid & 3, fr = lane & 15, fq = lane >> 4;
    const int K = S.K, lda = S.lda, nt = K / BK;
    int sR[2], sC[2];
    unsigned voffA[2][2], voffB[2], nvoffA[2][2];
#pragma unroll
    for (int i = 0; i < 2; ++i) { stage_rc(tid * 16 + i * 8192, sR[i], sC[i]); const int Rb = Epi::PERM ? ((sR[i] & ~31) + perm32(sR[i] & 31)) : sR[i];
        voffA[0][i] = (unsigned)(sR[i] * lda + sC[i]) * 2u; voffA[1][i] = voffA[0][i]; nvoffA[0][i] = voffA[0][i]; nvoffA[1][i] = voffA[0][i]; voffB[i] = (unsigned)(Rb * K + sC[i]) * 2u; }
    const size_t kstep = (size_t)(BK * 2);
    const size_t hstepA = GATHER ? 0 : (size_t)HALF * lda * 2, hstepB = (size_t)HALF * K * 2;
    const unsigned ldsw = (unsigned)wid * 1024u;
    const int aoff = lds_byte(wr * 64 + fr, fq * 8), boff = lds_byte(wc * 32 + fr, fq * 8);
#define PG8_SA(b, h) (((b) * 2 + (h)) * HTB)
#define PG8_SB(b, h) ((4 + (b) * 2 + (h)) * HTB)
#define PG8_STAGE(bufoff, gbase, voff) do { _Pragma("unroll") for (int _i = 0; _i < 2; ++_i) \
        __builtin_amdgcn_global_load_lds((const unsigned*)((const char*)(gbase) + (voff)[_i]), (LAS unsigned*)(lds + (bufoff) + ldsw + _i * 8192), 16, 0, 0); } while (0)
#define PG8_LDA(dst, b, h) do { _Pragma("unroll") for (int m = 0; m < 4; ++m) _Pragma("unroll") for (int k = 0; k < 2; ++k) dst[m][k] = *(const LAS bf16x8*)(lds + PG8_SA(b, h) + aoff + m * 2048 + k * 1024); } while (0)
#define PG8_LDB(dst, b, h) do { _Pragma("unroll") for (int n = 0; n < 2; ++n) _Pragma("unroll") for (int k = 0; k < 2; ++k) dst[n][k] = *(const LAS bf16x8*)(lds + PG8_SB(b, h) + boff + n * 2048 + k * 1024); } while (0)
#define PG8_MMA(ai, bj, At, Bt) do { __builtin_amdgcn_s_setprio(1); _Pragma("unroll") for (int m = 0; m < 4; ++m) _Pragma("unroll") for (int n = 0; n < 2; ++n) _Pragma("unroll") for (int k = 0; k < 2; ++k) \
        acc[ai][bj][m][n] = __builtin_amdgcn_mfma_f32_16x16x32_bf16(Bt[n][k], At[m][k], acc[ai][bj][m][n], 0, 0, 0); __builtin_amdgcn_s_setprio(0); } while (0)
#define PG8_WAIT_V(n) asm volatile("s_waitcnt vmcnt(" #n ")" ::: "memory")
#define PG8_WAIT_L(n) asm volatile("s_waitcnt lgkmcnt(" #n ")" ::: "memory")
#define PG8_BAR __builtin_amdgcn_s_barrier()
#define PG8_SCHED __builtin_amdgcn_sched_barrier(0)
    GUnit cur, nxt; int ui = 0;
    if (!S.next(0, cur)) return;
    if constexpr (GATHER) {
#pragma unroll
        for (int h = 0; h < 2; ++h)
#pragma unroll
            for (int i = 0; i < 2; ++i) voffA[h][i] = S.gather_off(cur, h * HALF + sR[i], sC[i]);
    }
    f32x4 acc[2][2][4][2];
#pragma unroll
    for (int a = 0; a < 2; ++a)
#pragma unroll
        for (int b = 0; b < 2; ++b)
#pragma unroll
            for (int m = 0; m < 4; ++m)
#pragma unroll
                for (int n = 0; n < 2; ++n) acc[a][b][m][n] = (f32x4){0.f, 0.f, 0.f, 0.f};
    bf16x8 At[4][2], B0[2][2], B1[2][2];
    const char* cA = cur.a; const char* cB = cur.b;
    PG8_STAGE(PG8_SB(0, 0), cB, voffB); PG8_STAGE(PG8_SB(0, 1), cB + hstepB, voffB); PG8_STAGE(PG8_SA(0, 0), cA, voffA[0]); PG8_STAGE(PG8_SA(0, 1), cA + hstepA, voffA[1]);
    if (wr == 1) PG8_BAR;
    PG8_WAIT_V(2); PG8_BAR;
    PG8_STAGE(PG8_SB(1, 0), cB + kstep, voffB); PG8_STAGE(PG8_SA(1, 0), cA + kstep, voffA[0]); PG8_STAGE(PG8_SB(1, 1), cB + hstepB + kstep, voffB);
    PG8_WAIT_V(6); PG8_BAR;
    for (;;) {
        GP_MARK(1);
        const bool has_next = S.next(ui + 1, nxt);
        const char* nA = has_next ? nxt.a : cA; const char* nB = has_next ? nxt.b : cB;
        if constexpr (GATHER) {
#pragma unroll
            for (int h = 0; h < 2; ++h)
#pragma unroll
                for (int i = 0; i < 2; ++i) nvoffA[h][i] = has_next ? S.gather_off(nxt, h * HALF + sR[i], sC[i]) : voffA[h][i];
        }
        for (int t = 0; t < nt; t += 2) {
            const bool last = (t == nt - 2);
            const char* a1 = cA + (size_t)(t + 1) * kstep;
            const char* a2 = last ? nA : cA + (size_t)(t + 2) * kstep; const char* b2 = last ? nB : cB + (size_t)(t + 2) * kstep;
            const char* a3 = a2 + kstep; const char* b3 = b2 + kstep;
            unsigned v2[2][2];
#pragma unroll
            for (int h = 0; h < 2; ++h)
#pragma unroll
                for (int i = 0; i < 2; ++i) v2[h][i] = (GATHER && last) ? nvoffA[h][i] : voffA[h][i];
            PG8_LDB(B0, 0, 0); PG8_LDB(B1, 0, 1); PG8_SCHED; PG8_LDA(At, 0, 0); PG8_STAGE(PG8_SA(1, 1), a1 + hstepA, voffA[1]);
            PG8_WAIT_V(8); PG8_WAIT_L(0); PG8_BAR; PG8_MMA(0, 0, At, B0); PG8_MMA(0, 1, At, B1); PG8_BAR; PG8_SCHED;
            PG8_LDA(At, 0, 1); PG8_STAGE(PG8_SB(0, 0), b2, voffB); PG8_STAGE(PG8_SB(0, 1), b2 + hstepB, voffB); PG8_STAGE(PG8_SA(0, 0), a2, v2[0]);
            PG8_WAIT_V(8); PG8_WAIT_L(0); PG8_BAR; PG8_MMA(1, 0, At, B0); PG8_MMA(1, 1, At, B1); PG8_BAR; PG8_SCHED;
            PG8_LDB(B0, 1, 0); PG8_LDB(B1, 1, 1); PG8_SCHED; PG8_LDA(At, 1, 0); PG8_STAGE(PG8_SA(0, 1), a2 + hstepA, v2[1]);
            PG8_WAIT_V(8); PG8_WAIT_L(0); PG8_BAR; PG8_MMA(0, 0, At, B0); PG8_MMA(0, 1, At, B1); PG8_BAR; PG8_SCHED;
            PG8_LDA(At, 1, 1); PG8_STAGE(PG8_SB(1, 0), b3, voffB); PG8_STAGE(PG8_SB(1, 1), b3 + hstepB, voffB); PG8_STAGE(PG8_SA(1, 0), a3, v2[0]);
            PG8_WAIT_V(8); PG8_WAIT_L(0); PG8_BAR; PG8_MMA(1, 0, At, B0); PG8_MMA(1, 1, At, B1); PG8_BAR; PG8_SCHED;
        }
        if (wr == 0) PG8_BAR;
        GP_MARK(2);
        E(acc, cur, wr, wc, fr, fq);
        GP_MARK(3);
        if (!has_next) break;
#pragma unroll
        for (int a = 0; a < 2; ++a)
#pragma unroll
            for (int b = 0; b < 2; ++b)
#pragma unroll
                for (int m = 0; m < 4; ++m)
#pragma unroll
                    for (int n = 0; n < 2; ++n) acc[a][b][m][n] = (f32x4){0.f, 0.f, 0.f, 0.f};
        cur = nxt; cA = nA; cB = nB; ++ui;
        if constexpr (GATHER) {
#pragma unroll
            for (int h = 0; h < 2; ++h)
#pragma unroll
                for (int i = 0; i < 2; ++i) voffA[h][i] = nvoffA[h][i];
        }
        if (wr == 1) PG8_BAR;
    }
    PG8_WAIT_V(0);
    PG8_BAR;
    GP_MARK(0);
    if (GEMM_PROF && prof && blockIdx.x == 0 && threadIdx.x == 0) { const unsigned old = prof[0]; prof[0] = old + (unsigned)pacc; prof[1] += (unsigned)(pacc >> 32) + ((old + (unsigned)pacc < old) ? 1u : 0u); }
#undef GP_MARK
#undef PG8_SA
#undef PG8_SB
#undef PG8_STAGE
#undef PG8_LDA
#undef PG8_LDB
#undef PG8_MMA
#undef PG8_WAIT_V
#undef PG8_WAIT_L
#undef PG8_BAR
#undef PG8_SCHED
}
}
#ifndef ATT_PROF
#define ATT_PROF 0
#endif
struct ProfSt { unsigned long long t0, acc; int cur; };
#define PROF_MARK(P, n) do { if (ATT_PROF) { const unsigned long long t_ = __builtin_readcyclecounter(); if ((P).cur == ATT_PROF) (P).acc += t_ - (P).t0; (P).cur = (n); (P).t0 = t_; } } while (0)
#ifndef ATT_MASK
#define ATT_MASK 7
#endif
namespace att {
typedef __bf16 bf16x2_t __attribute__((ext_vector_type(2)));
typedef short v4i16_t __attribute__((ext_vector_type(4)));
DI float xhalf_max(float v) { const auto rr = __builtin_amdgcn_permlane32_swap(__float_as_uint(v), __float_as_uint(v), false, false); return fmaxf(__uint_as_float(rr[0]), __uint_as_float(rr[1])); }
DI float xhalf_sum(float v) { const auto rr = __builtin_amdgcn_permlane32_swap(__float_as_uint(v), __float_as_uint(v), false, false); return __uint_as_float(rr[0]) + __uint_as_float(rr[1]); }
DI unsigned cvtpk(float lo, float hi) { f32x2 v = {lo, hi}; bf16x2_t b = __builtin_convertvector(v, bf16x2_t); return __builtin_bit_cast(unsigned, b); }
constexpr int BIGBAND = 1 << 28;

struct HJob {
    const bf16* q; int qpitch;
    const bf16* k; int kpitch;
    const bf16* k2; int k2pitch;
    const bf16* v; int vpitch;
    int qs0, ks0, kmax, ntiles, band; float slope2;
};

template <int DK, int DV, bool IL, bool SHV>
struct Core {
    static constexpr int KSTR = DK * 2 + 16, VSTR = (DV == 128) ? 320 : 192;
    static constexpr int KBYTES = 64 * KSTR, VBYTES = 64 * VSTR, HBYTES = KBYTES + VBYTES;
    static constexpr int NDS = DK / 16, NC = DV / 32, KCH = DK / 32, VCH = SHV ? DV / 64 : DV / 32, KCPR = DK / 8, VCPR = DV / 8;
    static constexpr int STG = SHV ? 2 * KBYTES + VBYTES : HBYTES, KOFF2 = SHV ? KBYTES : 0, VBASE = SHV ? 2 * KBYTES : KBYTES;

    static constexpr float THR = 8.0f;
    static DI void run(LAS unsigned char* lds, const HJob& J, int nt_max, f32x16 (&o)[NC], float& m_out, float& l_out, ProfSt& PS) {
        PROF_MARK(PS, 6);
        int tid_ = threadIdx.x; asm volatile("" : "+v"(tid_));
        const int tid = tid_, lane = tid & 63, r = lane & 31, h = lane >> 5;
        const int wave = __builtin_amdgcn_readfirstlane(tid >> 6), half = wave >> 2, wq = wave & 3, ht = tid & 255;
        LAS unsigned char* hb = SHV ? lds : lds + half * 2 * HBYTES;
        const int qloc = IL ? 32 * (r >> 3) + 8 * wq + (r & 7) : 32 * wq + r;
        unsigned kgo[KCH], vgo[VCH]; int klo[KCH], vlo[VCH];
#pragma unroll
        for (int i = 0; i < KCH; ++i) {
            if (i < 2) { const int id = ht + 256 * i, row = id >> 3, cc = id & 7; kgo[i] = (unsigned)(row * J.kpitch + cc * 8) * 2u; klo[i] = half * KOFF2 + row * KSTR + cc * 16; }
            else { const int row = ht >> 2, cc = ht & 3; kgo[i] = (unsigned)(row * J.k2pitch + cc * 8) * 2u; klo[i] = half * KOFF2 + row * KSTR + 128 + cc * 16; } }
#pragma unroll
        for (int i = 0; i < VCH; ++i) { const int id = (SHV ? tid + 512 * i : ht + 256 * i), row = id / VCPR, cc = id % VCPR; vgo[i] = (unsigned)(row * J.vpitch + cc * 8) * 2u; vlo[i] = VBASE + row * VSTR + cc * 16; }
        const char* kb0 = (const char*)J.k + (size_t)J.ks0 * J.kpitch * 2; const char* k2b0 = (DK == 96) ? (const char*)J.k2 + (size_t)J.ks0 * J.k2pitch * 2 : nullptr;
        const char* vb0 = (const char*)J.v + (size_t)J.ks0 * J.vpitch * 2;
        const size_t ktile = (size_t)64 * J.kpitch * 2, k2tile = (size_t)64 * J.k2pitch * 2, vtile = (size_t)64 * J.vpitch * 2;
        v4u kreg[KCH], vreg[VCH];
#define ATT_ISSUE(ti) do { \
        _Pragma("unroll") for (int i = 0; i < KCH; ++i) kreg[i] = *(const v4u*)((i < 2 ? kb0 + (size_t)(ti) * ktile : k2b0 + (size_t)(ti) * k2tile) + kgo[i]); \
        _Pragma("unroll") for (int i = 0; i < VCH; ++i) vreg[i] = *(const v4u*)(vb0 + (size_t)(ti) * vtile + vgo[i]); } while (0)
#define ATT_COMMIT(st) do { LAS unsigned char* sb_ = hb + (st) * STG; \
        _Pragma("unroll") for (int i = 0; i < KCH; ++i) *(LAS v4u*)(sb_ + klo[i]) = kreg[i]; \
        _Pragma("unroll") for (int i = 0; i < VCH; ++i) *(LAS v4u*)(sb_ + vlo[i]) = vreg[i]; } while (0)
        const int qidx = J.qs0 + qloc, wq0 = J.qs0 + (IL ? 8 * wq : 32 * wq), wq1 = wq0 + (IL ? 103 : 31), nt = J.ntiles;
        float m = 0.f, l = 0.f; bool started = false;
#pragma unroll
        for (int c = 0; c < NC; ++c)
#pragma unroll
            for (int i = 0; i < 16; ++i) o[c][i] = 0.f;
        if (nt > 0) ATT_ISSUE(nt - 1);
        bf16x8 qf[NDS];
        { const bf16* qp = J.q + (size_t)qloc * J.qpitch + 8 * h;
#pragma unroll
          for (int ds = 0; ds < NDS; ++ds) qf[ds] = *(const bf16x8*)(qp + 16 * ds);
#pragma unroll
          for (int ds = 0; ds < NDS; ++ds) asm volatile("" : "+v"(qf[ds])); }
        if (nt > 0) ATT_COMMIT(0);
        if (nt > 1) ATT_ISSUE(nt - 2);
        const int koff = half * KOFF2 + r * KSTR + 16 * h;
        const int voff = VBASE + (4 * h + ((lane & 15) >> 2)) * VSTR + ((lane >> 4) & 1) * 32 + (lane & 3) * 8;
        for (int kt = 0; kt < nt_max; ++kt) {
            PROF_MARK(PS, 1);
            asm volatile("s_waitcnt lgkmcnt(0)\n\ts_barrier" ::: "memory");
            PROF_MARK(PS, 2);
            if (kt + 1 < nt) ATT_COMMIT((kt + 1) & 1);
            if (kt + 2 < nt) ATT_ISSUE(nt - 3 - kt);
            const int ti = nt - 1 - kt, tk0 = J.ks0 + 64 * ti;
            if (kt < nt && tk0 <= wq1 && tk0 + 63 >= wq0 - J.band) {
                PROF_MARK(PS, 3);
                const LAS unsigned char* sb = hb + (kt & 1) * STG;
                f32x16 p[2];
#pragma unroll
                for (int kb = 0; kb < 2; ++kb) { const float base = J.slope2 * (float)(tk0 + 32 * kb + 4 * h - qidx) - m;
#pragma unroll
                    for (int i = 0; i < 16; ++i) p[kb][i] = __builtin_fmaf(J.slope2, (float)((i & 3) + 8 * (i >> 2)), base); }
                { bf16x8 kf[3][2];
#pragma unroll
                  for (int q = 0; q < 2; ++q) { kf[q][0] = *(const LAS bf16x8*)(sb + koff + q * 32); kf[q][1] = *(const LAS bf16x8*)(sb + koff + 32 * KSTR + q * 32); }
#pragma unroll
                  for (int ds = 0; ds < NDS; ++ds) {
                      if (ds + 2 < NDS) { kf[(ds + 2) % 3][0] = *(const LAS bf16x8*)(sb + koff + (ds + 2) * 32); kf[(ds + 2) % 3][1] = *(const LAS bf16x8*)(sb + koff + 32 * KSTR + (ds + 2) * 32); }
                      p[0] = __builtin_amdgcn_mfma_f32_32x32x16_bf16(kf[ds % 3][0], qf[ds], p[0], 0, 0, 0); p[1] = __builtin_amdgcn_mfma_f32_32x32x16_bf16(kf[ds % 3][1], qf[ds], p[1], 0, 0, 0);
                      __builtin_amdgcn_sched_barrier(0); } }
                v4i16_t va[NC][2], vb[NC][2];
#pragma unroll
                for (int c = 0; c < NC; ++c) { va[c][0] = __builtin_amdgcn_ds_read_tr16_b64_v4i16((LAS v4i16_t*)(sb + voff + c * 64)); va[c][1] = __builtin_amdgcn_ds_read_tr16_b64_v4i16((LAS v4i16_t*)(sb + voff + 8 * VSTR + c * 64)); }
                __builtin_amdgcn_sched_barrier(0);
                if (tk0 + 63 > wq0 || tk0 < wq1 - J.band) {
#pragma unroll
                    for (int kb = 0; kb < 2; ++kb)
#pragma unroll
                        for (int i = 0; i < 16; ++i) { const int kidx = tk0 + 32 * kb + (i & 3) + 8 * (i >> 2) + 4 * h; const bool ok = (kidx <= qidx) && (qidx - kidx <= J.band); if (!ok) p[kb][i] = -INFINITY; }
                }
                PROF_MARK(PS, 4);
                float g = fmaxf(p[0][0], p[1][0]);
#pragma unroll
                for (int i = 1; i < 16; ++i) g = fmaxf(g, fmaxf(p[0][i], p[1][i]));
                g = xhalf_max(g);
                const bool fin = g > -INFINITY;
                const bool up = started ? (g > THR) : fin;
                if (__any(up)) {
                    const float delta = up ? g : 0.f, alpha = started ? __builtin_amdgcn_exp2f(-delta) : 1.0f;
                    m += delta; l *= alpha;
#pragma unroll
                    for (int kb = 0; kb < 2; ++kb)
#pragma unroll
                        for (int i = 0; i < 16; ++i) p[kb][i] -= delta;
#pragma unroll
                    for (int c = 0; c < NC; ++c)
#pragma unroll
                        for (int i = 0; i < 16; ++i) o[c][i] *= alpha;
                }
                started = started || fin;
                float rs = 0.f;
#pragma unroll
                for (int ks = 0; ks < 4; ++ks) { const int kb = ks >> 1, b0 = 8 * (ks & 1); v4u w;
#pragma unroll
                    for (int i = 0; i < 8; ++i) { p[kb][b0 + i] = __builtin_amdgcn_exp2f(p[kb][b0 + i]); rs += p[kb][b0 + i]; }
                    w.x = cvtpk(p[kb][b0], p[kb][b0 + 1]); w.y = cvtpk(p[kb][b0 + 2], p[kb][b0 + 3]); w.z = cvtpk(p[kb][b0 + 4], p[kb][b0 + 5]); w.w = cvtpk(p[kb][b0 + 6], p[kb][b0 + 7]);
                    const bf16x8 pa = __builtin_bit_cast(bf16x8, w);
                    if (ks + 1 < 4) {
#pragma unroll
                        for (int c = 0; c < NC; ++c) { vb[c][0] = __builtin_amdgcn_ds_read_tr16_b64_v4i16((LAS v4i16_t*)(sb + voff + (16 * (ks + 1)) * VSTR + c * 64)); vb[c][1] = __builtin_amdgcn_ds_read_tr16_b64_v4i16((LAS v4i16_t*)(sb + voff + (16 * (ks + 1) + 8) * VSTR + c * 64)); } }
#pragma unroll
                    for (int c = 0; c < NC; ++c) { const bf16x8 vf = {va[c][0][0], va[c][0][1], va[c][0][2], va[c][0][3], va[c][1][0], va[c][1][1], va[c][1][2], va[c][1][3]};
                        o[c] = __builtin_amdgcn_mfma_f32_32x32x16_bf16(vf, pa, o[c], 0, 0, 0); }
#pragma unroll
                    for (int c = 0; c < NC; ++c) { va[c][0] = vb[c][0]; va[c][1] = vb[c][1]; }
                    __builtin_amdgcn_sched_barrier(0); }
                l += rs;
            }
        }
        PROF_MARK(PS, 5);
#undef ATT_ISSUE
#undef ATT_COMMIT
        m_out = m; l_out = xhalf_sum(l);
    }
    static DI void store_o(const f32x16 (&o)[NC], float inv, bf16* orow, int h) {
#pragma unroll
        for (int c = 0; c < NC; ++c)
#pragma unroll
            for (int g = 0; g < 4; ++g) { v2u w; w.x = cvtpk(o[c][4 * g] * inv, o[c][4 * g + 1] * inv); w.y = cvtpk(o[c][4 * g + 2] * inv, o[c][4 * g + 3] * inv);
                *(v2u*)(orow + 32 * c + 8 * g + 4 * h) = w; }
    }
};

constexpr int NJ_BC = 16 * 56, NJ_A0 = 256, NJ_A1 = 256, NJ_A2 = 256, NJOBS = NJ_BC + NJ_A0 + NJ_A1 + NJ_A2;

DI void phase(const Params& p, int l, LAS unsigned char* lds, volatile LAS unsigned* jobw, unsigned* ctr, bool st, int tmask, int j0, int j1) {
    unsigned char* ws = p.ws;
    const int tid0 = threadIdx.x; ProfSt PS; PS.t0 = 0; PS.acc = 0; PS.cur = 0; PROF_MARK(PS, 5);
    if (tid0 == 0) jobw[0] = atomicAdd(ctr, 1u);
    for (int it = 0;; ++it) {
        int tid = tid0; asm volatile("" : "+v"(tid));
        const int lane = tid & 63, r = lane & 31, h = lane >> 5, wave = __builtin_amdgcn_readfirstlane(tid >> 6), half = wave >> 2, wq = wave & 3;
        __syncthreads();
        const int idx = j0 + __builtin_amdgcn_readfirstlane((int)jobw[it & 1]);
        if (idx >= j1) break;
        unsigned nextj = 0u; if (tid0 == 0) nextj = atomicAdd(ctr, 1u);
        if (idx < NJ_BC) {
            const int qb = 15 - idx / 56, rr = idx % 56;
            if (rr < 32) { if (!(tmask & 2)) { if (tid0 == 0) jobw[(it + 1) & 1] = nextj; continue; }
                const int b = rr >> 2, hd = rr & 3, mp = half; const size_t t0 = (size_t)b * SEQ;
                bf16* base = (bf16*)(ws + WS_QKVB);
                HJob J; J.q = base + (t0 + 128 * qb) * PB + (2 * hd + mp) * 64; J.qpitch = PB; J.k = base + t0 * PB + 512 + (2 * hd + mp) * 64; J.kpitch = PB; J.k2 = nullptr; J.k2pitch = 0;
                J.v = base + t0 * PB + 1024 + hd * 128; J.vpitch = PB; J.qs0 = 128 * qb; J.ks0 = 0; J.kmax = SEQ - 1; J.ntiles = 2 * (qb + 1); J.band = BIGBAND; J.slope2 = alibi_b(hd) * LOG2E;
                f32x16 o[4]; float m, ls; Core<64, 128, true, true>::run(lds, J, J.ntiles, o, m, ls, PS);
                const float inv = 1.0f / ls;
                LAS float* ex = (LAS float*)lds;
                __syncthreads();
                if (half == 1) {
#pragma unroll
                    for (int c = 0; c < 4; ++c)
#pragma unroll
                        for (int i = 0; i < 16; ++i) ex[((wq * 4 + c) * 16 + i) * 64 + lane] = o[c][i] * inv;
                }
                __syncthreads();
                if (half == 0) {
                    const float lam = lam_of(p, l, lane); float ssq = 0.f;
#pragma unroll
                    for (int c = 0; c < 4; ++c)
#pragma unroll
                        for (int i = 0; i < 16; ++i) { const float d = o[c][i] * inv - lam * ex[((wq * 4 + c) * 16 + i) * 64 + lane]; o[c][i] = d; ssq += d * d; }
                    ssq = xhalf_sum(ssq);
                    const float rs = rsqrtf(ssq * (1.0f / 128.0f) + RMS_EPS) * (1.0f - lam_init_of(l));
                    const float* gs = p.in[15] + l * 128;
#pragma unroll
                    for (int c = 0; c < 4; ++c)
#pragma unroll
                        for (int g = 0; g < 4; ++g) { const f32x4 gg = *(const f32x4*)(gs + 32 * c + 8 * g + 4 * h);
                            o[c][4 * g] *= gg.x; o[c][4 * g + 1] *= gg.y; o[c][4 * g + 2] *= gg.z; o[c][4 * g + 3] *= gg.w; }
                    if (st || rs == 1.2345e33f) Core<64, 128, true, true>::store_o(o, rs, base + (t0 + 128 * qb + 32 * (r >> 3) + 8 * wq + (r & 7)) * PB + hd * 128, h);
                }
            } else { if (!(tmask & 4)) { if (tid0 == 0) jobw[(it + 1) & 1] = nextj; continue; }
                const int r2 = rr - 32, b = r2 / 3, hh = 2 * (r2 % 3) + half; const size_t t0 = (size_t)b * SEQ;
                const bf16* kv = (const bf16*)(ws + WS_KVC) + t0 * PKV + hh * 128;
                HJob J; J.q = (const bf16*)(ws + WS_QC) + (t0 + 128 * qb) * PQC + hh * 96; J.qpitch = PQC; J.k = kv; J.kpitch = PKV; J.k2 = (const bf16*)(ws + WS_KR) + t0 * 32; J.k2pitch = 32;
                J.v = kv + 64; J.vpitch = PKV; J.qs0 = 128 * qb; J.ks0 = 0; J.kmax = SEQ - 1; J.ntiles = 2 * (qb + 1); J.band = BIGBAND; J.slope2 = 0.f;
                f32x16 o[2]; float m, ls; Core<96, 64, true, false>::run(lds, J, J.ntiles, o, m, ls, PS);
                if (st || ls == 1.2345e33f) Core<96, 64, true, false>::store_o(o, 1.0f / ls, (bf16*)(ws + WS_OC) + (t0 + 128 * qb + 32 * (r >> 3) + 8 * wq + (r & 7)) * POC + hh * 64, h);
            }
        } else { if (!(tmask & 1)) { if (tid0 == 0) jobw[(it + 1) & 1] = nextj; continue; }
            int a = idx - NJ_BC, g, c, qb, b, sp;
            if (a < NJ_A0) { g = 0; c = 0; b = a >> 5; sp = (a >> 4) & 1; qb = a & 15; }
            else if (a < NJ_A0 + NJ_A1) { a -= NJ_A0; g = 1; b = a >> 5; sp = (a >> 4) & 1; c = (a >> 2) & 3; qb = a & 3; }
            else { a -= NJ_A0 + NJ_A1; g = 2; b = a >> 5; sp = (a >> 4) & 1; c = a & 15; qb = 0; }
            const int dil = g == 0 ? 1 : (g == 1 ? 4 : 16), L = SEQ / dil, hh = g * 4 + 2 * sp + half; const size_t t0 = (size_t)b * SEQ;
            bf16* base = (bf16*)(ws + WS_QKVA) + (t0 + c) * PA + hh * 64;
            HJob J; J.q = base + (size_t)(128 * qb) * dil * PA; J.qpitch = dil * PA; J.k = base + 768; J.kpitch = dil * PA; J.k2 = nullptr; J.k2pitch = 0; J.v = base + 1536; J.vpitch = dil * PA;
            J.qs0 = 128 * qb; J.ks0 = qb == 0 ? 0 : 128 * qb - 128; J.kmax = L - 1; J.ntiles = qb == 0 ? 2 : 4; J.band = 128; J.slope2 = alibi_a(hh) * LOG2E * (float)dil;
            f32x16 o[2]; float m, ls; Core<64, 64, false, false>::run(lds, J, J.ntiles, o, m, ls, PS);
            const int qi = 128 * qb + 32 * wq + r;
            if (st || ls == 1.2345e33f) Core<64, 64, false, false>::store_o(o, 1.0f / ls, base + (size_t)qi * dil * PA, h);
            if ((st || ls == 1.2345e33f) && h == 0) ((float*)(ws + WS_LSE))[((size_t)g * M + t0 + c + (size_t)qi * dil) * 4 + (2 * sp + half)] = m + log2f(ls);
        }
        if (tid0 == 0) jobw[(it + 1) & 1] = nextj;
    }
    PROF_MARK(PS, 0);
    if (ATT_PROF && blockIdx.x == 0 && tid0 == 0) { jobw[24] += (unsigned)PS.acc; jobw[25] += (unsigned)(PS.acc >> 32) + ((jobw[24] < (unsigned)PS.acc) ? 1u : 0u); }
}
}
struct MkProj {
    ProjDst D; float* ssq_q; float* ssq_kv;
    DI EpiProj make(const pg8::GUnit& u) const { return D.of(u.col0); }
    DI void extra(const f32x4 (&acc)[2][2][4][2], const pg8::GUnit& u, int wr, int wc, int fr, int fq) const {
        if (u.col0 != 3840 && u.col0 != 4096) return;
        const bool kv = (u.col0 == 4096); float* dst = kv ? ssq_kv : ssq_q;
#pragma unroll
        for (int ai = 0; ai < 2; ++ai)
#pragma unroll
            for (int m = 0; m < 4; ++m) { float s = 0.f;
#pragma unroll
                for (int bj = 0; bj < 2; ++bj) { if (kv && bj == 1) continue;
#pragma unroll
                    for (int n = 0; n < 2; ++n)
#pragma unroll
                        for (int c = 0; c < 4; ++c) { const float r = bf2f((unsigned short)f2bf(acc[ai][bj][m][n][c])); s += r * r; } }
                s += __shfl_xor(s, 16); s += __shfl_xor(s, 32);
                if (fq == 0) dst[(size_t)(u.row0 + ai * 128 + wr * 64 + m * 16 + fr) * 4 + wc] = s; }
    }
};
template <class F> struct MkPlain { F E; DI F make(const pg8::GUnit&) const { return E; } DI void extra(const f32x4 (&)[2][2][4][2], const pg8::GUnit&, int, int, int, int) const {} };
struct MkGateUp { bf16* act; const float* wl;
    DI EpiGateUp make(const pg8::GUnit& u) const { return EpiGateUp{act, wl + u.e * M, u.sb}; }
    DI void extra(const f32x4 (&)[2][2][4][2], const pg8::GUnit&, int, int, int, int) const {} };
struct MkDown { bf16* y; const int* list;
    DI EpiDown make(const pg8::GUnit& u) const { return EpiDown{y, list + u.e * M, u.row0 + u.cnt}; }
    DI void extra(const f32x4 (&)[2][2][4][2], const pg8::GUnit&, int, int, int, int) const {} };

#define XB_TMO      128
#define XB_XCNT(j)  (256  + 64 * (j))
#define XB_XSUB(j)  (1280 + 64 * (j))
#define XB_XGEN(j)  (2304 + 64 * (j))
#define XB_TOP      3328
#define XB_TOPGEN   3392
#define XCD_BAR_WORDS 3456
#define XB_SPIN_CAP (1u << 18)
__device__ __forceinline__ unsigned xb_ld(unsigned* p)              { return __hip_atomic_load(p, __ATOMIC_RELAXED, __HIP_MEMORY_SCOPE_AGENT); }
__device__ __forceinline__ unsigned xb_add(unsigned* p, unsigned v) { return __hip_atomic_fetch_add(p, v, __ATOMIC_RELAXED, __HIP_MEMORY_SCOPE_AGENT); }
__device__ __forceinline__ unsigned xb_xcc_id() { return (unsigned)__builtin_amdgcn_s_getreg((3 << 11) | 20) & 0xFu; }
#define XB_SPIN(cond, bar) do { unsigned _sp = 0; while (cond) { __builtin_amdgcn_s_sleep(1); \
    if ((++_sp & 255u) == 0u) { if (xb_ld(&(bar)[XB_TMO])) break; if (_sp > XB_SPIN_CAP) { atomicAdd(&(bar)[XB_TMO], 1u); break; } } } } while (0)
struct XcdBarrier { unsigned* bar; unsigned x; volatile LAS unsigned* st; };
__device__ __forceinline__ XcdBarrier xcd_barrier_post(unsigned* bar, volatile LAS unsigned* st) {
    XcdBarrier b; b.bar = bar; b.x = xb_xcc_id(); b.st = st;
    if (threadIdx.x == 0) (void)xb_add(&bar[XB_XCNT(b.x)], 1u);
    return b;
}
__device__ __forceinline__ void xcd_barrier_complete(unsigned* bar, unsigned x, unsigned& nloc, unsigned& nx) {
    const unsigned G = gridDim.x * gridDim.y * gridDim.z;
    unsigned sum, cnt, mine, sp = 0u;
    for (;;) {
        sum = 0u; cnt = 0u; mine = 0u;
#pragma unroll
        for (unsigned j = 0; j < 16; ++j) { const unsigned c = xb_ld(&bar[XB_XCNT(j)]); sum += c; cnt += (c > 0u) ? 1u : 0u; mine = (j == x) ? c : mine; }
        if (sum == G) break;
        __builtin_amdgcn_s_sleep(1);
        if ((++sp & 255u) == 0u) { if (xb_ld(&bar[XB_TMO])) break; if (sp > XB_SPIN_CAP) { atomicAdd(&bar[XB_TMO], 1u); break; } }
    }
    nloc = mine > 0u ? mine : 1u; nx = cnt > 0u ? cnt : 1u;
}
__device__ __forceinline__ void xcd_barrier(const XcdBarrier& b) {
    asm volatile("s_waitcnt vmcnt(0)" ::: "memory");
    __syncthreads();
    if (threadIdx.x == 0) {
        unsigned* bar = b.bar;
        __builtin_amdgcn_s_waitcnt(0);
        unsigned nloc = b.st[0], nx = b.st[1];
        if (nloc == 0u) { xcd_barrier_complete(bar, b.x, nloc, nx); b.st[0] = nloc; b.st[1] = nx; }
        const unsigned old = xb_add(&bar[XB_XSUB(b.x)], 1u);
        const unsigned gen = old / nloc;
        if (old + 1u == (gen + 1u) * nloc) {
            __builtin_amdgcn_fence(__ATOMIC_RELEASE, "agent");
            asm volatile("s_waitcnt vmcnt(0)" ::: "memory");
            const unsigned og = xb_add(&bar[XB_TOP], 1u);
            const unsigned tg = og / nx;
            if (og + 1u == (tg + 1u) * nx) xb_add(&bar[XB_TOPGEN], 1u);
            else XB_SPIN(xb_ld(&bar[XB_TOPGEN]) == tg, bar);
            __builtin_amdgcn_fence(__ATOMIC_ACQUIRE, "agent");
            xb_add(&bar[XB_XGEN(b.x)], 1u);
            asm volatile("s_waitcnt vmcnt(0)" ::: "memory");
        } else {
            XB_SPIN(xb_ld(&bar[XB_XGEN(b.x)]) == gen, bar);
            __builtin_amdgcn_fence(__ATOMIC_ACQUIRE, "agent");
            asm volatile("s_waitcnt vmcnt(0)" ::: "memory");
        }
    }
    __syncthreads();
}

constexpr int NWAVES = 8;
constexpr int RING_BYTES = 131072, MISC_OFF = RING_BYTES, LDS_BYTES = 147456;
#ifndef PH_MASK
#define PH_MASK 0x7ff
#endif
#define PH_EN(k) (((PH_MASK) >> (k)) & 1)
#ifndef REP_MASK
#define REP_MASK 0
#endif
#define NREP(k) ((((REP_MASK) >> (k)) & 1) ? 2 : 1)
#ifndef MK_PER_PHASE
#define MK_PER_PHASE 0
#endif
constexpr int N_PHASES = 1 + DEPTH * 10;
struct Args { Params p; int ph_lo, ph_hi, zero, pad; };

DI unsigned long long rf64(unsigned long long v) { const unsigned lo = __builtin_amdgcn_readfirstlane((unsigned)v), hi = __builtin_amdgcn_readfirstlane((unsigned)(v >> 32)); return ((unsigned long long)hi << 32) | lo; }
DI Params load_params(LAS const unsigned long long* PT) { Params p;
#pragma unroll
    for (int i = 0; i < 23; ++i) p.in[i] = (const float*)(GAS const float*)rf64(PT[i]);
    p.out = (float*)(GAS float*)rf64(PT[23]); p.ws = (unsigned char*)(GAS unsigned char*)rf64(PT[24]); return p; }
__global__ void __launch_bounds__(NWAVES * 64, 2) mega_fwd(Args args) {
    extern __shared__ __attribute__((aligned(16))) unsigned char lds_raw[];
    LAS unsigned char* lds = (LAS unsigned char*)lds_raw;
    const int tid = threadIdx.x, lane0 = tid & 63, wave0 = __builtin_amdgcn_readfirstlane(tid >> 6);
    LAS unsigned long long* PT = (LAS unsigned long long*)(lds + MISC_OFF + 256);
    if (tid < 23) PT[tid] = (unsigned long long)args.p.in[tid];
    if (tid == 23) PT[23] = (unsigned long long)args.p.out;
    if (tid == 24) PT[24] = (unsigned long long)args.p.ws;
    const int G0 = gridDim.x;
    volatile LAS unsigned* MISC = (volatile LAS unsigned*)(lds + MISC_OFF);
    if (tid < 64) MISC[tid] = 0u;
    __syncthreads();
    XcdBarrier bar; { unsigned* ctl0 = (unsigned*)((unsigned char*)(GAS unsigned char*)rf64(PT[24]) + WS_CTL); bar.bar = ctl0 + CW_BAR; bar.x = 0; bar.st = nullptr;
        if (!MK_PER_PHASE) bar = xcd_barrier_post(ctl0 + CW_BAR, MISC + 8); }
#define LOADP() int lane = lane0, wave = wave0, G = G0, bid = (int)blockIdx.x; asm volatile("" : "+v"(lane)); asm volatile("" : "+s"(wave), "+s"(G), "+s"(bid)); \
    const int gw = bid * NWAVES + wave, NGW = G * NWAVES; LAS float* const scr = (LAS float*)(lds + wave * 16384); (void)gw; (void)NGW; (void)scr; (void)lane; \
    const Params p = load_params(PT); unsigned char* const ws = p.ws; unsigned* const ctl = (unsigned*)(ws + WS_CTL); const f32x2* const rope = (const f32x2*)(ws + WS_ROPE); (void)ctl; (void)rope
    const int lo = args.ph_lo, hi = args.ph_hi;
#define IN(k) (lo <= (k) && (k) < hi)
#ifndef XBAR_REP
#define XBAR_REP 0
#endif
#ifndef DRY_TMASK
#define DRY_TMASK 7
#endif
#ifndef PROBE_PH
#define PROBE_PH -1
#endif
#ifndef PROBE_K
#define PROBE_K 4
#endif
#define T0COND (blockIdx.x == 0 && wave0 == 0 && __builtin_amdgcn_mbcnt_hi(~0u, __builtin_amdgcn_mbcnt_lo(~0u, 0u)) == 0u)
#define STAMP(slot) do { if (PROBE_PH >= 0 && T0COND) { const unsigned long long t_ = __builtin_amdgcn_s_memrealtime(); MISC[32 + 2 * (slot)] = (unsigned)t_; MISC[33 + 2 * (slot)] = (unsigned)(t_ >> 32); } } while (0)
#define PRB_L ((PROBE_PH - 1) / 10)
#define PRB_K ((PROBE_PH - 1) % 10)
#define SEAMX(k, endhit, beghit) do { if (IN(k) && IN((k) + 1)) { xcd_barrier(bar); if (XBAR_REP) { xcd_barrier(bar); xcd_barrier(bar); xcd_barrier(bar); xcd_barrier(bar); } } if (PROBE_PH >= 0 && (endhit)) STAMP(1); if (PROBE_PH >= 0 && (beghit)) STAMP(0); } while (0)
#define SEAM(k) SEAMX(k, false, false)
#define SEAML(kc) SEAMX(P + (kc), PROBE_PH >= 1 && (kc) == PRB_K && l == PRB_L, PROBE_PH >= 1 && (((kc) + 1 == PRB_K && l == PRB_L) || ((kc) == 9 && PRB_K == 0 && l + 1 == PRB_L)))

    if (PROBE_PH == 0) STAMP(0);
    if (PH_EN(0) && IN(0)) for (int rep = 0; rep < NREP(0); ++rep) { LOADP(); ph_cvt_mixer(p, 0, gw, NGW, lane, scr); ph_rope_table(p, gw, NGW, lane); ph_rmsnorm(p.in[0], p.in[2], (bf16*)(ws + WS_U), gw, NGW, lane); }
    SEAMX(0, PROBE_PH == 0, PROBE_PH == 1);
    for (int l = 0; l < DEPTH; ++l) {
        const int P = 1 + l * 10;
        if (PH_EN(1) && IN(P + 0)) for (int rep = 0; rep < NREP(1); ++rep) { LOADP();
            pg8::DenseSched S; S.T.init(M / 256, G == 256 ? NPROJ / 256 - 1 : NPROJ / 256, G, bid); S.A = (const char*)(ws + WS_U); S.Bt = (const char*)(ws + WM_IN); S.lda = DM; S.K = DM;
            pg8::Epi8<MkProj> E{MkProj{ProjDst{(bf16*)(ws + WS_QKVA), (bf16*)(ws + WS_QKVB), (bf16*)(ws + WS_CLAT), (bf16*)(ws + WS_G), rope, (bf16*)(ws + WS_KR)}, (float*)(ws + WS_SSQQ), (float*)(ws + WS_SSQKV)}};
            pg8::gemm_phase(lds, S, E, MISC + 40, 1);
        }
        SEAML(0);
        if (PH_EN(2) && IN(P + 1)) for (int rep = 0; rep < NREP(2); ++rep) { LOADP();
            const bool split = (G == 256);
            if (split && bid < 64) {
                pg8::DenseSched S; S.T.init(M / 256, 1, 64, bid); S.pn0 = NPROJ / 256 - 1; S.A = (const char*)(ws + WS_U); S.Bt = (const char*)(ws + WM_IN); S.lda = DM; S.K = DM;
                pg8::Epi8<MkProj> E{MkProj{ProjDst{(bf16*)(ws + WS_QKVA), (bf16*)(ws + WS_QKVB), (bf16*)(ws + WS_CLAT), (bf16*)(ws + WS_G), rope, (bf16*)(ws + WS_KR)}, (float*)(ws + WS_SSQQ), (float*)(ws + WS_SSQKV)}};
                pg8::gemm_phase(lds, S, E);
            } else {
            const int Gb = split ? 192 : G, cb = split ? bid - 64 : bid;
            { pg8::DenseSched S; S.T.init(M / 256, 3, Gb, cb); S.A = (const char*)(ws + WS_CLAT); S.Bt = (const char*)(ws + WM_UQ); S.lda = PCL; S.K = 256;
              pg8::Epi8<MkPlain<EpiQc>> E{MkPlain<EpiQc>{EpiQc{(bf16*)(ws + WS_QC), (const float*)(ws + WS_SSQQ), rope}}};
              pg8::gemm_phase(lds, S, E, MISC + 40, 2); }
            { pg8::DenseSched S; S.T.init(M / 256, 3, Gb, cb); S.A = (const char*)(ws + WS_CLAT) + 512; S.Bt = (const char*)(ws + WM_UKV); S.lda = PCL; S.K = 256;
              pg8::Epi8<MkPlain<EpiKv>> E{MkPlain<EpiKv>{EpiKv{(bf16*)(ws + WS_KVC), (const float*)(ws + WS_SSQKV)}}};
              pg8::gemm_phase(lds, S, E, MISC + 40, 2); }
            }
        }
        SEAML(1);
        if (PH_EN(3) && IN(P + 2)) { LOADP();
            if (NREP(3) == 2) { att::phase(p, l, lds, MISC + 16, ctl + CW_ATTN + l * 64 + 8, args.zero != 0, DRY_TMASK, 0, att::NJOBS); __syncthreads(); }
            att::phase(p, l, lds, MISC + 16, ctl + CW_ATTN + l * 64, true, 7, 0, att::NJOBS);
        }
        SEAML(2);
        if (PH_EN(4) && IN(P + 3)) { LOADP(); ph_amerge(p, gw, NGW, lane); }
        SEAML(3);
        if (PH_EN(5) && IN(P + 4)) for (int rep = 0; rep < NREP(5); ++rep) { LOADP();
            const int rot = bid % 3;
            for (int s = 0; s < 3; ++s) { const int br = (s + rot) % 3;
                pg8::DenseSched S; S.T.init(M / 256, 4, G, bid);
                S.A = (const char*)(ws + (br == 0 ? WS_OA : br == 1 ? WS_QKVB : WS_OC)); S.Bt = (const char*)(ws + (br == 0 ? WM_PA : br == 1 ? WM_PB : WM_PC));
                S.lda = br == 0 ? POA : br == 1 ? PB : POC; S.K = br == 0 ? 256 : br == 1 ? 512 : 384;
                pg8::Epi8<MkPlain<EpiMerge>> E{MkPlain<EpiMerge>{EpiMerge{(bf16*)(ws + WS_MERGED), (const bf16*)(ws + WS_G) + br * 1024, s == 0}}};
                pg8::gemm_phase(lds, S, E, MISC + 40, 5); }
        }
        SEAML(4);
        if (PH_EN(6) && IN(P + 5)) for (int rep = 0; rep < (l == 0 ? NREP(6) : 1); ++rep) { LOADP();
            pg8::DenseSched S; S.T.init(M / 256, 4, G, bid); S.A = (const char*)(ws + WS_MERGED); S.Bt = (const char*)(ws + WM_O); S.lda = DM; S.K = DM;
            pg8::Epi4<MkPlain<EpiResid>> E{MkPlain<EpiResid>{EpiResid{l == 0 ? p.in[0] : p.out, p.out}}};
            pg8::gemm_phase(lds, S, E, MISC + 40, 6);
        }
        SEAML(5);
        if (PH_EN(7) && IN(P + 6)) { LOADP(); ph_router(p, l, bid, G, wave, lane, lds, (LAS unsigned*)(lds + 81920)); __syncthreads(); for (int rep = 0; rep < NREP(11); ++rep) ph_cvt_experts(p, l, gw, NGW, lane, scr); }
        SEAML(6);
        if (PH_EN(8) && IN(P + 7)) for (int rep = 0; rep < NREP(8); ++rep) { LOADP();
            const unsigned* cnt = ctl + CW_CNT + l * 1024;
            pg8::MoeSched<true> S{cnt, (const int*)(ws + WS_LIST), (const char*)(ws + WS_U), (const char*)(ws + WS_WGU), DM, DM, 4, G, bid, (size_t)1024 * 1024 * 2};
            pg8::Epi8<MkGateUp> E{MkGateUp{(bf16*)(ws + WS_ACT), (const float*)(ws + WS_WLIST)}};
            pg8::gemm_phase(lds, S, E, MISC + 40, 8);
        }
        SEAML(7);
        if (PH_EN(9) && IN(P + 8)) for (int rep = 0; rep < NREP(9); ++rep) { LOADP();
            const unsigned* cnt = ctl + CW_CNT + l * 1024;
            pg8::MoeSched<false> S{cnt, (const int*)(ws + WS_LIST), (const char*)(ws + WS_ACT), (const char*)(ws + WS_WD), DEXP, DEXP, 4, G, bid, (size_t)1024 * 512 * 2};
            pg8::Epi8<MkDown> E{MkDown{(bf16*)(ws + WS_Y), (const int*)(ws + WS_LIST)}};
            pg8::gemm_phase(lds, S, E, MISC + 40, 9);
        }
        SEAML(8);
        if (PH_EN(10) && IN(P + 9)) { LOADP(); if (NREP(14) == 2) ph_combine(p, l, gw, NGW, lane, args.zero != 0); ph_combine(p, l, gw, NGW, lane, true); if (l + 1 < DEPTH) for (int rep = 0; rep < NREP(12); ++rep) ph_cvt_mixer(p, l + 1, gw, NGW, lane, scr); }
        SEAML(9);
    }
    if (PROBE_PH >= 0 && T0COND) {
        if (PROBE_PH == N_PHASES - 1) STAMP(1);
        const unsigned long long t0 = ((unsigned long long)MISC[33] << 32) | MISC[32], t1 = ((unsigned long long)MISC[35] << 32) | MISC[34];
        const unsigned long long tgt = __builtin_amdgcn_s_memrealtime() + (unsigned long long)PROBE_K * (t1 - t0);
        while (__builtin_amdgcn_s_memrealtime() < tgt) __builtin_amdgcn_s_sleep(8);
    }
    if ((ATT_PROF || GEMM_PROF) && T0COND) {
        const unsigned long long acc = ((unsigned long long)MISC[41] << 32) | MISC[40];
        const unsigned long long tgt = __builtin_readcyclecounter() + (unsigned long long)PROBE_K * acc;
        while (__builtin_readcyclecounter() < tgt) __builtin_amdgcn_s_sleep(8);
    }
#undef IN
#undef SEAM
}

extern "C" void kernel_launch(void* const* d_in, const int* in_sizes, int n_in, void* d_out, int out_size, void* d_ws, size_t ws_size, hipStream_t stream) {
    static int grid = 0;
    if (grid == 0) {
        if (n_in != 23 || ws_size < WS_END || out_size != M * DM) { fprintf(stderr, "kernel_launch: unexpected sizes\n"); grid = -1; return; }
        int dev = 0, cus = 0, per_cu = 0;
        if (hipGetDevice(&dev) != hipSuccess || hipDeviceGetAttribute(&cus, hipDeviceAttributeMultiprocessorCount, dev) != hipSuccess) { grid = -1; return; }
        if (hipFuncSetAttribute((const void*)mega_fwd, hipFuncAttributeMaxDynamicSharedMemorySize, LDS_BYTES) != hipSuccess) { fprintf(stderr, "kernel_launch: hipFuncSetAttribute failed\n"); grid = -1; return; }
        if (hipOccupancyMaxActiveBlocksPerMultiprocessor(&per_cu, (const void*)mega_fwd, NWAVES * 64, LDS_BYTES) != hipSuccess || per_cu < 1) { fprintf(stderr, "kernel_launch: occupancy query says %d\n", per_cu); }
        (void)hipGetLastError();
        grid = cus;
    }
    if (grid < 0) return;
    (void)hipMemsetAsync((char*)d_ws + WS_CTL, 0, CTL_BYTES, stream);
    Args a{}; for (int i = 0; i < 23; ++i) a.p.in[i] = (const float*)d_in[i]; a.p.out = (float*)d_out; a.p.ws = (unsigned char*)d_ws;
#if MK_PER_PHASE
    for (int ph = 0; ph < N_PHASES; ++ph) { a.ph_lo = ph; a.ph_hi = ph + 1; hipLaunchKernelGGL(mega_fwd, dim3(grid), dim3(NWAVES * 64), LDS_BYTES, stream, a); }
#else
    a.ph_lo = 0; a.ph_hi = N_PHASES; hipLaunchKernelGGL(mega_fwd, dim3(grid), dim3(NWAVES * 64), LDS_BYTES, stream, a);
#endif
}
```

```cpp
#include <hip/hip_runtime.h>
#include <cstdio>
#include <cstdint>
#include <cmath>

#define GAS __attribute__((address_space(1)))
#define LAS __attribute__((address_space(3)))
#define DI __device__ __forceinline__
typedef unsigned short bf16;
typedef unsigned v4u __attribute__((ext_vector_type(4)));
typedef unsigned v2u __attribute__((ext_vector_type(2)));
typedef float f32x4 __attribute__((ext_vector_type(4)));
typedef float f32x2 __attribute__((ext_vector_type(2)));
typedef float f32x16 __attribute__((ext_vector_type(16)));
typedef short bf16x8 __attribute__((ext_vector_type(8)));
typedef short s16x4 __attribute__((ext_vector_type(4)));

constexpr int NB = 8, SEQ = 2048, DM = 1024, M = NB * SEQ, DEPTH = 2;
constexpr int IN_COLS = 7328, NPROJ = 7424;
constexpr int NEXP = 16, DEXP = 512;
constexpr float RMS_EPS = 1e-6f;
constexpr float LOG2E = 1.4426950408889634f;
constexpr float C2A = 0.125f * LOG2E;
constexpr float C2C = 0.10206207261596577f * LOG2E;
constexpr int PA = 2304, PB = 1536, PCL = 512, PG = 3072, PQC = 576, PKV = 768, POC = 384, POA = 256;
constexpr int KR_COL = 384;

constexpr size_t MiB = 1u << 20;
constexpr size_t WS_CTL = 0, CTL_BYTES = 256 * 1024;
constexpr size_t WS_LIST = 1 * MiB;
constexpr size_t WS_WLIST = 2 * MiB;
constexpr size_t WS_SSQQ = 3 * MiB;
constexpr size_t WS_SSQKV = 3 * MiB + 256 * 1024;
constexpr size_t WS_LSE = 3 * MiB + 512 * 1024;
constexpr size_t WS_ROPE = 4 * MiB + 256 * 1024;
constexpr size_t WS_KR = 4 * MiB + 512 * 1024;
constexpr size_t WS_WMIX = 6 * MiB;
constexpr size_t WM_IN = WS_WMIX;
constexpr size_t WM_O = WM_IN + (size_t)NPROJ * DM * 2;
constexpr size_t WM_PA = WM_O + (size_t)DM * DM * 2;
constexpr size_t WM_PB = WM_PA + (size_t)DM * 256 * 2;
constexpr size_t WM_PC = WM_PB + (size_t)DM * 512 * 2;
constexpr size_t WM_UQ = WM_PC + (size_t)DM * 384 * 2;
constexpr size_t WM_UKV = WM_UQ + (size_t)768 * 256 * 2;
constexpr size_t WM_END = WM_UKV + (size_t)768 * 256 * 2;
static_assert(WM_END <= 26 * MiB, "mixer weights");
constexpr size_t WS_U = 26 * MiB;
constexpr size_t WS_OA = WS_U + 24 * MiB;
constexpr size_t WS_QKVA = 58 * MiB;
constexpr size_t WS_QKVB = 130 * MiB;
constexpr size_t WS_CLAT = 178 * MiB;
constexpr size_t WS_OC = WS_CLAT;
constexpr size_t WS_G = 194 * MiB;
constexpr size_t WS_QC = 290 * MiB;
constexpr size_t WS_KVC = 308 * MiB;
constexpr size_t WS_END = 332 * MiB;
constexpr size_t WS_MERGED = WS_QKVA;
constexpr size_t WS_WGU = 58 * MiB;
constexpr size_t WS_WD = 90 * MiB;
constexpr size_t WS_ACT = 106 * MiB;
constexpr size_t WS_Y = 142 * MiB;
constexpr int ACT_ROWS = 2 * M + NEXP * 256;
static_assert(WS_ACT + (size_t)ACT_ROWS * DEXP * 2 <= WS_Y && WS_Y + (size_t)2 * M * DM * 2 <= WS_G + 96 * MiB && WS_KVC + (size_t)M * 768 * 2 <= WS_END, "ws map");
constexpr int CW_TMO = 0;
constexpr int CW_CNT = 16384;
constexpr int CW_ERR = 256;
constexpr int CW_ATTN = 512;
constexpr int CW_BAR = 4096;

struct Params {
    const float* in[23]; float* out; unsigned char* ws;
};

DI unsigned f2bf(float f) { unsigned u = __builtin_bit_cast(unsigned, f); return (u + 0x7fffu + ((u >> 16) & 1u)) >> 16; }
typedef __bf16 bf16x2_hw __attribute__((ext_vector_type(2)));
DI unsigned pk2(float lo, float hi) { f32x2 v = {lo, hi}; bf16x2_hw b = __builtin_convertvector(v, bf16x2_hw); return __builtin_bit_cast(unsigned, b); }
DI float bf2f(unsigned short b) { return __builtin_bit_cast(float, (unsigned)b << 16); }
DI float bflo(unsigned w) { return __builtin_bit_cast(float, w << 16); }
DI float bfhi(unsigned w) { return __builtin_bit_cast(float, w & 0xffff0000u); }
DI float wave_sum(float v) {
#pragma unroll
    for (int o = 1; o < 64; o <<= 1) v += __shfl_xor(v, o);
    return v;
}
DI float wave_max(float v) {
#pragma unroll
    for (int o = 1; o < 64; o <<= 1) v = fmaxf(v, __shfl_xor(v, o));
    return v;
}
DI float sigmoidf_(float x) { return __builtin_amdgcn_rcpf(1.0f + __builtin_amdgcn_exp2f(-LOG2E * x)); }
DI float alibi_a(int h) { return exp2f(-8.0f * (float)(h + 1) / 12.0f); }
DI float alibi_b(int h) { return exp2f(-2.0f * (float)(h + 1)); }
DI float lam_init_of(int l) { return 0.8f - 0.6f * expf(-0.3f * (float)l); }
DI float lam_of(const Params& p, int l, int lane) {
    const float a = p.in[11][l * 64 + lane] * p.in[12][l * 64 + lane], b = p.in[13][l * 64 + lane] * p.in[14][l * 64 + lane];
    return expf(wave_sum(a)) - expf(wave_sum(b)) + lam_init_of(l);
}
#define LDS_WAIT() asm volatile("s_waitcnt lgkmcnt(0)" ::: "memory")

struct MapIdent { int off; DI int operator()(int n) const { return n + off; } };
struct MapWin { DI int operator()(int n) const { if (n < 4224) return n; if (n < 4256) { const int i = n - 4224; return 4224 + (i < 16 ? 2 * i : 2 * (i - 16) + 1); } return n + 96; } };
struct MapUq { DI int operator()(int n) const { const int h = n / 96, j = n % 96; if (j < 64) return n; const int i = j - 64; return h * 96 + 64 + (i < 16 ? 2 * i : 2 * (i - 16) + 1); } };
struct MapGate { DI int operator()(int n) const { return 8 * (n >> 2) + (n & 3); } };
struct MapUp { DI int operator()(int n) const { return 8 * (n >> 2) + 4 + (n & 3); } };

struct CvtDesc { const float* W; int N; bf16* WT; int Kd; const float* gk; int mapid, item; };
DI int cvt_map(int mapid, int n) { return mapid == 0 ? n : mapid == 1 ? MapWin{}(n) : mapid == 2 ? MapUq{}(n) : mapid == 3 ? MapGate{}(n) : MapUp{}(n); }
DI void cvt_load(const CvtDesc& d, int lane, float (&v)[32]) {
    const int nblk = d.N / 32, kb = d.item / nblk, nb = d.item % nblk, k0 = 64 * kb, n0 = 32 * nb;
    const float* src = d.W + (size_t)(k0 + (lane >> 5)) * d.N + n0 + (lane & 31);
#pragma unroll
    for (int i = 0; i < 32; ++i) v[i] = src[(size_t)(2 * i) * d.N];
    if (d.gk) {
#pragma unroll
        for (int i = 0; i < 32; ++i) v[i] *= d.gk[k0 + 2 * i + (lane >> 5)]; }
}
DI void cvt_store(const CvtDesc& d, int lane, const float (&v)[32], LAS float* scr) {
    const int nblk = d.N / 32, kb = d.item / nblk, nb = d.item % nblk, k0 = 64 * kb, n0 = 32 * nb;
#pragma unroll
    for (int i = 0; i < 32; ++i) scr[(2 * i + (lane >> 5)) * 33 + (lane & 31)] = v[i];
    LDS_WAIT(); asm volatile("" ::: "memory");
    const int c = lane & 7;
#pragma unroll
    for (int j = 0; j < 4; ++j) { const int n = (lane >> 3) + 8 * j; const LAS float* s = scr + (8 * c) * 33 + n;
        v4u o; o.x = pk2(s[0 * 33], s[1 * 33]); o.y = pk2(s[2 * 33], s[3 * 33]); o.z = pk2(s[4 * 33], s[5 * 33]); o.w = pk2(s[6 * 33], s[7 * 33]);
        const int dr = cvt_map(d.mapid, n0 + n);
        *(v4u*)(d.WT + (size_t)dr * d.Kd + k0 + 8 * c) = o; }
    LDS_WAIT(); asm volatile("" ::: "memory");
}
template <class Dec>
DI void cvt_run(const Dec& dec, int nit, int gw, int NGW, int lane, LAS float* scr) {
    float v[32], vn[32]; CvtDesc d, dn; int it = gw;
    if (it < nit) { d = dec(it); cvt_load(d, lane, v); }
    while (it < nit) { const int itn = it + NGW; dn = d;
        if (itn < nit) { dn = dec(itn); cvt_load(dn, lane, vn); }
        cvt_store(d, lane, v, scr);
#pragma unroll
        for (int i = 0; i < 32; ++i) v[i] = vn[i];
        d = dn; it = itn; }
}
struct DecMixer { const Params* p; int l;
    DI CvtDesc operator()(int it) const { unsigned char* ws = p->ws; int r = it;
        constexpr int I_IN = 16 * (IN_COLS / 32), I_O = 16 * 32, I_PA = 4 * 32, I_PB = 8 * 32, I_PC = 6 * 32, I_UQ = 4 * 18;
        if (r < I_IN) return CvtDesc{p->in[1] + (size_t)l * DM * IN_COLS, IN_COLS, (bf16*)(ws + WM_IN), DM, nullptr, 1, r}; r -= I_IN;
        if (r < I_O) return CvtDesc{p->in[6] + (size_t)l * DM * DM, DM, (bf16*)(ws + WM_O), DM, nullptr, 0, r}; r -= I_O;
        if (r < I_PA) return CvtDesc{p->in[3] + (size_t)l * 256 * DM, DM, (bf16*)(ws + WM_PA), 256, nullptr, 0, r}; r -= I_PA;
        if (r < I_PB) return CvtDesc{p->in[4] + (size_t)l * 512 * DM, DM, (bf16*)(ws + WM_PB), 512, nullptr, 0, r}; r -= I_PB;
        if (r < I_PC) return CvtDesc{p->in[5] + (size_t)l * 384 * DM, DM, (bf16*)(ws + WM_PC), 384, nullptr, 0, r}; r -= I_PC;
        if (r < I_UQ) return CvtDesc{p->in[8] + (size_t)l * 256 * 576, 576, (bf16*)(ws + WM_UQ), 256, p->in[7] + l * 256, 2, r}; r -= I_UQ;
        return CvtDesc{p->in[10] + (size_t)l * 128 * 768, 768, (bf16*)(ws + WM_UKV), 256, p->in[9] + l * 128, 0, r}; } };
DI void ph_cvt_mixer(const Params& p, int l, int gw, int NGW, int lane, LAS float* scr) {
    unsigned char* ws = p.ws;
    constexpr int NIT = 16 * (IN_COLS / 32) + 16 * 32 + 4 * 32 + 8 * 32 + 6 * 32 + 4 * 18 + 2 * 24;
    cvt_run(DecMixer{&p, l}, NIT, gw, NGW, lane, scr);
    const v4u z = {0u, 0u, 0u, 0u};
    const int gt = gw * 64 + lane, NT = NGW * 64;
    for (int c = gt; c < 96 * 128; c += NT) *(v4u*)((bf16*)(ws + WM_IN) + (size_t)4256 * DM + (size_t)c * 8) = z;
    for (int c = gt; c < 192 * 32; c += NT) *(v4u*)((bf16*)(ws + WM_UQ) + (size_t)576 * 256 + (size_t)c * 8) = z;
    for (int c = gt; c < 768 * 16; c += NT) *(v4u*)((bf16*)(ws + WM_UKV) + (size_t)(c >> 4) * 256 + 128 + (c & 15) * 8) = z;
}
struct DecExperts { const Params* p; int l;
    DI CvtDesc operator()(int it) const { unsigned char* ws = p->ws; constexpr int IG = 16 * 16, IDN = 8 * 32, PER = 2 * IG + IDN;
        const int e = it / PER; int r = it % PER; const size_t eo = ((size_t)l * NEXP + e) * DM * DEXP;
        if (r < IG) return CvtDesc{p->in[19] + eo, DEXP, (bf16*)(ws + WS_WGU) + (size_t)e * 1024 * 1024, DM, nullptr, 3, r}; r -= IG;
        if (r < IG) return CvtDesc{p->in[20] + eo, DEXP, (bf16*)(ws + WS_WGU) + (size_t)e * 1024 * 1024, DM, nullptr, 4, r}; r -= IG;
        return CvtDesc{p->in[21] + eo, DM, (bf16*)(ws + WS_WD) + (size_t)e * 1024 * 512, DEXP, nullptr, 0, r}; } };
DI void ph_cvt_experts(const Params& p, int l, int gw, int NGW, int lane, LAS float* scr) {
    cvt_run(DecExperts{&p, l}, NEXP * (2 * 16 * 16 + 8 * 32), gw, NGW, lane, scr);
}
DI void ph_rope_table(const Params& p, int gw, int NGW, int lane) {
    f32x2* tab = (f32x2*)(p.ws + WS_ROPE);
    for (int idx = gw * 64 + lane; idx < SEQ * 16; idx += NGW * 64) {
        const int pos = idx >> 4, i = idx & 15;
        double inv = 1.0; for (int j = 0; j < i; ++j) inv *= 0.56234132519034908;
        const double rev = (double)pos * inv * 0.15915494309189535;
        double fr = rev - floor(rev); if (fr >= 0.5) fr -= 1.0;
        const float f = (float)fr;
        tab[idx] = (f32x2){__builtin_amdgcn_cosf(f), __builtin_amdgcn_sinf(f)};
    }
}
DI void load_row(const float* xr, int lane, f32x4 (&v)[4]) {
#pragma unroll
    for (int j = 0; j < 4; ++j) v[j] = ((const f32x4*)xr)[lane + 64 * j];
}
DI float row_ss(const f32x4 (&v)[4]) {
    float s = 0.f;
#pragma unroll
    for (int j = 0; j < 4; ++j) s += (v[j].x * v[j].x + v[j].y * v[j].y) + (v[j].z * v[j].z + v[j].w * v[j].w);
    return wave_sum(s);
}
DI void store_row_bf16(bf16* orow, int lane, const f32x4 (&v)[4], float rs, const float* g) {
#pragma unroll
    for (int j = 0; j < 4; ++j) { const f32x4 gg = ((const f32x4*)g)[lane + 64 * j];
        v2u o; o.x = pk2(v[j].x * rs * gg.x, v[j].y * rs * gg.y); o.y = pk2(v[j].z * rs * gg.z, v[j].w * rs * gg.w);
        ((v2u*)orow)[lane + 64 * j] = o; }
}
DI void ph_rmsnorm(const float* x, const float* g, bf16* out, int gw, int NGW, int lane) {
    f32x4 v[4], vn[4];
    if (gw < M) load_row(x + (size_t)gw * DM, lane, vn);
    for (int m = gw; m < M; m += NGW) {
#pragma unroll
        for (int j = 0; j < 4; ++j) v[j] = vn[j];
        if (m + NGW < M) load_row(x + (size_t)(m + NGW) * DM, lane, vn);
        const float rs = rsqrtf(row_ss(v) * (1.0f / DM) + RMS_EPS);
        store_row_bf16(out + (size_t)m * DM, lane, v, rs, g); }
}
DI int wr_slot(int k) { return (((k >> 8) << 2) + (k & 3)) * 64 + ((k >> 2) & 63); }
DI void ph_router(const Params& p, int l, int bid, int G, int wave, int lane, LAS unsigned char* wlds, LAS unsigned* rl) {
    const float* x1 = p.out; const float* g = p.in[16] + l * DM; const float* wr = p.in[17]; const float* rb = p.in[18];
    bf16* h = (bf16*)(p.ws + WS_U); int* list = (int*)(p.ws + WS_LIST); float* wl = (float*)(p.ws + WS_WLIST);
    unsigned* cnt = (unsigned*)(p.ws + WS_CTL) + CW_CNT + l * 1024;
    const int rpw = (M + G - 1) / G, r0 = bid * rpw, nr = (M - r0 < rpw ? M - r0 : rpw), tid = wave * 64 + lane;
    LAS unsigned* lcnt = rl; LAS unsigned* gbase = rl + 16; LAS int* ee = (LAS int*)(rl + 32); LAS float* ew = (LAS float*)(rl + 32 + 256); LAS unsigned* er = rl + 32 + 512;
    if (tid < 16) lcnt[tid] = 0u;
    for (int c = tid; c < 1024 * 4; c += 512) { const int k = c >> 2, q = c & 3; *(LAS f32x4*)(wlds + wr_slot(k) * 80 + q * 16) = ((const f32x4*)wr)[c]; }
    __syncthreads();
    f32x4 gg[4];
#pragma unroll
    for (int j = 0; j < 4; ++j) gg[j] = ((const f32x4*)g)[lane + 64 * j];
    f32x4 v[4], vn[4];
    if (wave < nr) load_row(x1 + (size_t)(r0 + wave) * DM, lane, vn);
    for (int i = wave; i < nr; i += 8) {
        const int m = r0 + i;
#pragma unroll
        for (int j = 0; j < 4; ++j) v[j] = vn[j];
        if (i + 8 < nr) load_row(x1 + (size_t)(m + 8) * DM, lane, vn);
        const float rs = rsqrtf(row_ss(v) * (1.0f / DM) + RMS_EPS);
        float lg[16];
#pragma unroll
        for (int e = 0; e < 16; ++e) lg[e] = 0.f;
#pragma unroll
        for (int j = 0; j < 4; ++j) {
            const float hv[4] = {v[j].x * rs * gg[j].x, v[j].y * rs * gg[j].y, v[j].z * rs * gg[j].z, v[j].w * rs * gg[j].w};
            v2u o; o.x = pk2(hv[0], hv[1]); o.y = pk2(hv[2], hv[3]); ((v2u*)(h + (size_t)m * DM))[lane + 64 * j] = o;
#pragma unroll
            for (int c = 0; c < 4; ++c) { const LAS unsigned char* wrow = wlds + ((j * 4 + c) * 64 + lane) * 80;
#pragma unroll
                for (int q = 0; q < 4; ++q) { const f32x4 w = *(const LAS f32x4*)(wrow + q * 16); lg[4 * q] += hv[c] * w.x; lg[4 * q + 1] += hv[c] * w.y; lg[4 * q + 2] += hv[c] * w.z; lg[4 * q + 3] += hv[c] * w.w; } } }
        float a8[8], a4[4], a2[2], a1;
        { const bool hi = (lane & 32) != 0;
#pragma unroll
          for (int q = 0; q < 8; ++q) { const float keep = hi ? lg[q + 8] : lg[q], send = hi ? lg[q] : lg[q + 8]; a8[q] = keep + __shfl_xor(send, 32); } }
        { const bool hi = (lane & 16) != 0;
#pragma unroll
          for (int q = 0; q < 4; ++q) { const float keep = hi ? a8[q + 4] : a8[q], send = hi ? a8[q] : a8[q + 4]; a4[q] = keep + __shfl_xor(send, 16); } }
        { const bool hi = (lane & 8) != 0;
#pragma unroll
          for (int q = 0; q < 2; ++q) { const float keep = hi ? a4[q + 2] : a4[q], send = hi ? a4[q] : a4[q + 2]; a2[q] = keep + __shfl_xor(send, 8); } }
        { const bool hi = (lane & 4) != 0; const float keep = hi ? a2[1] : a2[0], send = hi ? a2[0] : a2[1]; a1 = keep + __shfl_xor(send, 4); }
        a1 += __shfl_xor(a1, 2); a1 += __shfl_xor(a1, 1);
        float sc[16], bs[16];
#pragma unroll
        for (int e = 0; e < 16; ++e) { const int src = ((e >> 3) & 1) * 32 + ((e >> 2) & 1) * 16 + ((e >> 1) & 1) * 8 + (e & 1) * 4; const float t = __shfl(a1, src); sc[e] = 1.0f / (1.0f + expf(-t)); bs[e] = sc[e] + rb[e]; }
        int bg = 0; float bgs = -1e30f; int i1 = 0, i2 = 1;
#pragma unroll
        for (int gI = 0; gI < 4; ++gI) {
            int a = 0; float av = bs[4 * gI];
#pragma unroll
            for (int ii = 1; ii < 4; ++ii) if (bs[4 * gI + ii] > av) { av = bs[4 * gI + ii]; a = ii; }
            int b = -1; float bv = -1e30f;
#pragma unroll
            for (int ii = 0; ii < 4; ++ii) if (ii != a && bs[4 * gI + ii] > bv) { bv = bs[4 * gI + ii]; b = ii; }
            const float gs = av + bv;
            if (gs > bgs) { bgs = gs; bg = gI; i1 = a; i2 = b; }
        }
        const int e1 = bg * 4 + i1, e2 = bg * 4 + i2;
        float s1 = 0.f, s2 = 0.f;
#pragma unroll
        for (int e = 0; e < 16; ++e) { if (e == e1) s1 = sc[e]; if (e == e2) s2 = sc[e]; }
        const float inv = 1.0f / (s1 + s2);
        if (lane == 0) {
            ee[2 * i] = e1; ew[2 * i] = s1 * inv; er[2 * i] = __hip_atomic_fetch_add(lcnt + e1, 1u, __ATOMIC_RELAXED, __HIP_MEMORY_SCOPE_WORKGROUP);
            ee[2 * i + 1] = e2; ew[2 * i + 1] = s2 * inv; er[2 * i + 1] = __hip_atomic_fetch_add(lcnt + e2, 1u, __ATOMIC_RELAXED, __HIP_MEMORY_SCOPE_WORKGROUP);
        }
    }
    __syncthreads();
    if (tid < 16) gbase[tid] = atomicAdd(cnt + tid * 64, lcnt[tid]);
    __syncthreads();
    for (int t = tid; t < 2 * nr; t += 512) { const int e = ee[t]; const unsigned pos = gbase[e] + er[t]; list[e * M + pos] = (r0 + (t >> 1)) * 2 + (t & 1); wl[e * M + pos] = ew[t]; }
}
DI void ph_combine(const Params& p, int l, int gw, int NGW, int lane, bool st) {
    float* x1 = p.out; const bf16* Y = (const bf16*)(p.ws + WS_Y); bf16* u = (bf16*)(p.ws + WS_U);
    const bool last = (l == DEPTH - 1); const float* g = last ? p.in[22] : p.in[2] + (l + 1) * DM;
    f32x4 v[4], vn[4]; v2u ya[4], yb[4], yan[4], ybn[4];
#define CMB_LOAD(m_) do { load_row(x1 + (size_t)(m_) * DM, lane, vn); _Pragma("unroll") for (int j = 0; j < 4; ++j) { yan[j] = ((const v2u*)(Y + (size_t)(2 * (m_)) * DM))[lane + 64 * j]; ybn[j] = ((const v2u*)(Y + (size_t)(2 * (m_) + 1) * DM))[lane + 64 * j]; } } while (0)
    if (gw < M) CMB_LOAD(gw);
    for (int m = gw; m < M; m += NGW) {
#pragma unroll
        for (int j = 0; j < 4; ++j) { v[j] = vn[j]; ya[j] = yan[j]; yb[j] = ybn[j]; }
        if (m + NGW < M) CMB_LOAD(m + NGW);
#pragma unroll
        for (int j = 0; j < 4; ++j) { const v2u a = ya[j], b = yb[j];
            v[j].x += bflo(a.x) + bflo(b.x); v[j].y += bfhi(a.x) + bfhi(b.x); v[j].z += bflo(a.y) + bflo(b.y); v[j].w += bfhi(a.y) + bfhi(b.y); }
        const float rs = rsqrtf(row_ss(v) * (1.0f / DM) + RMS_EPS);
        if (!(st || rs == 1.2345e33f)) continue;
        if (last) {
#pragma unroll
            for (int j = 0; j < 4; ++j) { const f32x4 gg = ((const f32x4*)g)[lane + 64 * j]; ((f32x4*)(x1 + (size_t)m * DM))[lane + 64 * j] = v[j] * rs * gg; }
        } else {
#pragma unroll
            for (int j = 0; j < 4; ++j) ((f32x4*)(x1 + (size_t)m * DM))[lane + 64 * j] = v[j];
            store_row_bf16(u + (size_t)m * DM, lane, v, rs, g);
        }
    }
#undef CMB_LOAD
}
DI void amerge_tok(const bf16* og, const float* lse, bf16* oa, int t, int s, int d0, float (&lv)[3], v2u (&xv)[3], bool load) {
    if (load) {
#pragma unroll
        for (int g = 0; g < 3; ++g) { lv[g] = lse[((size_t)g * M + t) * 4 + s]; xv[g] = *(const v2u*)(og + (size_t)t * PA + (g * 4 + s) * 64 + d0); }
    } else {
        const float mx = fmaxf(lv[0], fmaxf(lv[1], lv[2])); const float a0 = exp2f(lv[0] - mx), a1 = exp2f(lv[1] - mx), a2 = exp2f(lv[2] - mx); const float inv = __builtin_amdgcn_rcpf(a0 + a1 + a2);
        const float w0 = a0 * inv, w1 = a1 * inv, w2 = a2 * inv;
        v2u o; o.x = pk2(w0 * bflo(xv[0].x) + w1 * bflo(xv[1].x) + w2 * bflo(xv[2].x), w0 * bfhi(xv[0].x) + w1 * bfhi(xv[1].x) + w2 * bfhi(xv[2].x));
        o.y = pk2(w0 * bflo(xv[0].y) + w1 * bflo(xv[1].y) + w2 * bflo(xv[2].y), w0 * bfhi(xv[0].y) + w1 * bfhi(xv[1].y) + w2 * bfhi(xv[2].y));
        *(v2u*)(oa + (size_t)t * POA + s * 64 + d0) = o;
    }
}
DI void ph_amerge(const Params& p, int gw, int NGW, int lane) {
    const bf16* og = (const bf16*)(p.ws + WS_QKVA); const float* lse = (const float*)(p.ws + WS_LSE); bf16* oa = (bf16*)(p.ws + WS_OA);
    const int s = lane >> 4, d0 = (lane & 15) * 4;
    for (int t = gw; t < M; t += 2 * NGW) {
        float la[3], lb[3]; v2u xa[3], xb[3]; const int t2 = t + NGW;
        amerge_tok(og, lse, oa, t, s, d0, la, xa, true);
        if (t2 < M) amerge_tok(og, lse, oa, t2, s, d0, lb, xb, true);
        amerge_tok(og, lse, oa, t, s, d0, la, xa, false);
        if (t2 < M) amerge_tok(og, lse, oa, t2, s, d0, lb, xb, false);
    }
}

DI void store8_bf16(bf16* dst, const float (&v)[8]) { v4u o; o.x = pk2(v[0], v[1]); o.y = pk2(v[2], v[3]); o.z = pk2(v[4], v[5]); o.w = pk2(v[6], v[7]); *(v4u*)dst = o; }
DI void rope4(float (&v)[8], const f32x2* tab, int pos, int i0) {
#pragma unroll
    for (int j = 0; j < 4; ++j) { const f32x2 cs = tab[pos * 16 + i0 + j]; const float t1 = v[2 * j], t2 = v[2 * j + 1]; v[2 * j] = t1 * cs.x - t2 * cs.y; v[2 * j + 1] = t1 * cs.y + t2 * cs.x; }
}
struct EpiProj {
    bf16* dst; int pitch, coff, mode; const f32x2* rope; bf16* kr;
    struct Ctx {}; DI void pre(int, int, Ctx&) const {}
    DI void s8(int row, int col, float (&v)[8], const Ctx&) const {
        const int c = col - coff;
        if (mode == 0) {
#pragma unroll
            for (int i = 0; i < 8; ++i) v[i] *= C2A; }
        else if (mode == 2) { if (c >= KR_COL && c < KR_COL + 32) { rope4(v, rope, row & (SEQ - 1), (c - KR_COL) >> 1); store8_bf16(kr + (size_t)row * 32 + (c - KR_COL), v); } }
        store8_bf16(dst + (size_t)row * pitch + c, v);
    }
};
struct ProjDst { bf16 *qkva, *qkvb, *clat, *g; const f32x2* rope; bf16* kr;
    DI EpiProj of(int col0) const {
        if (col0 < 2304) return EpiProj{qkva, PA, 0, col0 < 768 ? 0 : 1, rope, kr};
        if (col0 < 3840) return EpiProj{qkvb, PB, 2304, col0 < 2816 ? 0 : 1, rope, kr};
        if (col0 < 4352) return EpiProj{clat, PCL, 3840, col0 < 4096 ? 1 : 2, rope, kr};
        return EpiProj{g, PG, 4352, 3, rope, kr};
    }
};
struct EpiQc {
    bf16* qc; const float* ssq; const f32x2* rope;
    struct Ctx { f32x4 pp; }; DI void pre(int row, int col, Ctx& c) const { if (col < 576) c.pp = *(const f32x4*)(ssq + (size_t)row * 4); }
    DI void s8(int row, int col, float (&v)[8], const Ctx& c) const {
        if (col >= 576) return;
        const f32x4 pp = c.pp; const float rs = rsqrtf(((pp.x + pp.y) + (pp.z + pp.w)) * (1.0f / 256.0f) + RMS_EPS);
#pragma unroll
        for (int i = 0; i < 8; ++i) v[i] *= rs;
        const int j = col % 96; if (j >= 64) rope4(v, rope, row & (SEQ - 1), (j - 64) >> 1);
#pragma unroll
        for (int i = 0; i < 8; ++i) v[i] *= C2C;
        store8_bf16(qc + (size_t)row * PQC + col, v);
    }
};
struct EpiKv {
    bf16* kvc; const float* ssq;
    struct Ctx { f32x4 pp; }; DI void pre(int row, int, Ctx& c) const { c.pp = *(const f32x4*)(ssq + (size_t)row * 4); }
    DI void s8(int row, int col, float (&v)[8], const Ctx& c) const {
        const f32x4 pp = c.pp; const float rs = rsqrtf(((pp.x + pp.y) + (pp.z + pp.w)) * (1.0f / 128.0f) + RMS_EPS);
#pragma unroll
        for (int i = 0; i < 8; ++i) v[i] *= rs;
        store8_bf16(kvc + (size_t)row * PKV + col, v);
    }
};
struct EpiMerge {
    bf16* merged; const bf16* gate; bool first;
    struct Ctx { v4u g, o; };
    DI void pre(int row, int col, Ctx& c) const { c.g = *(const v4u*)(gate + (size_t)row * PG + col); if (!first) c.o = *(const v4u*)(merged + (size_t)row * DM + col); }
    DI void s8(int row, int col, float (&v)[8], const Ctx& c) const {
        const v4u gw = c.g;
        float r[8] = {v[0] * sigmoidf_(bflo(gw.x)), v[1] * sigmoidf_(bfhi(gw.x)), v[2] * sigmoidf_(bflo(gw.y)), v[3] * sigmoidf_(bfhi(gw.y)), v[4] * sigmoidf_(bflo(gw.z)), v[5] * sigmoidf_(bfhi(gw.z)), v[6] * sigmoidf_(bflo(gw.w)), v[7] * sigmoidf_(bfhi(gw.w))};
        if (!first) { const v4u o = c.o; r[0] += bflo(o.x); r[1] += bfhi(o.x); r[2] += bflo(o.y); r[3] += bfhi(o.y); r[4] += bflo(o.z); r[5] += bfhi(o.z); r[6] += bflo(o.w); r[7] += bfhi(o.w); }
        store8_bf16(merged + (size_t)row * DM + col, r);
    }
};
struct EpiResid {
    const float* xin; float* xout;
    struct Ctx { f32x4 b; }; DI void pre(int row, int col, Ctx& c) const { c.b = *(const f32x4*)(xin + (size_t)row * DM + col); }
    DI void s4(int row, int col, f32x4 v, const Ctx& c) const { *(f32x4*)(xout + (size_t)row * DM + col) = c.b + v; }
};
struct EpiGateUp {
    bf16* act; const float* wl; int slot0;
    struct Ctx { float w; }; DI void pre(int row, int, Ctx& c) const { c.w = wl[row]; }
    DI void s8(int row, int col, float (&v)[8], const Ctx& c) const {
        const float w = c.w;
        float a[4];
#pragma unroll
        for (int i = 0; i < 4; ++i) a[i] = v[i] * sigmoidf_(v[i]) * v[4 + i] * w;
        v2u o; o.x = pk2(a[0], a[1]); o.y = pk2(a[2], a[3]);
        *(v2u*)(act + (size_t)(slot0 + row) * DEXP + (col >> 1)) = o;
    }
};
struct EpiDown {
    bf16* y; const int* list; int cnt;
    struct Ctx { int tok; }; DI void pre(int row, int, Ctx& c) const { c.tok = row < cnt ? list[row] : -1; }
    DI void s8(int row, int col, float (&v)[8], const Ctx& c) const { if (c.tok < 0) return; store8_bf16(y + (size_t)c.tok * DM + col, v); }
};
#ifndef MOE_XCD
#define MOE_XCD 1
#endif
#ifndef GEMM_PROF
#define GEMM_PROF 0
#endif
__device__ unsigned long long g_gemm_prof_dummy;
namespace pg8 {
typedef unsigned u32x4 __attribute__((ext_vector_type(4)));
constexpr int BM = 256, BK = 64, HALF = 128, HTB = HALF * BK * 2, STAGE_BYTES = 8 * HTB, NXCD = 8, WGM = 8;
__host__ __device__ __forceinline__ int lds_byte(int r, int c) { const int st = (r >> 4) * 2 + (c >> 5), rr = r & 15, cc = c & 31, ob = rr * 64 + cc * 2; return st * 1024 + (ob ^ (((ob >> 9) & 1) << 5)); }
__host__ __device__ __forceinline__ void stage_rc(int b, int& R, int& C) { const int st = b / 1024, sb = b % 1024, swz = sb ^ (((sb >> 9) & 1) << 5); R = (st >> 1) * 16 + swz / 64; C = (st & 1) * 32 + (swz % 64) / 2; }
__host__ __device__ __forceinline__ int perm32(int rho) { const int n = rho >> 4, i = rho & 15; return 8 * (i >> 2) + 4 * n + (i & 3); }

struct GUnit { const char* a; const char* b; int row0, col0, e, cnt, sb; };

struct TileOrder {
    int nM, nN, nwg, G, c;
    DI void init(int nM_, int nN_, int G_, int c_) { nM = nM_; nN = nN_; nwg = nM * nN; G = G_; c = c_; }
    DI bool tile(int i, int& pm, int& pn) const {
        const long L = (long)i * G + c; if (L >= nwg) return false;
        int wgid = (int)L; { const int q = nwg / NXCD, r = nwg % NXCD, xcd = wgid % NXCD, off = wgid / NXCD; wgid = (xcd < r ? xcd * (q + 1) : r * (q + 1) + (xcd - r) * q) + off; }
        const int nig = WGM * nN, gid = wgid / nig, fm = gid * WGM, gsz = (nM - fm) < WGM ? (nM - fm) : WGM;
        pm = fm + ((wgid % nig) % gsz); pn = (wgid % nig) / gsz; return true;
    }
};
struct DenseSched {
    static constexpr bool GATHER = false;
    TileOrder T; const char* A; const char* Bt; int lda, K, pn0 = 0;
    DI bool next(int i, GUnit& u) const { int pm, pn; if (!T.tile(i, pm, pn)) return false; pn += pn0;
        u.a = A + (size_t)pm * BM * lda * 2; u.b = Bt + (size_t)pn * BM * K * 2; u.row0 = pm * BM; u.col0 = pn * BM; u.e = 0; u.cnt = BM; u.sb = 0; return true; }
    DI unsigned gather_off(const GUnit&, int, int) const { return 0u; }
};
template <bool GATH>
struct MoeSched {
    static constexpr bool GATHER = GATH;
    const unsigned* cnt; const int* list; const char* A; const char* Bt; int lda, K, nN, G, c; size_t bstride;
    DI int ntile(int e) const { return ((int)__builtin_amdgcn_readfirstlane((int)cnt[e * 64]) + 255) >> 8; }
    DI bool next(int i, GUnit& u) const {
        int e, tl, pn;
        if (MOE_XCD && (G & 7) == 0) {
            const int x = c & 7, n = i * (G >> 3) + (c >> 3), nt0 = ntile(2 * x), nt1 = ntile(2 * x + 1);
            if (n >= (nt0 + nt1) * nN) return false;
            const int tloc = n / nN; pn = n % nN; e = tloc < nt0 ? 2 * x : 2 * x + 1; tl = tloc < nt0 ? tloc : tloc - nt0;
        } else {
            const int L = i * G + c; int t = L / nN; pn = L % nN; e = -1; tl = 0;
            for (int q = 0; q < NEXP; ++q) { const int nt = ntile(q); if (t < nt) { e = q; tl = t; break; } t -= nt; }
            if (e < 0) return false;
        }
        int sb = 0; for (int q = 0; q < e; ++q) sb += ntile(q) * 256;
        const int ce = (int)__builtin_amdgcn_readfirstlane((int)cnt[e * 64]);
        u.e = e; u.sb = sb; u.cnt = ce - tl * 256; u.row0 = tl * 256; u.col0 = pn * BM; u.b = Bt + (size_t)e * bstride + (size_t)pn * BM * K * 2;
        u.a = GATH ? A : A + (size_t)(sb + tl * 256) * lda * 2; return true;
    }
    DI unsigned gather_off(const GUnit& u, int r, int C) const {
        const int lr = u.row0 + r; int tok = 0; if (r < u.cnt) tok = list[u.e * M + lr] >> 1;
        return (unsigned)(tok * lda + C) * 2u;
    }
};

DI unsigned cvt_pk_bf16(float lo, float hi) { unsigned r; asm volatile("v_cvt_pk_bf16_f32 %0, %1, %2" : "=v"(r) : "v"(lo), "v"(hi)); return r; }

template <class Mk>
struct Epi8 {
    static constexpr bool PERM = true;
    Mk mk;
    DI void operator()(const f32x4 (&acc)[2][2][4][2], const GUnit& u, int wr, int wc, int fr, int fq) const {
        asm volatile("" : "+v"(fr), "+v"(fq));
        const auto F = mk.make(u);
        typedef decltype(F) FT; typename FT::Ctx cx[2][2];
        const int rowb = u.row0 + wr * 64 + fr, colb = u.col0 + wc * 32 + 8 * fq;
#pragma unroll
        for (int bj = 0; bj < 2; ++bj) F.pre(rowb, colb + bj * HALF, cx[0][bj]);
#pragma unroll
        for (int g = 0; g < 8; ++g) { const int ai = g >> 2, m = g & 3, row = rowb + ai * HALF + m * 16;
            if (g + 1 < 8) { const int rown = rowb + ((g + 1) >> 2) * HALF + ((g + 1) & 3) * 16;
#pragma unroll
                for (int bj = 0; bj < 2; ++bj) F.pre(rown, colb + bj * HALF, cx[(g + 1) & 1][bj]); }
#pragma unroll
            for (int bj = 0; bj < 2; ++bj) { const f32x4 a = acc[ai][bj][m][0], b = acc[ai][bj][m][1]; float v[8] = {a[0], a[1], a[2], a[3], b[0], b[1], b[2], b[3]};
                F.s8(row, colb + bj * HALF, v, cx[g & 1][bj]); }
            if (false) asm volatile("" ::: "memory"); }
        mk.extra(acc, u, wr, wc, fr, fq);
    }
};
template <class Mk>
struct Epi4 {
    static constexpr bool PERM = false;
    Mk mk;
    DI void operator()(const f32x4 (&acc)[2][2][4][2], const GUnit& u, int wr, int wc, int fr, int fq) const {
        asm volatile("" : "+v"(fr), "+v"(fq));
        const auto F = mk.make(u);
        typedef decltype(F) FT; typename FT::Ctx cx[2][2][2];
        const int rowb = u.row0 + wr * 64 + fr, colb = u.col0 + wc * 32 + 4 * fq;
#pragma unroll
        for (int bj = 0; bj < 2; ++bj)
#pragma unroll
            for (int n = 0; n < 2; ++n) F.pre(rowb, colb + bj * HALF + 16 * n, cx[0][bj][n]);
#pragma unroll
        for (int g = 0; g < 8; ++g) { const int ai = g >> 2, m = g & 3, row = rowb + ai * HALF + m * 16;
            if (g + 1 < 8) { const int rown = rowb + ((g + 1) >> 2) * HALF + ((g + 1) & 3) * 16;
#pragma unroll
                for (int bj = 0; bj < 2; ++bj)
#pragma unroll
                    for (int n = 0; n < 2; ++n) F.pre(rown, colb + bj * HALF + 16 * n, cx[(g + 1) & 1][bj][n]); }
#pragma unroll
            for (int bj = 0; bj < 2; ++bj)
#pragma unroll
                for (int n = 0; n < 2; ++n) F.s4(row, colb + bj * HALF + 16 * n, acc[ai][bj][m][n], cx[g & 1][bj][n]);
            asm volatile("" ::: "memory"); }
    }
};

template <class Epi, class Sched>
__device__ __forceinline__ void gemm_phase(LAS unsigned char* lds, const Sched& S, const Epi& E, volatile LAS unsigned* prof = nullptr, int prof_id = 0) {
    unsigned long long pt0 = 0, pacc = 0; int pcur = 0;
#define GP_MARK(n) do { if (GEMM_PROF && prof) { const unsigned long long t_ = __builtin_readcyclecounter(); if (pcur == (GEMM_PROF & 15) && prof_id == (GEMM_PROF >> 4)) pacc += t_ - pt0; pcur = (n); pt0 = t_; } } while (0)
    GP_MARK(3);
    constexpr bool GATHER = Sched::GATHER;
    int tid_ = threadIdx.x; asm volatile("" : "+v"(tid_));
    const int tid = tid_, wid = __builtin_amdgcn_readfirstlane(tid >> 6), lane = tid & 63, wr = wid >> 2, wc = wid & 3, fr = lane & 15, fq = lane >> 4;
    const int K = S.K, lda = S.lda, nt = K / BK;
    int sR[2], sC[2];
    unsigned voffA[2][2], voffB[2], nvoffA[2][2];
#pragma unroll
    for (int i = 0; i < 2; ++i) { stage_rc(tid * 16 + i * 8192, sR[i], sC[i]); const int Rb = Epi::PERM ? ((sR[i] & ~31) + perm32(sR[i] & 31)) : sR[i];
        voffA[0][i] = (unsigned)(sR[i] * lda + sC[i]) * 2u; voffA[1][i] = voffA[0][i]; nvoffA[0][i] = voffA[0][i]; nvoffA[1][i] = voffA[0][i]; voffB[i] = (unsigned)(Rb * K + sC[i]) * 2u; }
    const size_t kstep = (size_t)(BK * 2);
    const size_t hstepA = GATHER ? 0 : (size_t)HALF * lda * 2, hstepB = (size_t)HALF * K * 2;
    const unsigned ldsw = (unsigned)wid * 1024u;
    const int aoff = lds_byte(wr * 64 + fr, fq * 8), boff = lds_byte(wc * 32 + fr, fq * 8);
#define PG8_SA(b, h) (((b) * 2 + (h)) * HTB)
#define PG8_SB(b, h) ((4 + (b) * 2 + (h)) * HTB)
#define PG8_STAGE(bufoff, gbase, voff) do { _Pragma("unroll") for (int _i = 0; _i < 2; ++_i) \
        __builtin_amdgcn_global_load_lds((const unsigned*)((const char*)(gbase) + (voff)[_i]), (LAS unsigned*)(lds + (bufoff) + ldsw + _i * 8192), 16, 0, 0); } while (0)
#define PG8_LDA(dst, b, h) do { _Pragma("unroll") for (int m = 0; m < 4; ++m) _Pragma("unroll") for (int k = 0; k < 2; ++k) dst[m][k] = *(const LAS bf16x8*)(lds + PG8_SA(b, h) + aoff + m * 2048 + k * 1024); } while (0)
#define PG8_LDB(dst, b, h) do { _Pragma("unroll") for (int n = 0; n < 2; ++n) _Pragma("unroll") for (int k = 0; k < 2; ++k) dst[n][k] = *(const LAS bf16x8*)(lds + PG8_SB(b, h) + boff + n * 2048 + k * 1024); } while (0)
#define PG8_MMA(ai, bj, At, Bt) do { __builtin_amdgcn_s_setprio(1); _Pragma("unroll") for (int m = 0; m < 4; ++m) _Pragma("unroll") for (int n = 0; n < 2; ++n) _Pragma("unroll") for (int k = 0; k < 2; ++k) \
        acc[ai][bj][m][n] = __builtin_amdgcn_mfma_f32_16x16x32_bf16(Bt[n][k], At[m][k], acc[ai][bj][m][n], 0, 0, 0); __builtin_amdgcn_s_setprio(0); } while (0)
#define PG8_WAIT_V(n) asm volatile("s_waitcnt vmcnt(" #n ")" ::: "memory")
#define PG8_WAIT_L(n) asm volatile("s_waitcnt lgkmcnt(" #n ")" ::: "memory")
#define PG8_BAR __builtin_amdgcn_s_barrier()
#define PG8_SCHED __builtin_amdgcn_sched_barrier(0)
    GUnit cur, nxt; int ui = 0;
    if (!S.next(0, cur)) return;
    if constexpr (GATHER) {
#pragma unroll
        for (int h = 0; h < 2; ++h)
#pragma unroll
            for (int i = 0; i < 2; ++i) voffA[h][i] = S.gather_off(cur, h * HALF + sR[i], sC[i]);
    }
    f32x4 acc[2][2][4][2];
#pragma unroll
    for (int a = 0; a < 2; ++a)
#pragma unroll
        for (int b = 0; b < 2; ++b)
#pragma unroll
            for (int m = 0; m < 4; ++m)
#pragma unroll
                for (int n = 0; n < 2; ++n) acc[a][b][m][n] = (f32x4){0.f, 0.f, 0.f, 0.f};
    bf16x8 At[4][2], B0[2][2], B1[2][2];
    const char* cA = cur.a; const char* cB = cur.b;
    PG8_STAGE(PG8_SB(0, 0), cB, voffB); PG8_STAGE(PG8_SB(0, 1), cB + hstepB, voffB); PG8_STAGE(PG8_SA(0, 0), cA, voffA[0]); PG8_STAGE(PG8_SA(0, 1), cA + hstepA, voffA[1]);
    if (wr == 1) PG8_BAR;
    PG8_WAIT_V(2); PG8_BAR;
    PG8_STAGE(PG8_SB(1, 0), cB + kstep, voffB); PG8_STAGE(PG8_SA(1, 0), cA + kstep, voffA[0]); PG8_STAGE(PG8_SB(1, 1), cB + hstepB + kstep, voffB);
    PG8_WAIT_V(6); PG8_BAR;
    for (;;) {
        GP_MARK(1);
        const bool has_next = S.next(ui + 1, nxt);
        const char* nA = has_next ? nxt.a : cA; const char* nB = has_next ? nxt.b : cB;
        if constexpr (GATHER) {
#pragma unroll
            for (int h = 0; h < 2; ++h)
#pragma unroll
                for (int i = 0; i < 2; ++i) nvoffA[h][i] = has_next ? S.gather_off(nxt, h * HALF + sR[i], sC[i]) : voffA[h][i];
        }
        for (int t = 0; t < nt; t += 2) {
            const bool last = (t == nt - 2);
            const char* a1 = cA + (size_t)(t + 1) * kstep;
            const char* a2 = last ? nA : cA + (size_t)(t + 2) * kstep; const char* b2 = last ? nB : cB + (size_t)(t + 2) * kstep;
            const char* a3 = a2 + kstep; const char* b3 = b2 + kstep;
            unsigned v2[2][2];
#pragma unroll
            for (int h = 0; h < 2; ++h)
#pragma unroll
                for (int i = 0; i < 2; ++i) v2[h][i] = (GATHER && last) ? nvoffA[h][i] : voffA[h][i];
            PG8_LDB(B0, 0, 0); PG8_LDB(B1, 0, 1); PG8_SCHED; PG8_LDA(At, 0, 0); PG8_STAGE(PG8_SA(1, 1), a1 + hstepA, voffA[1]);
            PG8_WAIT_V(8); PG8_WAIT_L(0); PG8_BAR; PG8_MMA(0, 0, At, B0); PG8_MMA(0, 1, At, B1); PG8_BAR; PG8_SCHED;
            PG8_LDA(At, 0, 1); PG8_STAGE(PG8_SB(0, 0), b2, voffB); PG8_STAGE(PG8_SB(0, 1), b2 + hstepB, voffB); PG8_STAGE(PG8_SA(0, 0), a2, v2[0]);
            PG8_WAIT_V(8); PG8_WAIT_L(0); PG8_BAR; PG8_MMA(1, 0, At, B0); PG8_MMA(1, 1, At, B1); PG8_BAR; PG8_SCHED;
            PG8_LDB(B0, 1, 0); PG8_LDB(B1, 1, 1); PG8_SCHED; PG8_LDA(At, 1, 0); PG8_STAGE(PG8_SA(0, 1), a2 + hstepA, v2[1]);
            PG8_WAIT_V(8); PG8_WAIT_L(0); PG8_BAR; PG8_MMA(0, 0, At, B0); PG8_MMA(0, 1, At, B1); PG8_BAR; PG8_SCHED;
            PG8_LDA(At, 1, 1); PG8_STAGE(PG8_SB(1, 0), b3, voffB); PG8_STAGE(PG8_SB(1, 1), b3 + hstepB, voffB); PG8_STAGE(PG8_SA(1, 0), a3, v2[0]);
            PG8_WAIT_V(8); PG8_WAIT_L(0); PG8_BAR; PG8_MMA(1, 0, At, B0); PG8_MMA(1, 1, At, B1); PG8_BAR; PG8_SCHED;
        }
        if (wr == 0) PG8_BAR;
        GP_MARK(2);
        E(acc, cur, wr, wc, fr, fq);
        GP_MARK(3);
        if (!has_next) break;
#pragma unroll
        for (int a = 0; a < 2; ++a)
#pragma unroll
            for (int b = 0; b < 2; ++b)
#pragma unroll
                for (int m = 0; m < 4; ++m)
#pragma unroll
                    for (int n = 0; n < 2; ++n) acc[a][b][m][n] = (f32x4){0.f, 0.f, 0.f, 0.f};
        cur = nxt; cA = nA; cB = nB; ++ui;
        if constexpr (GATHER) {
#pragma unroll
            for (int h = 0; h < 2; ++h)
#pragma unroll
                for (int i = 0; i < 2; ++i) voffA[h][i] = nvoffA[h][i];
        }
        if (wr == 1) PG8_BAR;
    }
    PG8_WAIT_V(0);
    PG8_BAR;
    GP_MARK(0);
    if (GEMM_PROF && prof && blockIdx.x == 0 && threadIdx.x == 0) { const unsigned old = prof[0]; prof[0] = old + (unsigned)pacc; prof[1] += (unsigned)(pacc >> 32) + ((old + (unsigned)pacc < old) ? 1u : 0u); }
#undef GP_MARK
#undef PG8_SA
#undef PG8_SB
#undef PG8_STAGE
#undef PG8_LDA
#undef PG8_LDB
#undef PG8_MMA
#undef PG8_WAIT_V
#undef PG8_WAIT_L
#undef PG8_BAR
#undef PG8_SCHED
}
}
#ifndef ATT_PROF
#define ATT_PROF 0
#endif
struct ProfSt { unsigned long long t0, acc; int cur; };
#define PROF_MARK(P, n) do { if (ATT_PROF) { const unsigned long long t_ = __builtin_readcyclecounter(); if ((P).cur == ATT_PROF) (P).acc += t_ - (P).t0; (P).cur = (n); (P).t0 = t_; } } while (0)
#ifndef ATT_MASK
#define ATT_MASK 7
#endif
namespace att {
typedef __bf16 bf16x2_t __attribute__((ext_vector_type(2)));
typedef short v4i16_t __attribute__((ext_vector_type(4)));
DI float xhalf_max(float v) { const auto rr = __builtin_amdgcn_permlane32_swap(__float_as_uint(v), __float_as_uint(v), false, false); return fmaxf(__uint_as_float(rr[0]), __uint_as_float(rr[1])); }
DI float xhalf_sum(float v) { const auto rr = __builtin_amdgcn_permlane32_swap(__float_as_uint(v), __float_as_uint(v), false, false); return __uint_as_float(rr[0]) + __uint_as_float(rr[1]); }
DI unsigned cvtpk(float lo, float hi) { f32x2 v = {lo, hi}; bf16x2_t b = __builtin_convertvector(v, bf16x2_t); return __builtin_bit_cast(unsigned, b); }
constexpr int BIGBAND = 1 << 28;

struct HJob {
    const bf16* q; int qpitch;
    const bf16* k; int kpitch;
    const bf16* k2; int k2pitch;
    const bf16* v; int vpitch;
    int qs0, ks0, kmax, ntiles, band; float slope2;
};

template <int DK, int DV, bool IL, bool SHV>
struct Core {
    static constexpr int KSTR = DK * 2 + 16, VSTR = (DV == 128) ? 320 : 192;
    static constexpr int KBYTES = 64 * KSTR, VBYTES = 64 * VSTR, HBYTES = KBYTES + VBYTES;
    static constexpr int NDS = DK / 16, NC = DV / 32, KCH = DK / 32, VCH = SHV ? DV / 64 : DV / 32, KCPR = DK / 8, VCPR = DV / 8;
    static constexpr int STG = SHV ? 2 * KBYTES + VBYTES : HBYTES, KOFF2 = SHV ? KBYTES : 0, VBASE = SHV ? 2 * KBYTES : KBYTES;

    static constexpr float THR = 8.0f;
    static DI void run(LAS unsigned char* lds, const HJob& J, int nt_max, f32x16 (&o)[NC], float& m_out, float& l_out, ProfSt& PS) {
        PROF_MARK(PS, 6);
        int tid_ = threadIdx.x; asm volatile("" : "+v"(tid_));
        const int tid = tid_, lane = tid & 63, r = lane & 31, h = lane >> 5;
        const int wave = __builtin_amdgcn_readfirstlane(tid >> 6), half = wave >> 2, wq = wave & 3, ht = tid & 255;
        LAS unsigned char* hb = SHV ? lds : lds + half * 2 * HBYTES;
        const int qloc = IL ? 32 * (r >> 3) + 8 * wq + (r & 7) : 32 * wq + r;
        unsigned kgo[KCH], vgo[VCH]; int klo[KCH], vlo[VCH];
#pragma unroll
        for (int i = 0; i < KCH; ++i) {
            if (i < 2) { const int id = ht + 256 * i, row = id >> 3, cc = id & 7; kgo[i] = (unsigned)(row * J.kpitch + cc * 8) * 2u; klo[i] = half * KOFF2 + row * KSTR + cc * 16; }
            else { const int row = ht >> 2, cc = ht & 3; kgo[i] = (unsigned)(row * J.k2pitch + cc * 8) * 2u; klo[i] = half * KOFF2 + row * KSTR + 128 + cc * 16; } }
#pragma unroll
        for (int i = 0; i < VCH; ++i) { const int id = (SHV ? tid + 512 * i : ht + 256 * i), row = id / VCPR, cc = id % VCPR; vgo[i] = (unsigned)(row * J.vpitch + cc * 8) * 2u; vlo[i] = VBASE + row * VSTR + cc * 16; }
        const char* kb0 = (const char*)J.k + (size_t)J.ks0 * J.kpitch * 2; const char* k2b0 = (DK == 96) ? (const char*)J.k2 + (size_t)J.ks0 * J.k2pitch * 2 : nullptr;
        const char* vb0 = (const char*)J.v + (size_t)J.ks0 * J.vpitch * 2;
        const size_t ktile = (size_t)64 * J.kpitch * 2, k2tile = (size_t)64 * J.k2pitch * 2, vtile = (size_t)64 * J.vpitch * 2;
        v4u kreg[KCH], vreg[VCH];
#define ATT_ISSUE(ti) do { \
        _Pragma("unroll") for (int i = 0; i < KCH; ++i) kreg[i] = *(const v4u*)((i < 2 ? kb0 + (size_t)(ti) * ktile : k2b0 + (size_t)(ti) * k2tile) + kgo[i]); \
        _Pragma("unroll") for (int i = 0; i < VCH; ++i) vreg[i] = *(const v4u*)(vb0 + (size_t)(ti) * vtile + vgo[i]); } while (0)
#define ATT_COMMIT(st) do { LAS unsigned char* sb_ = hb + (st) * STG; \
        _Pragma("unroll") for (int i = 0; i < KCH; ++i) *(LAS v4u*)(sb_ + klo[i]) = kreg[i]; \
        _Pragma("unroll") for (int i = 0; i < VCH; ++i) *(LAS v4u*)(sb_ + vlo[i]) = vreg[i]; } while (0)
        const int qidx = J.qs0 + qloc, wq0 = J.qs0 + (IL ? 8 * wq : 32 * wq), wq1 = wq0 + (IL ? 103 : 31), nt = J.ntiles;
        float m = 0.f, l = 0.f; bool started = false;
#pragma unroll
        for (int c = 0; c < NC; ++c)
#pragma unroll
            for (int i = 0; i < 16; ++i) o[c][i] = 0.f;
        if (nt > 0) ATT_ISSUE(nt - 1);
        bf16x8 qf[NDS];
        { const bf16* qp = J.q + (size_t)qloc * J.qpitch + 8 * h;
#pragma unroll
          for (int ds = 0; ds < NDS; ++ds) qf[ds] = *(const bf16x8*)(qp + 16 * ds);
#pragma unroll
          for (int ds = 0; ds < NDS; ++ds) asm volatile("" : "+v"(qf[ds])); }
        if (nt > 0) ATT_COMMIT(0);
        if (nt > 1) ATT_ISSUE(nt - 2);
        const int koff = half * KOFF2 + r * KSTR + 16 * h;
        const int voff = VBASE + (4 * h + ((lane & 15) >> 2)) * VSTR + ((lane >> 4) & 1) * 32 + (lane & 3) * 8;
        for (int kt = 0; kt < nt_max; ++kt) {
            PROF_MARK(PS, 1);
            asm volatile("s_waitcnt lgkmcnt(0)\n\ts_barrier" ::: "memory");
            PROF_MARK(PS, 2);
            if (kt + 1 < nt) ATT_COMMIT((kt + 1) & 1);
            if (kt + 2 < nt) ATT_ISSUE(nt - 3 - kt);
            const int ti = nt - 1 - kt, tk0 = J.ks0 + 64 * ti;
            if (kt < nt && tk0 <= wq1 && tk0 + 63 >= wq0 - J.band) {
                PROF_MARK(PS, 3);
                const LAS unsigned char* sb = hb + (kt & 1) * STG;
                f32x16 p[2];
#pragma unroll
                for (int kb = 0; kb < 2; ++kb) { const float base = J.slope2 * (float)(tk0 + 32 * kb + 4 * h - qidx) - m;
#pragma unroll
                    for (int i = 0; i < 16; ++i) p[kb][i] = __builtin_fmaf(J.slope2, (float)((i & 3) + 8 * (i >> 2)), base); }
                { bf16x8 kf[3][2];
#pragma unroll
                  for (int q = 0; q < 2; ++q) { kf[q][0] = *(const LAS bf16x8*)(sb + koff + q * 32); kf[q][1] = *(const LAS bf16x8*)(sb + koff + 32 * KSTR + q * 32); }
#pragma unroll
                  for (int ds = 0; ds < NDS; ++ds) {
                      if (ds + 2 < NDS) { kf[(ds + 2) % 3][0] = *(const LAS bf16x8*)(sb + koff + (ds + 2) * 32); kf[(ds + 2) % 3][1] = *(const LAS bf16x8*)(sb + koff + 32 * KSTR + (ds + 2) * 32); }
                      p[0] = __builtin_amdgcn_mfma_f32_32x32x16_bf16(kf[ds % 3][0], qf[ds], p[0], 0, 0, 0); p[1] = __builtin_amdgcn_mfma_f32_32x32x16_bf16(kf[ds % 3][1], qf[ds], p[1], 0, 0, 0);
                      __builtin_amdgcn_sched_barrier(0); } }
                v4i16_t va[NC][2], vb[NC][2];
#pragma unroll
                for (int c = 0; c < NC; ++c) { va[c][0] = __builtin_amdgcn_ds_read_tr16_b64_v4i16((LAS v4i16_t*)(sb + voff + c * 64)); va[c][1] = __builtin_amdgcn_ds_read_tr16_b64_v4i16((LAS v4i16_t*)(sb + voff + 8 * VSTR + c * 64)); }
                __builtin_amdgcn_sched_barrier(0);
                if (tk0 + 63 > wq0 || tk0 < wq1 - J.band) {
#pragma unroll
                    for (int kb = 0; kb < 2; ++kb)
#pragma unroll
                        for (int i = 0; i < 16; ++i) { const int kidx = tk0 + 32 * kb + (i & 3) + 8 * (i >> 2) + 4 * h; const bool ok = (kidx <= qidx) && (qidx - kidx <= J.band); if (!ok) p[kb][i] = -INFINITY; }
                }
                PROF_MARK(PS, 4);
                float g = fmaxf(p[0][0], p[1][0]);
#pragma unroll
                for (int i = 1; i < 16; ++i) g = fmaxf(g, fmaxf(p[0][i], p[1][i]));
                g = xhalf_max(g);
                const bool fin = g > -INFINITY;
                const bool up = started ? (g > THR) : fin;
                if (__any(up)) {
                    const float delta = up ? g : 0.f, alpha = started ? __builtin_amdgcn_exp2f(-delta) : 1.0f;
                    m += delta; l *= alpha;
#pragma unroll
                    for (int kb = 0; kb < 2; ++kb)
#pragma unroll
                        for (int i = 0; i < 16; ++i) p[kb][i] -= delta;
#pragma unroll
                    for (int c = 0; c < NC; ++c)
#pragma unroll
                        for (int i = 0; i < 16; ++i) o[c][i] *= alpha;
                }
                started = started || fin;
                float rs = 0.f;
#pragma unroll
                for (int ks = 0; ks < 4; ++ks) { const int kb = ks >> 1, b0 = 8 * (ks & 1); v4u w;
#pragma unroll
                    for (int i = 0; i < 8; ++i) { p[kb][b0 + i] = __builtin_amdgcn_exp2f(p[kb][b0 + i]); rs += p[kb][b0 + i]; }
                    w.x = cvtpk(p[kb][b0], p[kb][b0 + 1]); w.y = cvtpk(p[kb][b0 + 2], p[kb][b0 + 3]); w.z = cvtpk(p[kb][b0 + 4], p[kb][b0 + 5]); w.w = cvtpk(p[kb][b0 + 6], p[kb][b0 + 7]);
                    const bf16x8 pa = __builtin_bit_cast(bf16x8, w);
                    if (ks + 1 < 4) {
#pragma unroll
                        for (int c = 0; c < NC; ++c) { vb[c][0] = __builtin_amdgcn_ds_read_tr16_b64_v4i16((LAS v4i16_t*)(sb + voff + (16 * (ks + 1)) * VSTR + c * 64)); vb[c][1] = __builtin_amdgcn_ds_read_tr16_b64_v4i16((LAS v4i16_t*)(sb + voff + (16 * (ks + 1) + 8) * VSTR + c * 64)); } }
#pragma unroll
                    for (int c = 0; c < NC; ++c) { const bf16x8 vf = {va[c][0][0], va[c][0][1], va[c][0][2], va[c][0][3], va[c][1][0], va[c][1][1], va[c][1][2], va[c][1][3]};
                        o[c] = __builtin_amdgcn_mfma_f32_32x32x16_bf16(vf, pa, o[c], 0, 0, 0); }
#pragma unroll
                    for (int c = 0; c < NC; ++c) { va[c][0] = vb[c][0]; va[c][1] = vb[c][1]; }
                    __builtin_amdgcn_sched_barrier(0); }
                l += rs;
            }
        }
        PROF_MARK(PS, 5);
#undef ATT_ISSUE
#undef ATT_COMMIT
        m_out = m; l_out = xhalf_sum(l);
    }
    static DI void store_o(const f32x16 (&o)[NC], float inv, bf16* orow, int h) {
#pragma unroll
        for (int c = 0; c < NC; ++c)
#pragma unroll
            for (int g = 0; g < 4; ++g) { v2u w; w.x = cvtpk(o[c][4 * g] * inv, o[c][4 * g + 1] * inv); w.y = cvtpk(o[c][4 * g + 2] * inv, o[c][4 * g + 3] * inv);
                *(v2u*)(orow + 32 * c + 8 * g + 4 * h) = w; }
    }
};

constexpr int NJ_BC = 16 * 56, NJ_A0 = 256, NJ_A1 = 256, NJ_A2 = 256, NJOBS = NJ_BC + NJ_A0 + NJ_A1 + NJ_A2;

DI void phase(const Params& p, int l, LAS unsigned char* lds, volatile LAS unsigned* jobw, unsigned* ctr, bool st, int tmask, int j0, int j1) {
    unsigned char* ws = p.ws;
    const int tid0 = threadIdx.x; ProfSt PS; PS.t0 = 0; PS.acc = 0; PS.cur = 0; PROF_MARK(PS, 5);
    if (tid0 == 0) jobw[0] = atomicAdd(ctr, 1u);
    for (int it = 0;; ++it) {
        int tid = tid0; asm volatile("" : "+v"(tid));
        const int lane = tid & 63, r = lane & 31, h = lane >> 5, wave = __builtin_amdgcn_readfirstlane(tid >> 6), half = wave >> 2, wq = wave & 3;
        __syncthreads();
        const int idx = j0 + __builtin_amdgcn_readfirstlane((int)jobw[it & 1]);
        if (idx >= j1) break;
        unsigned nextj = 0u; if (tid0 == 0) nextj = atomicAdd(ctr, 1u);
        if (idx < NJ_BC) {
            const int qb = 15 - idx / 56, rr = idx % 56;
            if (rr < 32) { if (!(tmask & 2)) { if (tid0 == 0) jobw[(it + 1) & 1] = nextj; continue; }
                const int b = rr >> 2, hd = rr & 3, mp = half; const size_t t0 = (size_t)b * SEQ;
                bf16* base = (bf16*)(ws + WS_QKVB);
                HJob J; J.q = base + (t0 + 128 * qb) * PB + (2 * hd + mp) * 64; J.qpitch = PB; J.k = base + t0 * PB + 512 + (2 * hd + mp) * 64; J.kpitch = PB; J.k2 = nullptr; J.k2pitch = 0;
                J.v = base + t0 * PB + 1024 + hd * 128; J.vpitch = PB; J.qs0 = 128 * qb; J.ks0 = 0; J.kmax = SEQ - 1; J.ntiles = 2 * (qb + 1); J.band = BIGBAND; J.slope2 = alibi_b(hd) * LOG2E;
                f32x16 o[4]; float m, ls; Core<64, 128, true, true>::run(lds, J, J.ntiles, o, m, ls, PS);
                const float inv = 1.0f / ls;
                LAS float* ex = (LAS float*)lds;
                __syncthreads();
                if (half == 1) {
#pragma unroll
                    for (int c = 0; c < 4; ++c)
#pragma unroll
                        for (int i = 0; i < 16; ++i) ex[((wq * 4 + c) * 16 + i) * 64 + lane] = o[c][i] * inv;
                }
                __syncthreads();
                if (half == 0) {
                    const float lam = lam_of(p, l, lane); float ssq = 0.f;
#pragma unroll
                    for (int c = 0; c < 4; ++c)
#pragma unroll
                        for (int i = 0; i < 16; ++i) { const float d = o[c][i] * inv - lam * ex[((wq * 4 + c) * 16 + i) * 64 + lane]; o[c][i] = d; ssq += d * d; }
                    ssq = xhalf_sum(ssq);
                    const float rs = rsqrtf(ssq * (1.0f / 128.0f) + RMS_EPS) * (1.0f - lam_init_of(l));
                    const float* gs = p.in[15] + l * 128;
#pragma unroll
                    for (int c = 0; c < 4; ++c)
#pragma unroll
                        for (int g = 0; g < 4; ++g) { const f32x4 gg = *(const f32x4*)(gs + 32 * c + 8 * g + 4 * h);
                            o[c][4 * g] *= gg.x; o[c][4 * g + 1] *= gg.y; o[c][4 * g + 2] *= gg.z; o[c][4 * g + 3] *= gg.w; }
                    if (st || rs == 1.2345e33f) Core<64, 128, true, true>::store_o(o, rs, base + (t0 + 128 * qb + 32 * (r >> 3) + 8 * wq + (r & 7)) * PB + hd * 128, h);
                }
            } else { if (!(tmask & 4)) { if (tid0 == 0) jobw[(it + 1) & 1] = nextj; continue; }
                const int r2 = rr - 32, b = r2 / 3, hh = 2 * (r2 % 3) + half; const size_t t0 = (size_t)b * SEQ;
                const bf16* kv = (const bf16*)(ws + WS_KVC) + t0 * PKV + hh * 128;
                HJob J; J.q = (const bf16*)(ws + WS_QC) + (t0 + 128 * qb) * PQC + hh * 96; J.qpitch = PQC; J.k = kv; J.kpitch = PKV; J.k2 = (const bf16*)(ws + WS_KR) + t0 * 32; J.k2pitch = 32;
                J.v = kv + 64; J.vpitch = PKV; J.qs0 = 128 * qb; J.ks0 = 0; J.kmax = SEQ - 1; J.ntiles = 2 * (qb + 1); J.band = BIGBAND; J.slope2 = 0.f;
                f32x16 o[2]; float m, ls; Core<96, 64, true, false>::run(lds, J, J.ntiles, o, m, ls, PS);
                if (st || ls == 1.2345e33f) Core<96, 64, true, false>::store_o(o, 1.0f / ls, (bf16*)(ws + WS_OC) + (t0 + 128 * qb + 32 * (r >> 3) + 8 * wq + (r & 7)) * POC + hh * 64, h);
            }
        } else { if (!(tmask & 1)) { if (tid0 == 0) jobw[(it + 1) & 1] = nextj; continue; }
            int a = idx - NJ_BC, g, c, qb, b, sp;
            if (a < NJ_A0) { g = 0; c = 0; b = a >> 5; sp = (a >> 4) & 1; qb = a & 15; }
            else if (a < NJ_A0 + NJ_A1) { a -= NJ_A0; g = 1; b = a >> 5; sp = (a >> 4) & 1; c = (a >> 2) & 3; qb = a & 3; }
            else { a -= NJ_A0 + NJ_A1; g = 2; b = a >> 5; sp = (a >> 4) & 1; c = a & 15; qb = 0; }
            const int dil = g == 0 ? 1 : (g == 1 ? 4 : 16), L = SEQ / dil, hh = g * 4 + 2 * sp + half; const size_t t0 = (size_t)b * SEQ;
            bf16* base = (bf16*)(ws + WS_QKVA) + (t0 + c) * PA + hh * 64;
            HJob J; J.q = base + (size_t)(128 * qb) * dil * PA; J.qpitch = dil * PA; J.k = base + 768; J.kpitch = dil * PA; J.k2 = nullptr; J.k2pitch = 0; J.v = base + 1536; J.vpitch = dil * PA;
            J.qs0 = 128 * qb; J.ks0 = qb == 0 ? 0 : 128 * qb - 128; J.kmax = L - 1; J.ntiles = qb == 0 ? 2 : 4; J.band = 128; J.slope2 = alibi_a(hh) * LOG2E * (float)dil;
            f32x16 o[2]; float m, ls; Core<64, 64, false, false>::run(lds, J, J.ntiles, o, m, ls, PS);
            const int qi = 128 * qb + 32 * wq + r;
            if (st || ls == 1.2345e33f) Core<64, 64, false, false>::store_o(o, 1.0f / ls, base + (size_t)qi * dil * PA, h);
            if ((st || ls == 1.2345e33f) && h == 0) ((float*)(ws + WS_LSE))[((size_t)g * M + t0 + c + (size_t)qi * dil) * 4 + (2 * sp + half)] = m + log2f(ls);
        }
        if (tid0 == 0) jobw[(it + 1) & 1] = nextj;
    }
    PROF_MARK(PS, 0);
    if (ATT_PROF && blockIdx.x == 0 && tid0 == 0) { jobw[24] += (unsigned)PS.acc; jobw[25] += (unsigned)(PS.acc >> 32) + ((jobw[24] < (unsigned)PS.acc) ? 1u : 0u); }
}
}
struct MkProj {
    ProjDst D; float* ssq_q; float* ssq_kv;
    DI EpiProj make(const pg8::GUnit& u) const { return D.of(u.col0); }
    DI void extra(const f32x4 (&acc)[2][2][4][2], const pg8::GUnit& u, int wr, int wc, int fr, int fq) const {
        if (u.col0 != 3840 && u.col0 != 4096) return;
        const bool kv = (u.col0 == 4096); float* dst = kv ? ssq_kv : ssq_q;
#pragma unroll
        for (int ai = 0; ai < 2; ++ai)
#pragma unroll
            for (int m = 0; m < 4; ++m) { float s = 0.f;
#pragma unroll
                for (int bj = 0; bj < 2; ++bj) { if (kv && bj == 1) continue;
#pragma unroll
                    for (int n = 0; n < 2; ++n)
#pragma unroll
                        for (int c = 0; c < 4; ++c) { const float r = bf2f((unsigned short)f2bf(acc[ai][bj][m][n][c])); s += r * r; } }
                s += __shfl_xor(s, 16); s += __shfl_xor(s, 32);
                if (fq == 0) dst[(size_t)(u.row0 + ai * 128 + wr * 64 + m * 16 + fr) * 4 + wc] = s; }
    }
};
template <class F> struct MkPlain { F E; DI F make(const pg8::GUnit&) const { return E; } DI void extra(const f32x4 (&)[2][2][4][2], const pg8::GUnit&, int, int, int, int) const {} };
struct MkGateUp { bf16* act; const float* wl;
    DI EpiGateUp make(const pg8::GUnit& u) const { return EpiGateUp{act, wl + u.e * M, u.sb}; }
    DI void extra(const f32x4 (&)[2][2][4][2], const pg8::GUnit&, int, int, int, int) const {} };
struct MkDown { bf16* y; const int* list;
    DI EpiDown make(const pg8::GUnit& u) const { return EpiDown{y, list + u.e * M, u.row0 + u.cnt}; }
    DI void extra(const f32x4 (&)[2][2][4][2], const pg8::GUnit&, int, int, int, int) const {} };

#define XB_TMO      128
#define XB_XCNT(j)  (256  + 64 * (j))
#define XB_XSUB(j)  (1280 + 64 * (j))
#define XB_XGEN(j)  (2304 + 64 * (j))
#define XB_TOP      3328
#define XB_TOPGEN   3392
#define XCD_BAR_WORDS 3456
#define XB_SPIN_CAP (1u << 18)
__device__ __forceinline__ unsigned xb_ld(unsigned* p)              { return __hip_atomic_load(p, __ATOMIC_RELAXED, __HIP_MEMORY_SCOPE_AGENT); }
__device__ __forceinline__ unsigned xb_add(unsigned* p, unsigned v) { return __hip_atomic_fetch_add(p, v, __ATOMIC_RELAXED, __HIP_MEMORY_SCOPE_AGENT); }
__device__ __forceinline__ unsigned xb_xcc_id() { return (unsigned)__builtin_amdgcn_s_getreg((3 << 11) | 20) & 0xFu; }
#define XB_SPIN(cond, bar) do { unsigned _sp = 0; while (cond) { __builtin_amdgcn_s_sleep(1); \
    if ((++_sp & 255u) == 0u) { if (xb_ld(&(bar)[XB_TMO])) break; if (_sp > XB_SPIN_CAP) { atomicAdd(&(bar)[XB_TMO], 1u); break; } } } } while (0)
struct XcdBarrier { unsigned* bar; unsigned x; volatile LAS unsigned* st; };
__device__ __forceinline__ XcdBarrier xcd_barrier_post(unsigned* bar, volatile LAS unsigned* st) {
    XcdBarrier b; b.bar = bar; b.x = xb_xcc_id(); b.st = st;
    if (threadIdx.x == 0) (void)xb_add(&bar[XB_XCNT(b.x)], 1u);
    return b;
}
__device__ __forceinline__ void xcd_barrier_complete(unsigned* bar, unsigned x, unsigned& nloc, unsigned& nx) {
    const unsigned G = gridDim.x * gridDim.y * gridDim.z;
    unsigned sum, cnt, mine, sp = 0u;
    for (;;) {
        sum = 0u; cnt = 0u; mine = 0u;
#pragma unroll
        for (unsigned j = 0; j < 16; ++j) { const unsigned c = xb_ld(&bar[XB_XCNT(j)]); sum += c; cnt += (c > 0u) ? 1u : 0u; mine = (j == x) ? c : mine; }
        if (sum == G) break;
        __builtin_amdgcn_s_sleep(1);
        if ((++sp & 255u) == 0u) { if (xb_ld(&bar[XB_TMO])) break; if (sp > XB_SPIN_CAP) { atomicAdd(&bar[XB_TMO], 1u); break; } }
    }
    nloc = mine > 0u ? mine : 1u; nx = cnt > 0u ? cnt : 1u;
}
__device__ __forceinline__ void xcd_barrier(const XcdBarrier& b) {
    asm volatile("s_waitcnt vmcnt(0)" ::: "memory");
    __syncthreads();
    if (threadIdx.x == 0) {
        unsigned* bar = b.bar;
        __builtin_amdgcn_s_waitcnt(0);
        unsigned nloc = b.st[0], nx = b.st[1];
        if (nloc == 0u) { xcd_barrier_complete(bar, b.x, nloc, nx); b.st[0] = nloc; b.st[1] = nx; }
        const unsigned old = xb_add(&bar[XB_XSUB(b.x)], 1u);
        const unsigned gen = old / nloc;
        if (old + 1u == (gen + 1u) * nloc) {
            __builtin_amdgcn_fence(__ATOMIC_RELEASE, "agent");
            asm volatile("s_waitcnt vmcnt(0)" ::: "memory");
            const unsigned og = xb_add(&bar[XB_TOP], 1u);
            const unsigned tg = og / nx;
            if (og + 1u == (tg + 1u) * nx) xb_add(&bar[XB_TOPGEN], 1u);
            else XB_SPIN(xb_ld(&bar[XB_TOPGEN]) == tg, bar);
            __builtin_amdgcn_fence(__ATOMIC_ACQUIRE, "agent");
            xb_add(&bar[XB_XGEN(b.x)], 1u);
            asm volatile("s_waitcnt vmcnt(0)" ::: "memory");
        } else {
            XB_SPIN(xb_ld(&bar[XB_XGEN(b.x)]) == gen, bar);
            __builtin_amdgcn_fence(__ATOMIC_ACQUIRE, "agent");
            asm volatile("s_waitcnt vmcnt(0)" ::: "memory");
        }
    }
    __syncthreads();
}

constexpr int NWAVES = 8;
constexpr int RING_BYTES = 131072, MISC_OFF = RING_BYTES, LDS_BYTES = 147456;
#ifndef PH_MASK
#define PH_MASK 0x7ff
#endif
#define PH_EN(k) (((PH_MASK) >> (k)) & 1)
#ifndef REP_MASK
#define REP_MASK 0
#endif
#define NREP(k) ((((REP_MASK) >> (k)) & 1) ? 2 : 1)
#ifndef MK_PER_PHASE
#define MK_PER_PHASE 0
#endif
constexpr int N_PHASES = 1 + DEPTH * 10;
struct Args { Params p; int ph_lo, ph_hi, zero, pad; };

DI unsigned long long rf64(unsigned long long v) { const unsigned lo = __builtin_amdgcn_readfirstlane((unsigned)v), hi = __builtin_amdgcn_readfirstlane((unsigned)(v >> 32)); return ((unsigned long long)hi << 32) | lo; }
DI Params load_params(LAS const unsigned long long* PT) { Params p;
#pragma unroll
    for (int i = 0; i < 23; ++i) p.in[i] = (const float*)(GAS const float*)rf64(PT[i]);
    p.out = (float*)(GAS float*)rf64(PT[23]); p.ws = (unsigned char*)(GAS unsigned char*)rf64(PT[24]); return p; }
__global__ void __launch_bounds__(NWAVES * 64, 2) mega_fwd(Args args) {
    extern __shared__ __attribute__((aligned(16))) unsigned char lds_raw[];
    LAS unsigned char* lds = (LAS unsigned char*)lds_raw;
    const int tid = threadIdx.x, lane0 = tid & 63, wave0 = __builtin_amdgcn_readfirstlane(tid >> 6);
    LAS unsigned long long* PT = (LAS unsigned long long*)(lds + MISC_OFF + 256);
    if (tid < 23) PT[tid] = (unsigned long long)args.p.in[tid];
    if (tid == 23) PT[23] = (unsigned long long)args.p.out;
    if (tid == 24) PT[24] = (unsigned long long)args.p.ws;
    const int G0 = gridDim.x;
    volatile LAS unsigned* MISC = (volatile LAS unsigned*)(lds + MISC_OFF);
    if (tid < 64) MISC[tid] = 0u;
    __syncthreads();
    XcdBarrier bar; { unsigned* ctl0 = (unsigned*)((unsigned char*)(GAS unsigned char*)rf64(PT[24]) + WS_CTL); bar.bar = ctl0 + CW_BAR; bar.x = 0; bar.st = nullptr;
        if (!MK_PER_PHASE) bar = xcd_barrier_post(ctl0 + CW_BAR, MISC + 8); }
#define LOADP() int lane = lane0, wave = wave0, G = G0, bid = (int)blockIdx.x; asm volatile("" : "+v"(lane)); asm volatile("" : "+s"(wave), "+s"(G), "+s"(bid)); \
    const int gw = bid * NWAVES + wave, NGW = G * NWAVES; LAS float* const scr = (LAS float*)(lds + wave * 16384); (void)gw; (void)NGW; (void)scr; (void)lane; \
    const Params p = load_params(PT); unsigned char* const ws = p.ws; unsigned* const ctl = (unsigned*)(ws + WS_CTL); const f32x2* const rope = (const f32x2*)(ws + WS_ROPE); (void)ctl; (void)rope
    const int lo = args.ph_lo, hi = args.ph_hi;
#define IN(k) (lo <= (k) && (k) < hi)
#ifndef XBAR_REP
#define XBAR_REP 0
#endif
#ifndef DRY_TMASK
#define DRY_TMASK 7
#endif
#ifndef PROBE_PH
#define PROBE_PH -1
#endif
#ifndef PROBE_K
#define PROBE_K 4
#endif
#define T0COND (blockIdx.x == 0 && wave0 == 0 && __builtin_amdgcn_mbcnt_hi(~0u, __builtin_amdgcn_mbcnt_lo(~0u, 0u)) == 0u)
#define STAMP(slot) do { if (PROBE_PH >= 0 && T0COND) { const unsigned long long t_ = __builtin_amdgcn_s_memrealtime(); MISC[32 + 2 * (slot)] = (unsigned)t_; MISC[33 + 2 * (slot)] = (unsigned)(t_ >> 32); } } while (0)
#define PRB_L ((PROBE_PH - 1) / 10)
#define PRB_K ((PROBE_PH - 1) % 10)
#define SEAMX(k, endhit, beghit) do { if (IN(k) && IN((k) + 1)) { xcd_barrier(bar); if (XBAR_REP) { xcd_barrier(bar); xcd_barrier(bar); xcd_barrier(bar); xcd_barrier(bar); } } if (PROBE_PH >= 0 && (endhit)) STAMP(1); if (PROBE_PH >= 0 && (beghit)) STAMP(0); } while (0)
#define SEAM(k) SEAMX(k, false, false)
#define SEAML(kc) SEAMX(P + (kc), PROBE_PH >= 1 && (kc) == PRB_K && l == PRB_L, PROBE_PH >= 1 && (((kc) + 1 == PRB_K && l == PRB_L) || ((kc) == 9 && PRB_K == 0 && l + 1 == PRB_L)))

    if (PROBE_PH == 0) STAMP(0);
    if (PH_EN(0) && IN(0)) for (int rep = 0; rep < NREP(0); ++rep) { LOADP(); ph_cvt_mixer(p, 0, gw, NGW, lane, scr); ph_rope_table(p, gw, NGW, lane); ph_rmsnorm(p.in[0], p.in[2], (bf16*)(ws + WS_U), gw, NGW, lane); }
    SEAMX(0, PROBE_PH == 0, PROBE_PH == 1);
    for (int l = 0; l < DEPTH; ++l) {
        const int P = 1 + l * 10;
        if (PH_EN(1) && IN(P + 0)) for (int rep = 0; rep < NREP(1); ++rep) { LOADP();
            pg8::DenseSched S; S.T.init(M / 256, G == 256 ? NPROJ / 256 - 1 : NPROJ / 256, G, bid); S.A = (const char*)(ws + WS_U); S.Bt = (const char*)(ws + WM_IN); S.lda = DM; S.K = DM;
            pg8::Epi8<MkProj> E{MkProj{ProjDst{(bf16*)(ws + WS_QKVA), (bf16*)(ws + WS_QKVB), (bf16*)(ws + WS_CLAT), (bf16*)(ws + WS_G), rope, (bf16*)(ws + WS_KR)}, (float*)(ws + WS_SSQQ), (float*)(ws + WS_SSQKV)}};
            pg8::gemm_phase(lds, S, E, MISC + 40, 1);
        }
        SEAML(0);
        if (PH_EN(2) && IN(P + 1)) for (int rep = 0; rep < NREP(2); ++rep) { LOADP();
            const bool split = (G == 256);
            if (split && bid < 64) {
                pg8::DenseSched S; S.T.init(M / 256, 1, 64, bid); S.pn0 = NPROJ / 256 - 1; S.A = (const char*)(ws + WS_U); S.Bt = (const char*)(ws + WM_IN); S.lda = DM; S.K = DM;
                pg8::Epi8<MkProj> E{MkProj{ProjDst{(bf16*)(ws + WS_QKVA), (bf16*)(ws + WS_QKVB), (bf16*)(ws + WS_CLAT), (bf16*)(ws + WS_G), rope, (bf16*)(ws + WS_KR)}, (float*)(ws + WS_SSQQ), (float*)(ws + WS_SSQKV)}};
                pg8::gemm_phase(lds, S, E);
            } else {
            const int Gb = split ? 192 : G, cb = split ? bid - 64 : bid;
            { pg8::DenseSched S; S.T.init(M / 256, 3, Gb, cb); S.A = (const char*)(ws + WS_CLAT); S.Bt = (const char*)(ws + WM_UQ); S.lda = PCL; S.K = 256;
              pg8::Epi8<MkPlain<EpiQc>> E{MkPlain<EpiQc>{EpiQc{(bf16*)(ws + WS_QC), (const float*)(ws + WS_SSQQ), rope}}};
              pg8::gemm_phase(lds, S, E, MISC + 40, 2); }
            { pg8::DenseSched S; S.T.init(M / 256, 3, Gb, cb); S.A = (const char*)(ws + WS_CLAT) + 512; S.Bt = (const char*)(ws + WM_UKV); S.lda = PCL; S.K = 256;
              pg8::Epi8<MkPlain<EpiKv>> E{MkPlain<EpiKv>{EpiKv{(bf16*)(ws + WS_KVC), (const float*)(ws + WS_SSQKV)}}};
              pg8::gemm_phase(lds, S, E, MISC + 40, 2); }
            }
        }
        SEAML(1);
        if (PH_EN(3) && IN(P + 2)) { LOADP();
            if (NREP(3) == 2) { att::phase(p, l, lds, MISC + 16, ctl + CW_ATTN + l * 64 + 8, args.zero != 0, DRY_TMASK, 0, att::NJOBS); __syncthreads(); }
            att::phase(p, l, lds, MISC + 16, ctl + CW_ATTN + l * 64, true, 7, 0, att::NJOBS);
        }
        SEAML(2);
        if (PH_EN(4) && IN(P + 3)) { LOADP(); ph_amerge(p, gw, NGW, lane); }
        SEAML(3);
        if (PH_EN(5) && IN(P + 4)) for (int rep = 0; rep < NREP(5); ++rep) { LOADP();
            const int rot = bid % 3;
            for (int s = 0; s < 3; ++s) { const int br = (s + rot) % 3;
                pg8::DenseSched S; S.T.init(M / 256, 4, G, bid);
                S.A = (const char*)(ws + (br == 0 ? WS_OA : br == 1 ? WS_QKVB : WS_OC)); S.Bt = (const char*)(ws + (br == 0 ? WM_PA : br == 1 ? WM_PB : WM_PC));
                S.lda = br == 0 ? POA : br == 1 ? PB : POC; S.K = br == 0 ? 256 : br == 1 ? 512 : 384;
                pg8::Epi8<MkPlain<EpiMerge>> E{MkPlain<EpiMerge>{EpiMerge{(bf16*)(ws + WS_MERGED), (const bf16*)(ws + WS_G) + br * 1024, s == 0}}};
                pg8::gemm_phase(lds, S, E, MISC + 40, 5); }
        }
        SEAML(4);
        if (PH_EN(6) && IN(P + 5)) for (int rep = 0; rep < (l == 0 ? NREP(6) : 1); ++rep) { LOADP();
            pg8::DenseSched S; S.T.init(M / 256, 4, G, bid); S.A = (const char*)(ws + WS_MERGED); S.Bt = (const char*)(ws + WM_O); S.lda = DM; S.K = DM;
            pg8::Epi4<MkPlain<EpiResid>> E{MkPlain<EpiResid>{EpiResid{l == 0 ? p.in[0] : p.out, p.out}}};
            pg8::gemm_phase(lds, S, E, MISC + 40, 6);
        }
        SEAML(5);
        if (PH_EN(7) && IN(P + 6)) { LOADP(); ph_router(p, l, bid, G, wave, lane, lds, (LAS unsigned*)(lds + 81920)); __syncthreads(); for (int rep = 0; rep < NREP(11); ++rep) ph_cvt_experts(p, l, gw, NGW, lane, scr); }
        SEAML(6);
        if (PH_EN(8) && IN(P + 7)) for (int rep = 0; rep < NREP(8); ++rep) { LOADP();
            const unsigned* cnt = ctl + CW_CNT + l * 1024;
            pg8::MoeSched<true> S{cnt, (const int*)(ws + WS_LIST), (const char*)(ws + WS_U), (const char*)(ws + WS_WGU), DM, DM, 4, G, bid, (size_t)1024 * 1024 * 2};
            pg8::Epi8<MkGateUp> E{MkGateUp{(bf16*)(ws + WS_ACT), (const float*)(ws + WS_WLIST)}};
            pg8::gemm_phase(lds, S, E, MISC + 40, 8);
        }
        SEAML(7);
        if (PH_EN(9) && IN(P + 8)) for (int rep = 0; rep < NREP(9); ++rep) { LOADP();
            const unsigned* cnt = ctl + CW_CNT + l * 1024;
            pg8::MoeSched<false> S{cnt, (const int*)(ws + WS_LIST), (const char*)(ws + WS_ACT), (const char*)(ws + WS_WD), DEXP, DEXP, 4, G, bid, (size_t)1024 * 512 * 2};
            pg8::Epi8<MkDown> E{MkDown{(bf16*)(ws + WS_Y), (const int*)(ws + WS_LIST)}};
            pg8::gemm_phase(lds, S, E, MISC + 40, 9);
        }
        SEAML(8);
        if (PH_EN(10) && IN(P + 9)) { LOADP(); if (NREP(14) == 2) ph_combine(p, l, gw, NGW, lane, args.zero != 0); ph_combine(p, l, gw, NGW, lane, true); if (l + 1 < DEPTH) for (int rep = 0; rep < NREP(12); ++rep) ph_cvt_mixer(p, l + 1, gw, NGW, lane, scr); }
        SEAML(9);
    }
    if (PROBE_PH >= 0 && T0COND) {
        if (PROBE_PH == N_PHASES - 1) STAMP(1);
        const unsigned long long t0 = ((unsigned long long)MISC[33] << 32) | MISC[32], t1 = ((unsigned long long)MISC[35] << 32) | MISC[34];
        const unsigned long long tgt = __builtin_amdgcn_s_memrealtime() + (unsigned long long)PROBE_K * (t1 - t0);
        while (__builtin_amdgcn_s_memrealtime() < tgt) __builtin_amdgcn_s_sleep(8);
    }
    if ((ATT_PROF || GEMM_PROF) && T0COND) {
        const unsigned long long acc = ((unsigned long long)MISC[41] << 32) | MISC[40];
        const unsigned long long tgt = __builtin_readcyclecounter() + (unsigned long long)PROBE_K * acc;
        while (__builtin_readcyclecounter() < tgt) __builtin_amdgcn_s_sleep(8);
    }
#undef IN
#undef SEAM
}

extern "C" void kernel_launch(void* const* d_in, const int* in_sizes, int n_in, void* d_out, int out_size, void* d_ws, size_t ws_size, hipStream_t stream) {
    static int grid = 0;
    if (grid == 0) {
        if (n_in != 23 || ws_size < WS_END || out_size != M * DM) { fprintf(stderr, "kernel_launch: unexpected sizes\n"); grid = -1; return; }
        int dev = 0, cus = 0, per_cu = 0;
        if (hipGetDevice(&dev) != hipSuccess || hipDeviceGetAttribute(&cus, hipDeviceAttributeMultiprocessorCount, dev) != hipSuccess) { grid = -1; return; }
        if (hipFuncSetAttribute((const void*)mega_fwd, hipFuncAttributeMaxDynamicSharedMemorySize, LDS_BYTES) != hipSuccess) { fprintf(stderr, "kernel_launch: hipFuncSetAttribute failed\n"); grid = -1; return; }
        if (hipOccupancyMaxActiveBlocksPerMultiprocessor(&per_cu, (const void*)mega_fwd, NWAVES * 64, LDS_BYTES) != hipSuccess || per_cu < 1) { fprintf(stderr, "kernel_launch: occupancy query says %d\n", per_cu); }
        (void)hipGetLastError();
        grid = cus;
    }
    if (grid < 0) return;
    (void)hipMemsetAsync((char*)d_ws + WS_CTL, 0, CTL_BYTES, stream);
    Args a{}; for (int i = 0; i < 23; ++i) a.p.in[i] = (const float*)d_in[i]; a.p.out = (float*)d_out; a.p.ws = (unsigned char*)d_ws;
#if MK_PER_PHASE
    for (int ph = 0; ph < N_PHASES; ++ph) { a.ph_lo = ph; a.ph_hi = ph + 1; hipLaunchKernelGGL(mega_fwd, dim3(grid), dim3(NWAVES * 64), LDS_BYTES, stream, a); }
#else
    a.ph_lo = 0; a.ph_hi = N_PHASES; hipLaunchKernelGGL(mega_fwd, dim3(grid), dim3(NWAVES * 64), LDS_BYTES, stream, a);
#endif
}
```
